# Optimizing an MI355X kernel written in HIP

```python
import jax, jax.numpy as jnp
from jax import lax
import numpy as np

D_MODEL = 1024
BATCH = 8
SEQ = 4096
DEPTH = 2

CHUNK = 64
QBLOCK = 128
EPS = 1e-6
N_BRANCH = 4

A_HEADS = 8
A_NOPE = 64
A_ROPE = 32
A_VDIM = 64
A_QRANK = D_MODEL // 4
A_KVRANK = D_MODEL // 8
A_WIDTH = A_HEADS * A_VDIM
ROPE_THETA = 10000.0

B_HEADS = 4
B_QK = 64
B_V = 128
B_WIDTH = B_HEADS * B_V
MLSTM_CHUNK = CHUNK
F_BIAS_INIT = 3.0

C_WIDTH = D_MODEL // 2
CONV_K = 3

D_GROUPS = 4
D_POS = 128
D_WIDTH = D_MODEL // 2
D_GCH = D_WIDTH // D_GROUPS

IN_SIZES = (A_QRANK, A_KVRANK, A_ROPE, A_WIDTH,
            B_HEADS * B_QK, B_HEADS * B_QK, B_WIDTH, B_HEADS, B_HEADS, B_WIDTH, B_WIDTH,
            C_WIDTH, C_WIDTH, C_WIDTH, C_WIDTH,
            2 * D_WIDTH, D_WIDTH)
IN_DIM = (A_QRANK + A_KVRANK + A_ROPE + A_WIDTH
          + 2 * B_HEADS * B_QK + 3 * B_WIDTH + 2 * B_HEADS
          + 4 * C_WIDTH + 3 * D_WIDTH)

kernel_name = 'hybrid_gated_parallel_mixers'


def split_cols(z):
    idx = []
    acc = 0
    for s in IN_SIZES[:-1]:
        acc += s
        idx.append(acc)
    return jnp.split(z, idx, axis=-1)


def rmsnorm(x, g):
    xf = x.astype(jnp.float32)
    y = xf * lax.rsqrt(jnp.mean(xf * xf, axis=-1, keepdims=True) + EPS)
    return (y * g.astype(jnp.float32)).astype(x.dtype)


def layernorm(x, g):
    xf = x.astype(jnp.float32)
    xc = xf - jnp.mean(xf, axis=-1, keepdims=True)
    y = xc * lax.rsqrt(jnp.mean(xc * xc, axis=-1, keepdims=True) + EPS)
    return (y * g.astype(jnp.float32)).astype(x.dtype)


def rope(t, pos):
    half = t.shape[-1] // 2
    inv = ROPE_THETA ** (-jnp.arange(half, dtype=jnp.float32) / half)
    ang = pos.astype(jnp.float32)[..., None] * inv
    cos = jnp.cos(ang).astype(t.dtype)
    sin = jnp.sin(ang).astype(t.dtype)
    t1, t2 = t[..., :half], t[..., half:]
    return jnp.concatenate([t1 * cos - t2 * sin, t1 * sin + t2 * cos], axis=-1)


def mla_branch(cq, ckv, krope, pos, g_cq, g_ckv, w_uq, w_ukv):
    bsz, s_len, _ = cq.shape
    q = (rmsnorm(cq, g_cq) @ w_uq).reshape(bsz, s_len, A_HEADS, A_NOPE + A_ROPE).transpose(0, 2, 1, 3)
    kv = (rmsnorm(ckv, g_ckv) @ w_ukv).reshape(bsz, s_len, A_HEADS, A_NOPE + A_VDIM).transpose(0, 2, 1, 3)
    k_nope, v = kv[..., :A_NOPE], kv[..., A_NOPE:]
    pos_h = pos[:, None, :]
    q_rope = rope(q[..., A_NOPE:], pos_h)
    k_rope = rope(krope[:, None], pos_h)
    q = jnp.concatenate([q[..., :A_NOPE], q_rope], axis=-1)
    k = jnp.concatenate([k_nope, jnp.broadcast_to(k_rope, k_nope.shape[:-1] + (A_ROPE,))], axis=-1)
    scale = (A_NOPE + A_ROPE) ** -0.5
    chunk_id = jnp.arange(s_len) // CHUNK
    outs = []
    for qb in range(s_len // QBLOCK):
        lo, hi = qb * QBLOCK, (qb + 1) * QBLOCK
        sc = jnp.einsum('bhqd,bhkd->bhqk', q[:, :, lo:hi], k[:, :, :hi]).astype(jnp.float32) * scale
        mask = chunk_id[None, :hi] <= chunk_id[lo:hi, None]
        sc = jnp.where(mask, sc, -1e30)
        p = jax.nn.softmax(sc, axis=-1).astype(v.dtype)
        outs.append(jnp.einsum('bhqk,bhkd->bhqd', p, v[:, :, :hi]))
    o = jnp.concatenate(outs, axis=2)
    return o.transpose(0, 2, 1, 3).reshape(bsz, s_len, A_WIDTH)


def mlstm_branch(q, k, v, i_pre, f_pre, o_pre, f_bias, g_mh):
    bsz, s_len, _ = q.shape
    L = MLSTM_CHUNK
    nc = s_len // L
    f32 = jnp.float32

    def heads(t, d):
        return t.reshape(bsz, nc, L, B_HEADS, d).transpose(0, 3, 1, 2, 4).astype(f32)

    def gates(t):
        return t.reshape(bsz, nc, L, B_HEADS).transpose(0, 3, 1, 2).astype(f32)

    qh = heads(q, B_QK) * (B_QK ** -0.5)
    kh = heads(k, B_QK)
    vh = heads(v, B_V)
    ig = gates(i_pre)
    lf = jax.nn.log_sigmoid(gates(f_pre + f_bias))
    b = jnp.cumsum(lf, axis=-1)
    g = b[..., -1]
    a = g[..., None] - b + ig
    m_loc = jnp.max(a, axis=-1)
    w = jnp.exp(a - m_loc[..., None])
    ck = jnp.einsum('bhcl,bhcld,bhcle->bhcde', w, kh, vh)
    nk = jnp.einsum('bhcl,bhcld->bhcd', w, kh)

    def step(carry, inp):
        c_st, n_st, m_st = carry
        ck_c, nk_c, g_c, ml_c = inp
        m_new = jnp.maximum(g_c + m_st, ml_c)
        s_old = jnp.exp(g_c + m_st - m_new)
        s_new = jnp.exp(ml_c - m_new)
        c_new = s_old[..., None, None] * c_st + s_new[..., None, None] * ck_c
        n_new = s_old[..., None] * n_st + s_new[..., None] * nk_c
        return (c_new, n_new, m_new), (c_st, n_st, m_st)

    init = (jnp.zeros((bsz, B_HEADS, B_QK, B_V), f32),
            jnp.zeros((bsz, B_HEADS, B_QK), f32),
            jnp.zeros((bsz, B_HEADS), f32))
    xs = (jnp.moveaxis(ck, 2, 0), jnp.moveaxis(nk, 2, 0), jnp.moveaxis(g, 2, 0), jnp.moveaxis(m_loc, 2, 0))
    _, (c_prev, n_prev, m_prev) = lax.scan(step, init, xs)
    c_prev = jnp.moveaxis(c_prev, 0, 2)
    n_prev = jnp.moveaxis(n_prev, 0, 2)
    m_prev = jnp.moveaxis(m_prev, 0, 2)

    causal = jnp.tril(jnp.ones((L, L), dtype=bool))
    dmat = jnp.where(causal, b[..., :, None] - b[..., None, :] + ig[..., None, :], -jnp.inf)
    inter = b + m_prev[..., None]
    m_t = jnp.maximum(jnp.max(dmat, axis=-1), inter)
    pq = jnp.exp(dmat - m_t[..., None]) * jnp.einsum('bhctd,bhcsd->bhcts', qh, kh)
    e_inter = jnp.exp(inter - m_t)
    num = jnp.einsum('bhcts,bhcse->bhcte', pq, vh) + e_inter[..., None] * jnp.einsum('bhctd,bhcde->bhcte', qh, c_prev)
    den = jnp.sum(pq, axis=-1) + e_inter * jnp.einsum('bhctd,bhcd->bhct', qh, n_prev)
    h = num / jnp.maximum(jnp.abs(den), jnp.exp(-m_t))[..., None]
    h = h * lax.rsqrt(jnp.mean(h * h, axis=-1, keepdims=True) + EPS)
    h = h.transpose(0, 2, 3, 1, 4).reshape(bsz, s_len, B_WIDTH) * g_mh.astype(f32)
    return (h * jax.nn.sigmoid(o_pre.astype(f32))).astype(v.dtype)


def shortconv_branch(xc, bg, cg, w_conv, b_conv):
    u = cg * xc
    y = lax.conv_general_dilated(u, w_conv, window_strides=(1,), padding=[(CONV_K - 1, 0)],
                                 dimension_numbers=('NWC', 'WIO', 'NWC'),
                                 feature_group_count=C_WIDTH)
    return bg * (y + b_conv)


def sgu_branch(uv, g_sv, w_s, b_s):
    bsz, s_len, _ = uv.shape
    uv = jax.nn.gelu(uv)
    u, v = uv[..., :D_WIDTH], uv[..., D_WIDTH:]
    v = layernorm(v, g_sv).reshape(bsz, s_len // D_POS, D_POS, D_GROUPS, D_GCH)
    ws = jnp.tril(w_s)
    mixed = jnp.einsum('gts,bnsgc->bntgc', ws, v) + b_s.T[None, None, :, :, None]
    return u * mixed.reshape(bsz, s_len, D_WIDTH)


def hybrid_layer(x, pos, g_pre, g_post, w_in, w_gate, b_gate, g_cq, g_ckv, w_uq, w_ukv,
                 f_bias, g_mh, w_conv, b_conv, g_sv, w_s, b_s, w_pa, w_pb, w_pc, w_pd, w_out):
    bsz, s_len, _ = x.shape
    h = rmsnorm(x, g_pre)
    (cq, ckv, krope, ga,
     mq, mk, mv, mi, mf, mo, gb,
     cx, cb, cc, gc,
     duv, gd) = split_cols(h @ w_in)
    y_a = mla_branch(cq, ckv, krope, pos, g_cq, g_ckv, w_uq, w_ukv) * jax.nn.silu(ga)
    y_b = mlstm_branch(mq, mk, mv, mi, mf, mo, f_bias, g_mh) * jax.nn.silu(gb)
    y_c = shortconv_branch(cx, cb, cc, w_conv, b_conv) * jax.nn.silu(gc)
    y_d = sgu_branch(duv, g_sv, w_s, b_s) * jax.nn.silu(gd)
    gates = jax.nn.sigmoid((h @ w_gate + b_gate).astype(jnp.float32)).astype(x.dtype)
    gates = gates.reshape(bsz, s_len, N_BRANCH, D_MODEL)
    merged = (gates[:, :, 0] * (y_a @ w_pa) + gates[:, :, 1] * (y_b @ w_pb)
              + gates[:, :, 2] * (y_c @ w_pc) + gates[:, :, 3] * (y_d @ w_pd))
    return x + rmsnorm(merged @ w_out, g_post)


def setup_inputs(seed: int = 0) -> dict:
    key = jax.random.key(seed)
    ks = jax.random.split(key, 32)
    f32 = jnp.float32

    def nrm(k, shape, fan_in):
        return jax.random.normal(k, shape, f32) * (fan_in ** -0.5)

    def gain(k, shape):
        return 1.0 + 0.05 * jax.random.normal(k, shape, f32)

    x = jax.random.normal(ks[0], (BATCH, SEQ, D_MODEL), f32)
    offsets = jax.random.randint(ks[1], (BATCH, 1), 0, 64) * CHUNK
    positions = (offsets + jnp.arange(SEQ)[None, :]).astype(jnp.int32)
    return {
        'x': x,
        'positions': positions,
        'g_pre': gain(ks[2], (DEPTH, D_MODEL)),
        'g_post': gain(ks[3], (DEPTH, D_MODEL)),
        'w_in': nrm(ks[4], (DEPTH, D_MODEL, IN_DIM), D_MODEL),
        'w_gate': nrm(ks[5], (DEPTH, D_MODEL, N_BRANCH * D_MODEL), D_MODEL),
        'b_gate': 0.01 * jax.random.normal(ks[6], (DEPTH, N_BRANCH * D_MODEL), f32),
        'g_cq': gain(ks[7], (DEPTH, A_QRANK)),
        'g_ckv': gain(ks[8], (DEPTH, A_KVRANK)),
        'w_uq': nrm(ks[9], (DEPTH, A_QRANK, A_HEADS * (A_NOPE + A_ROPE)), A_QRANK),
        'w_ukv': nrm(ks[10], (DEPTH, A_KVRANK, A_HEADS * (A_NOPE + A_VDIM)), A_KVRANK),
        'f_bias': F_BIAS_INIT + 0.1 * jax.random.normal(ks[11], (DEPTH, B_HEADS), f32),
        'g_mh': gain(ks[12], (DEPTH, B_WIDTH)),
        'w_conv': nrm(ks[13], (DEPTH, CONV_K, 1, C_WIDTH), CONV_K),
        'b_conv': 0.01 * jax.random.normal(ks[14], (DEPTH, C_WIDTH), f32),
        'g_sv': gain(ks[15], (DEPTH, D_WIDTH)),
        'w_s': nrm(ks[16], (DEPTH, D_GROUPS, D_POS, D_POS), D_POS),
        'b_s': 1.0 + 0.01 * jax.random.normal(ks[17], (DEPTH, D_GROUPS, D_POS), f32),
        'w_pa': nrm(ks[18], (DEPTH, A_WIDTH, D_MODEL), A_WIDTH),
        'w_pb': nrm(ks[19], (DEPTH, B_WIDTH, D_MODEL), B_WIDTH),
        'w_pc': nrm(ks[20], (DEPTH, C_WIDTH, D_MODEL), C_WIDTH),
        'w_pd': nrm(ks[21], (DEPTH, D_WIDTH, D_MODEL), D_WIDTH),
        'w_out': nrm(ks[22], (DEPTH, D_MODEL, D_MODEL), D_MODEL),
    }


def reference(x, positions, g_pre, g_post, w_in, w_gate, b_gate, g_cq, g_ckv, w_uq, w_ukv,
              f_bias, g_mh, w_conv, b_conv, g_sv, w_s, b_s, w_pa, w_pb, w_pc, w_pd, w_out):
    for l in range(DEPTH):
        x = hybrid_layer(x, positions, g_pre[l], g_post[l], w_in[l], w_gate[l], b_gate[l],
                         g_cq[l], g_ckv[l], w_uq[l], w_ukv[l], f_bias[l], g_mh[l],
                         w_conv[l], b_conv[l], g_sv[l], w_s[l], b_s[l],
                         w_pa[l], w_pb[l], w_pc[l], w_pd[l], w_out[l])
    return x
```

```cpp
#include <hip/hip_runtime.h>
#include <cstdio>
#include <cstdint>
#include <cmath>
constexpr int ZT_LD = 2432, ZT_CQ = 0, ZT_CKV = 256, ZT_MQ = 384, ZT_MK = 640, ZT_MV = 896, ZT_U = 1408, ZT_V = 1920;
constexpr int ZY_LD = 2048, YA = 0, YB = 512, YC = 1024, YD = 1536;
constexpr float RMS_EPS = 1e-6f;
namespace pg8 {
#define PG8_LAS __attribute__((address_space(3)))
typedef unsigned short bf16_t;
typedef short bf16x8 __attribute__((ext_vector_type(8)));
typedef float f32x4 __attribute__((ext_vector_type(4)));
typedef unsigned u32x4 __attribute__((ext_vector_type(4)));
constexpr int BM = 256, BK = 64, HALF = 128, HTB = HALF * BK * 2  , STAGE_BYTES = 8 * HTB, NXCD = 8, WGM = 8;

__host__ __device__ __forceinline__ int lds_byte(int r, int c) { const int st = (r >> 4) * 2 + (c >> 5), rr = r & 15, cc = c & 31, ob = rr * 64 + cc * 2; return st * 1024 + (ob ^ (((ob >> 9) & 1) << 5)); }
__host__ __device__ __forceinline__ void stage_rc(int b, int& R, int& C) { const int st = b / 1024, sb = b % 1024, swz = sb ^ (((sb >> 9) & 1) << 5); R = (st >> 1) * 16 + swz / 64; C = (st & 1) * 32 + (swz % 64) / 2; }
__host__ __device__ __forceinline__ int perm32(int rho) { const int n = rho >> 4, i = rho & 15; return 8 * (i >> 2) + 4 * n + (i & 3); }

struct Unit { int pm, pn; };
struct Gemm { const bf16_t* A; const bf16_t* Bt; int M, N, K, lda; };

struct StaticOrder {
    int nM, nN, nwg, G, c;
    __host__ __device__ __forceinline__ void init(int M, int N, int G_, int c_) { nM = M / BM; nN = N / BM; nwg = nM * nN; G = G_; c = c_; }
    __host__ __device__ __forceinline__ bool next(int i, Unit& u) const {
        const long L = (long)i * G + c; if (L >= nwg) return false;
        int wgid = (int)L; { const int q = nwg / NXCD, r = nwg % NXCD, xcd = wgid % NXCD, off = wgid / NXCD; wgid = (xcd < r ? xcd * (q + 1) : r * (q + 1) + (xcd - r) * q) + off; }
        const int nig = WGM * nN, gid = wgid / nig, fm = gid * WGM, gsz = (nM - fm) < WGM ? (nM - fm) : WGM;
        u.pm = fm + ((wgid % nig) % gsz); u.pn = (wgid % nig) / gsz; return true;
    }
    __device__ __forceinline__ void a_ready(const Unit&) const {}
    __device__ __forceinline__ void done(const Unit&) const {}
};

typedef __bf16 bf16x2_t __attribute__((ext_vector_type(2)));
__device__ __forceinline__ unsigned cvt_pk_bf16(float lo, float hi) { typedef float f32x2_t __attribute__((ext_vector_type(2))); f32x2_t v = {lo, hi}; bf16x2_t b = __builtin_convertvector(v, bf16x2_t); return __builtin_bit_cast(unsigned, b); }
typedef float f32x2 __attribute__((ext_vector_type(2)));
typedef unsigned u32x2 __attribute__((ext_vector_type(2)));
__device__ __forceinline__ float fexp2(float x) { return __builtin_amdgcn_exp2f(x); }
__device__ __forceinline__ float frcp(float x) { return __builtin_amdgcn_rcpf(x); }
__device__ __forceinline__ float sigm(float x) { return frcp(1.f + fexp2(-1.4426950409f * x)); }
__device__ __forceinline__ float silu(float x) { return x * sigm(x); }
__device__ __forceinline__ float gelu_t(float x) { const float u = x + 0.044715f * x * x * x; return x * frcp(1.f + fexp2(-2.302208198f * u)); }
__device__ __forceinline__ float bflo(unsigned w) { return __uint_as_float(w << 16); }
__device__ __forceinline__ float bfhi(unsigned w) { return __uint_as_float(w & 0xffff0000u); }
__device__ __forceinline__ u32x4 pack8(const float (&o)[8]) { u32x4 w; w.x = cvt_pk_bf16(o[0], o[1]); w.y = cvt_pk_bf16(o[2], o[3]); w.z = cvt_pk_bf16(o[4], o[5]); w.w = cvt_pk_bf16(o[6], o[7]); return w; }
__device__ __forceinline__ float quad_sum(float s) {
    s += __int_as_float(__builtin_amdgcn_ds_swizzle(__float_as_int(s), (16 << 10) | 0x1f)); auto r = __builtin_amdgcn_permlane32_swap(__float_as_uint(s), __float_as_uint(s), false, false); return __uint_as_float(r[0]) + __uint_as_float(r[1]); }

struct EpiIn {
    static constexpr bool PERM = true, AFTER_DRAIN = false;
    bf16_t* ZT; bf16_t* ZY; bf16_t* KR; float* PQ; float* PKV; float* PVS; float* GIF; const float* ROPE;
    __device__ __forceinline__ void operator()(const f32x4 (&acc)[2][2][4][2], const Unit& u, int wr, int wc, int fr_, int fq_) const {
        int fr = fr_, fq = fq_; asm volatile("" : "+v"(fr), "+v"(fq));
        const int t = u.pn, row0 = u.pm * BM + wr * 64 + fr, cw = wc * 32 + 8 * fq;
        if (t >= 8 && t < 24) {
            const int kind = (t - 8) >> 2, c0 = ((t - 8) & 3) * 128 + cw;
            bf16_t* dst = kind == 0 ? ZY + YB : kind == 1 ? ZT + ZT_U : kind == 2 ? ZY + YC : ZY + YD; const int ld = kind == 1 ? ZT_LD : ZY_LD;
#pragma unroll
            for (int ai = 0; ai < 2; ++ai)
#pragma unroll
                for (int m = 0; m < 4; ++m) { const size_t row = (size_t)(row0 + ai * HALF + m * 16); float o[8];
#pragma unroll
                    for (int e = 0; e < 8; ++e) { const float a = acc[ai][0][m][e >> 2][e & 3], b = acc[ai][1][m][e >> 2][e & 3];
                        o[e] = kind == 0 ? sigm(a) * silu(b) : kind == 1 ? a * b : kind == 2 ? a * silu(b) : gelu_t(a) * silu(b); }
                    *(u32x4*)(dst + row * ld + c0) = pack8(o); }
            return;
        }
        if (t == 1) {
#pragma unroll
            for (int ai = 0; ai < 2; ++ai)
#pragma unroll
                for (int m = 0; m < 4; ++m) { const size_t row = (size_t)(row0 + ai * HALF + m * 16); float o[8]; float ss = 0.f;
#pragma unroll
                    for (int e = 0; e < 8; ++e) { o[e] = acc[ai][0][m][e >> 2][e & 3]; ss += o[e] * o[e]; }
                    *(u32x4*)(ZT + row * ZT_LD + ZT_CKV + cw) = pack8(o);
                    ss = quad_sum(ss); if (fq == 0) PKV[row * 4 + wc] = ss;
                    if (wc == 0) { const f32x4 t1 = acc[ai][1][m][0], t2 = acc[ai][1][m][1];
                        const f32x4 cs0 = *(const f32x4*)(ROPE + row * 32 + 8 * fq), cs1 = *(const f32x4*)(ROPE + row * 32 + 8 * fq + 4);
                        const float c[4] = {cs0[0], cs0[2], cs1[0], cs1[2]}, s[4] = {cs0[1], cs0[3], cs1[1], cs1[3]};
                        u32x2 w1, w2; w1.x = cvt_pk_bf16(t1[0] * c[0] - t2[0] * s[0], t1[1] * c[1] - t2[1] * s[1]); w1.y = cvt_pk_bf16(t1[2] * c[2] - t2[2] * s[2], t1[3] * c[3] - t2[3] * s[3]);
                        w2.x = cvt_pk_bf16(t1[0] * s[0] + t2[0] * c[0], t1[1] * s[1] + t2[1] * c[1]); w2.y = cvt_pk_bf16(t1[2] * s[2] + t2[2] * c[2], t1[3] * s[3] + t2[3] * c[3]);
                        *(u32x2*)(KR + row * 32 + 4 * fq) = w1; *(u32x2*)(KR + row * 32 + 16 + 4 * fq) = w2; }
                    if (wc == 1 && fq == 0) { *(f32x4*)(GIF + row * 8) = acc[ai][1][m][0]; *(f32x4*)(GIF + row * 8 + 4) = acc[ai][1][m][1]; } }
            return;
        }
        bf16_t* dst; int ld, act = 0, st = 0;
        if (t == 0) { dst = ZT + ZT_CQ; ld = ZT_LD; st = 1; } else if (t < 4) { dst = ZY + YA + (t - 2) * 256; ld = ZY_LD; act = 1; }
        else if (t == 4) { dst = ZT + ZT_MQ; ld = ZT_LD; } else if (t == 5) { dst = ZT + ZT_MK; ld = ZT_LD; } else if (t < 8) { dst = ZT + ZT_MV + (t - 6) * 256; ld = ZT_LD; }
        else { dst = ZT + ZT_V + (t - 24) * 256; ld = ZT_LD; act = 2; st = 2; }
#pragma unroll
        for (int ai = 0; ai < 2; ++ai)
#pragma unroll
            for (int m = 0; m < 4; ++m) { const size_t row = (size_t)(row0 + ai * HALF + m * 16); float s1 = 0.f, s2 = 0.f;
#pragma unroll
                for (int bj = 0; bj < 2; ++bj) { float o[8];
#pragma unroll
                    for (int e = 0; e < 8; ++e) { float v = acc[ai][bj][m][e >> 2][e & 3]; v = act == 1 ? silu(v) : act == 2 ? gelu_t(v) : v; o[e] = v; s1 += v; s2 += v * v; }
                    *(u32x4*)(dst + row * ld + bj * HALF + cw) = pack8(o); }
                if (st == 1) { s2 = quad_sum(s2); if (fq == 0) PQ[row * 4 + wc] = s2; }
                if (st == 2) { s1 = quad_sum(s1); s2 = quad_sum(s2); if (fq == 0) { f32x2 p; p.x = s1; p.y = s2; *(f32x2*)(PVS + (row * 8 + (t - 24) * 4 + wc) * 2) = p; } } }
    }
};
struct EpiUpQ {
    static constexpr bool PERM = true, AFTER_DRAIN = false;
    bf16_t* Q; const float* PQ; const float* ROPE;
    __device__ __forceinline__ void operator()(const f32x4 (&acc)[2][2][4][2], const Unit& u, int wr, int wc, int fr_, int fq_) const {
        int fr = fr_, fq = fq_; asm volatile("" : "+v"(fr), "+v"(fq));
        const int t = u.pn, row0 = u.pm * BM + wr * 64 + fr;
#pragma unroll
        for (int ai = 0; ai < 2; ++ai)
#pragma unroll
            for (int m = 0; m < 4; ++m) { const size_t row = (size_t)(row0 + ai * HALF + m * 16);
                const f32x4 pq = *(const f32x4*)(PQ + row * 4); const float rs = __builtin_amdgcn_rsqf(((pq[0] + pq[1]) + (pq[2] + pq[3])) * (1.f / 256.f) + RMS_EPS);
                if (t < 2) {
#pragma unroll
                    for (int bj = 0; bj < 2; ++bj) { float o[8];
#pragma unroll
                        for (int e = 0; e < 8; ++e) o[e] = acc[ai][bj][m][e >> 2][e & 3] * rs;
                        *(u32x4*)(Q + row * 768 + (4 * t + 2 * bj + (wc >> 1)) * 96 + (wc & 1) * 32 + 8 * fq) = pack8(o); }
                } else {
                    const int head = 2 * wc + (fq >> 1), j0 = 8 * (fq & 1);
#pragma unroll
                    for (int n = 0; n < 2; ++n) { const int j = j0 + 4 * n;
                        const f32x4 ca = *(const f32x4*)(ROPE + row * 32 + 2 * j), cb = *(const f32x4*)(ROPE + row * 32 + 2 * j + 4);
                        const f32x4 t1 = acc[ai][0][m][n] * rs, t2 = acc[ai][1][m][n] * rs;
                        u32x2 w1, w2; w1.x = cvt_pk_bf16(t1[0] * ca[0] - t2[0] * ca[1], t1[1] * ca[2] - t2[1] * ca[3]); w1.y = cvt_pk_bf16(t1[2] * cb[0] - t2[2] * cb[1], t1[3] * cb[2] - t2[3] * cb[3]);
                        w2.x = cvt_pk_bf16(t1[0] * ca[1] + t2[0] * ca[0], t1[1] * ca[3] + t2[1] * ca[2]); w2.y = cvt_pk_bf16(t1[2] * cb[1] + t2[2] * cb[0], t1[3] * cb[3] + t2[3] * cb[2]);
                        *(u32x2*)(Q + row * 768 + head * 96 + 64 + j) = w1; *(u32x2*)(Q + row * 768 + head * 96 + 80 + j) = w2; }
                } }
    }
};
struct EpiUpKV {
    static constexpr bool PERM = true, AFTER_DRAIN = false;
    bf16_t* KN; bf16_t* V; const float* PKV;
    __device__ __forceinline__ void operator()(const f32x4 (&acc)[2][2][4][2], const Unit& u, int wr, int wc, int fr_, int fq_) const {
        int fr = fr_, fq = fq_; asm volatile("" : "+v"(fr), "+v"(fq));
        const int t = u.pn, row0 = u.pm * BM + wr * 64 + fr, cw = wc * 32 + 8 * fq; bf16_t* dst = (t < 2 ? KN : V) + (t & 1) * 256;
#pragma unroll
        for (int ai = 0; ai < 2; ++ai)
#pragma unroll
            for (int m = 0; m < 4; ++m) { const size_t row = (size_t)(row0 + ai * HALF + m * 16);
                const f32x4 pq = *(const f32x4*)(PKV + row * 4); const float rs = __builtin_amdgcn_rsqf(((pq[0] + pq[1]) + (pq[2] + pq[3])) * (1.f / 128.f) + RMS_EPS);
#pragma unroll
                for (int bj = 0; bj < 2; ++bj) { float o[8];
#pragma unroll
                    for (int e = 0; e < 8; ++e) o[e] = acc[ai][bj][m][e >> 2][e & 3] * rs;
                    *(u32x4*)(dst + row * 512 + bj * HALF + cw) = pack8(o); } }
    }
};
struct EpiGate {
    static constexpr bool PERM = true, AFTER_DRAIN = false;
    bf16_t* S; const float* bias;
    __device__ __forceinline__ void operator()(const f32x4 (&acc)[2][2][4][2], const Unit& u, int wr, int wc, int fr_, int fq_) const {
        int fr = fr_, fq = fq_; asm volatile("" : "+v"(fr), "+v"(fq));
        const int row0 = u.pm * BM + wr * 64 + fr, col0 = u.pn * BM + wc * 32 + 8 * fq;
        f32x4 bv[2][2];
#pragma unroll
        for (int bj = 0; bj < 2; ++bj)
#pragma unroll
            for (int n = 0; n < 2; ++n) bv[bj][n] = *(const f32x4*)(bias + col0 + bj * HALF + 4 * n);
#pragma unroll
        for (int ai = 0; ai < 2; ++ai)
#pragma unroll
            for (int m = 0; m < 4; ++m) { const size_t row = (size_t)(row0 + ai * HALF + m * 16);
#pragma unroll
                for (int bj = 0; bj < 2; ++bj) { float o[8];
#pragma unroll
                    for (int e = 0; e < 8; ++e) o[e] = sigm(acc[ai][bj][m][e >> 2][e & 3] + bv[bj][e >> 2][e & 3]);
                    *(u32x4*)(S + row * 1024 + col0 + bj * HALF) = pack8(o); } }
    }
};
struct EpiProj {
    static constexpr bool PERM = true, AFTER_DRAIN = false;
    const bf16_t* S; bf16_t* MG; int first;
    __device__ __forceinline__ void operator()(const f32x4 (&acc)[2][2][4][2], const Unit& u, int wr, int wc, int fr_, int fq_) const {
        int fr = fr_, fq = fq_; asm volatile("" : "+v"(fr), "+v"(fq));
        const int row0 = u.pm * BM + wr * 64 + fr, col0 = u.pn * BM + wc * 32 + 8 * fq;
#pragma unroll
        for (int ai = 0; ai < 2; ++ai)
#pragma unroll
            for (int m = 0; m < 4; ++m) { const size_t row = (size_t)(row0 + ai * HALF + m * 16);
#pragma unroll
                for (int bj = 0; bj < 2; ++bj) { const size_t off = row * 1024 + col0 + bj * HALF;
                    const u32x4 sv = *(const u32x4*)(S + off); u32x4 mv = (u32x4){0u, 0u, 0u, 0u}; if (!first) mv = *(const u32x4*)(MG + off);
                    float o[8];
#pragma unroll
                    for (int q = 0; q < 4; ++q) { o[2 * q] = bflo(mv[q]) + bflo(sv[q]) * acc[ai][bj][m][q >> 1][(2 * q) & 3]; o[2 * q + 1] = bfhi(mv[q]) + bfhi(sv[q]) * acc[ai][bj][m][q >> 1][(2 * q + 1) & 3]; }
                    *(u32x4*)(MG + off) = pack8(o); } }
    }
};
struct EpiOut {
    static constexpr bool PERM = true, AFTER_DRAIN = false;
    bf16_t* MO; float* PO;
    __device__ __forceinline__ void operator()(const f32x4 (&acc)[2][2][4][2], const Unit& u, int wr, int wc, int fr_, int fq_) const {
        int fr = fr_, fq = fq_; asm volatile("" : "+v"(fr), "+v"(fq));
        const int row0 = u.pm * BM + wr * 64 + fr, col0 = u.pn * BM + wc * 32 + 8 * fq;
#pragma unroll
        for (int ai = 0; ai < 2; ++ai)
#pragma unroll
            for (int m = 0; m < 4; ++m) { const size_t row = (size_t)(row0 + ai * HALF + m * 16); float ss = 0.f;
#pragma unroll
                for (int bj = 0; bj < 2; ++bj) { float o[8];
#pragma unroll
                    for (int e = 0; e < 8; ++e) { o[e] = acc[ai][bj][m][e >> 2][e & 3]; ss += o[e] * o[e]; }
                    *(u32x4*)(MO + row * 1024 + col0 + bj * HALF) = pack8(o); }
                ss = quad_sum(ss); if (fq == 0) PO[row * 16 + u.pn * 4 + wc] = ss; }
    }
};
template <class Epi, class Sched, bool ALIGN_EPI = false, bool SP2 = false>
__device__ __forceinline__ void gemm_phase(PG8_LAS unsigned char* lds, const Gemm g, const Sched& S, const Epi& E) {
    int tid_ = threadIdx.x; asm volatile("" : "+v"(tid_));
    const int tid = tid_, wid = __builtin_amdgcn_readfirstlane(tid >> 6), lane = tid & 63, wr = wid >> 2, wc = wid & 3, fr = lane & 15, fq = lane >> 4;
    const int K = g.K, nt = K / BK;
    unsigned voffA[2], voffB[2];
#pragma unroll
    for (int i = 0; i < 2; ++i) { int R, C; stage_rc(tid * 16 + i * 8192, R, C); const int Rb = Epi::PERM ? ((R & ~31) + perm32(R & 31)) : R;
        voffA[i] = (unsigned)(R * g.lda + C) * 2u; voffB[i] = (unsigned)(Rb * K + C) * 2u; }
    const size_t kstep = (size_t)(BK * 2);
    const size_t hstepB = (size_t)HALF * K * 2, hstepA = (size_t)HALF * g.lda * 2;
    const size_t tstepA = 2 * hstepA, tstepB = 2 * hstepB;
    const unsigned ldsw = (unsigned)wid * 1024u;
    const int aoff = lds_byte(wr * 64 + fr, fq * 8), boff = lds_byte(wc * 32 + fr, fq * 8);
#define PG8_SA(b, h) (((b) * 2 + (h)) * HTB)
#define PG8_SB(b, h) ((4 + (b) * 2 + (h)) * HTB)
#define PG8_STAGE(bufoff, gbase, voff) do { _Pragma("unroll") for (int _i = 0; _i < 2; ++_i) \
        __builtin_amdgcn_global_load_lds((const unsigned*)((const char*)(gbase) + (voff)[_i]), (PG8_LAS unsigned*)(lds + (bufoff) + ldsw + _i * 8192), 16, 0, 0); } while (0)
#define PG8_LDA(dst, b, h) do { _Pragma("unroll") for (int m = 0; m < 4; ++m) _Pragma("unroll") for (int k = 0; k < 2; ++k) dst[m][k] = *(const PG8_LAS bf16x8*)(lds + PG8_SA(b, h) + aoff + m * 2048 + k * 1024); } while (0)
#define PG8_LDB(dst, b, h) do { _Pragma("unroll") for (int n = 0; n < 2; ++n) _Pragma("unroll") for (int k = 0; k < 2; ++k) dst[n][k] = *(const PG8_LAS bf16x8*)(lds + PG8_SB(b, h) + boff + n * 2048 + k * 1024); } while (0)
#define PG8_MMA(ai, bj, At, Bt) do { __builtin_amdgcn_s_setprio(1); _Pragma("unroll") for (int m = 0; m < 4; ++m) _Pragma("unroll") for (int n = 0; n < 2; ++n) _Pragma("unroll") for (int k = 0; k < 2; ++k) \
        acc[ai][bj][m][n] = __builtin_amdgcn_mfma_f32_16x16x32_bf16(Bt[n][k], At[m][k], acc[ai][bj][m][n], 0, 0, 0); __builtin_amdgcn_s_setprio(0); } while (0)
#define PG8_WAIT_V(n) asm volatile("s_waitcnt vmcnt(" #n ")" ::: "memory")
#define PG8_WAIT_L(n) asm volatile("s_waitcnt lgkmcnt(" #n ")" ::: "memory")
#define PG8_BAR __builtin_amdgcn_s_barrier()
#define PG8_SCHED __builtin_amdgcn_sched_barrier(0)
    Unit cur, nxt; int ui = 0;
    if (!S.next(0, cur)) return;
    f32x4 acc[2][2][4][2];
#pragma unroll
    for (int a = 0; a < 2; ++a)
#pragma unroll
        for (int b = 0; b < 2; ++b)
#pragma unroll
            for (int m = 0; m < 4; ++m)
#pragma unroll
                for (int n = 0; n < 2; ++n) acc[a][b][m][n] = (f32x4){0.f, 0.f, 0.f, 0.f};
    bf16x8 At[4][2], B0[2][2], B1[2][2];
    const char* cA = (const char*)g.A + (size_t)cur.pm * tstepA; const char* cB = (const char*)g.Bt + (size_t)cur.pn * tstepB;
    S.a_ready(cur);
    if constexpr (SP2) {
        PG8_STAGE(PG8_SB(0, 0), cB, voffB); PG8_STAGE(PG8_SB(0, 1), cB + hstepB, voffB); PG8_STAGE(PG8_SA(0, 0), cA, voffA); PG8_STAGE(PG8_SA(0, 1), cA + hstepA, voffA);
        if (wr == 1) PG8_BAR;
        PG8_WAIT_V(2); PG8_BAR;
        PG8_STAGE(PG8_SB(1, 0), cB + kstep, voffB); PG8_STAGE(PG8_SA(1, 0), cA + kstep, voffA); PG8_STAGE(PG8_SB(1, 1), cB + hstepB + kstep, voffB);
        PG8_WAIT_V(6); PG8_BAR;
    } else {
        PG8_STAGE(PG8_SB(0, 0), cB, voffB); PG8_STAGE(PG8_SA(0, 0), cA, voffA); PG8_STAGE(PG8_SB(0, 1), cB + hstepB, voffB); PG8_STAGE(PG8_SA(0, 1), cA + hstepA, voffA);
        if (wr == 1) PG8_BAR;
        PG8_WAIT_V(4); PG8_BAR;
        PG8_STAGE(PG8_SB(1, 0), cB + kstep, voffB); PG8_STAGE(PG8_SA(1, 0), cA + kstep, voffA); PG8_STAGE(PG8_SB(1, 1), cB + hstepB + kstep, voffB);
        PG8_WAIT_V(6); PG8_BAR;
    }
    for (;;) {
        const bool has_next = S.next(ui + 1, nxt);
        const char* nA = has_next ? (const char*)g.A + (size_t)nxt.pm * tstepA : cA; const char* nB = has_next ? (const char*)g.Bt + (size_t)nxt.pn * tstepB : cB;
        for (int t = 0; t < nt; t += 2) {
            const bool last = (t == nt - 2);
            const char* a1 = cA + (size_t)(t + 1) * kstep;
            const char* a2 = last ? nA : cA + (size_t)(t + 2) * kstep; const char* b2 = last ? nB : cB + (size_t)(t + 2) * kstep;
            const char* a3 = a2 + kstep; const char* b3 = b2 + kstep;
            if (last && has_next) S.a_ready(nxt);
            if constexpr (SP2) {
            PG8_LDB(B0, 0, 0); PG8_LDB(B1, 0, 1); PG8_SCHED; PG8_LDA(At, 0, 0); PG8_STAGE(PG8_SA(1, 1), a1 + hstepA, voffA);
            PG8_WAIT_V(8); PG8_WAIT_L(0); PG8_BAR; PG8_MMA(0, 0, At, B0); PG8_MMA(0, 1, At, B1); PG8_BAR; PG8_SCHED;
            PG8_LDA(At, 0, 1); PG8_STAGE(PG8_SB(0, 0), b2, voffB); PG8_STAGE(PG8_SB(0, 1), b2 + hstepB, voffB); PG8_STAGE(PG8_SA(0, 0), a2, voffA);
            PG8_WAIT_V(8); PG8_WAIT_L(0); PG8_BAR; PG8_MMA(1, 0, At, B0); PG8_MMA(1, 1, At, B1); PG8_BAR; PG8_SCHED;
            PG8_LDB(B0, 1, 0); PG8_LDB(B1, 1, 1); PG8_SCHED; PG8_LDA(At, 1, 0); PG8_STAGE(PG8_SA(0, 1), a2 + hstepA, voffA);
            PG8_WAIT_V(8); PG8_WAIT_L(0); PG8_BAR; PG8_MMA(0, 0, At, B0); PG8_MMA(0, 1, At, B1); PG8_BAR; PG8_SCHED;
            PG8_LDA(At, 1, 1); PG8_STAGE(PG8_SB(1, 0), b3, voffB); PG8_STAGE(PG8_SB(1, 1), b3 + hstepB, voffB); PG8_STAGE(PG8_SA(1, 0), a3, voffA);
            PG8_WAIT_V(8); PG8_WAIT_L(0); PG8_BAR; PG8_MMA(1, 0, At, B0); PG8_MMA(1, 1, At, B1); PG8_BAR; PG8_SCHED;
            } else {
            PG8_LDB(B0, 0, 0); PG8_SCHED; PG8_LDA(At, 0, 0); PG8_STAGE(PG8_SA(1, 1), a1 + hstepA, voffA);
            PG8_WAIT_L(8); PG8_BAR; PG8_WAIT_L(0); PG8_MMA(0, 0, At, B0); PG8_BAR; PG8_SCHED;
            PG8_LDB(B1, 0, 1); PG8_STAGE(PG8_SB(0, 0), b2, voffB);
            PG8_BAR; PG8_WAIT_L(0); PG8_MMA(0, 1, At, B1); PG8_BAR;
            PG8_LDA(At, 0, 1); PG8_STAGE(PG8_SA(0, 0), a2, voffA);
            PG8_BAR; PG8_WAIT_L(0); PG8_MMA(1, 0, At, B0); PG8_BAR; PG8_SCHED;
            PG8_STAGE(PG8_SB(0, 1), b2 + hstepB, voffB);
            PG8_WAIT_V(6); PG8_BAR; PG8_MMA(1, 1, At, B1); PG8_BAR;
            PG8_LDB(B0, 1, 0); PG8_SCHED; PG8_LDA(At, 1, 0); PG8_STAGE(PG8_SA(0, 1), a2 + hstepA, voffA);
            PG8_WAIT_L(8); PG8_BAR; PG8_WAIT_L(0); PG8_MMA(0, 0, At, B0); PG8_BAR; PG8_SCHED;
            PG8_LDB(B1, 1, 1); PG8_STAGE(PG8_SB(1, 0), b3, voffB);
            PG8_BAR; PG8_WAIT_L(0); PG8_MMA(0, 1, At, B1); PG8_BAR;
            PG8_LDA(At, 1, 1); PG8_STAGE(PG8_SA(1, 0), a3, voffA);
            PG8_BAR; PG8_WAIT_L(0); PG8_MMA(1, 0, At, B0); PG8_BAR; PG8_SCHED;
            PG8_STAGE(PG8_SB(1, 1), b3 + hstepB, voffB);
            PG8_WAIT_V(6); PG8_BAR; PG8_MMA(1, 1, At, B1); PG8_BAR;
            }
        }
        if constexpr (ALIGN_EPI) { if (wr == 0) PG8_BAR; }
        if constexpr (!Epi::AFTER_DRAIN) { E(acc, cur, wr, wc, fr, fq); S.done(cur); }
        if (!has_next) break;
#pragma unroll
        for (int a = 0; a < 2; ++a)
#pragma unroll
            for (int b = 0; b < 2; ++b)
#pragma unroll
                for (int m = 0; m < 4; ++m)
#pragma unroll
                    for (int n = 0; n < 2; ++n) acc[a][b][m][n] = (f32x4){0.f, 0.f, 0.f, 0.f};
        cur = nxt; cA = nA; cB = nB; ++ui;
        if constexpr (ALIGN_EPI) { if (wr == 1) PG8_BAR; }
    }
    PG8_WAIT_V(0);
    if constexpr (!ALIGN_EPI) { if (wr == 0) PG8_BAR; }
    PG8_BAR;
    if constexpr (Epi::AFTER_DRAIN) { E.fused(acc, cur, wr, wc, fr, fq, lds, wid, lane); S.done(cur); }
#undef PG8_SA
#undef PG8_SB
#undef PG8_STAGE
#undef PG8_LDA
#undef PG8_LDB
#undef PG8_MMA
#undef PG8_WAIT_V
#undef PG8_WAIT_L
#undef PG8_BAR
#undef PG8_SCHED
}
}

constexpr int NWAVES = 8, NTHREADS = 512;
constexpr int NB = 8, SEQ = 4096, D = 1024, M = NB * SEQ, DEPTH = 2;
constexpr int IN_DIM = 6568, NV_IN = 6656;
constexpr int O_CQ = 0, O_CKV = 256, O_KR = 384, O_GA = 416, O_MQ = 928, O_MK = 1184, O_MV = 1440, O_MI = 1952, O_MF = 1956, O_MO = 1960, O_GB = 2472,
              O_CX = 2984, O_CB = 3496, O_CC = 4008, O_GC = 4520, O_DU = 5032, O_DV = 5544, O_GD = 6056;
constexpr float QSCALE = 0.10206207261596577f * 1.4426950408889634f;
constexpr int N_PHASES = 13;
#ifndef MK_ONE_LAUNCH
#define MK_ONE_LAUNCH 0
#endif
#ifndef MK_NAIVE_ATTN
#define MK_NAIVE_ATTN 1
#endif
#ifndef MK_NAIVE_MLSTM
#define MK_NAIVE_MLSTM 1
#endif
#ifndef MK_NAIVE_SGU
#define MK_NAIVE_SGU 1
#endif

__host__ __device__ __forceinline__ int map_in(int vc, float& cs) {
    const int t = vc >> 8, j = vc & 255; cs = 1.f;
    if (t == 0) return O_CQ + j;
    if (t == 1) { if (j < 128) return O_CKV + j; const int jp = j - 128;
        if (jp < 32) { const int g = jp >> 3, w = jp & 7; return O_KR + (w < 4 ? 4 * g + w : 16 + 4 * g + (w - 4)); }
        if (jp < 36) return O_MI + (jp - 32); if (jp < 40) return O_MF + (jp - 36); return -1; }
    if (t < 4) return O_GA + 256 * (t - 2) + j;
    if (t == 4) { cs = 0.125f; return O_MQ + j; }
    if (t == 5) return O_MK + j;
    if (t < 8) return O_MV + 256 * (t - 6) + j;
    if (t < 24) { const int kind = (t - 8) >> 2, c0 = ((t - 8) & 3) * 128, jj = j & 127, hi = j >> 7;
        const int a = kind == 0 ? O_MO : kind == 1 ? O_CX : kind == 2 ? O_CB : O_DU, b = kind == 0 ? O_GB : kind == 1 ? O_CC : kind == 2 ? O_GC : O_GD;
        return (hi ? b : a) + c0 + jj; }
    return O_DV + 256 * (t - 24) + j;
}
__host__ __device__ __forceinline__ int map_q(int vc) { if (vc < 512) return (vc >> 6) * 96 + (vc & 63); const int j = vc - 512, hi = j >> 7, jj = j & 127; return (jj >> 4) * 96 + 64 + 16 * hi + (jj & 15); }
__host__ __device__ __forceinline__ int map_kv(int vc) { const int isv = vc >> 9, j = vc & 511; return (j >> 6) * 128 + 64 * isv + (j & 63); }

constexpr size_t MiB = 1u << 20;
constexpr size_t WS_CTL = 0, CTL_ZERO_BYTES = 1 * MiB;
constexpr size_t WS_WB = 1 * MiB;
constexpr size_t WB_IN = 0, WB_GATE = WB_IN + (size_t)NV_IN * 1024 * 2, WB_UQ = WB_GATE + (size_t)4096 * 1024 * 2, WB_UKV = WB_UQ + (size_t)768 * 256 * 2,
                 WB_P = WB_UKV + (size_t)1024 * 128 * 2, WB_OUT = WB_P + (size_t)4 * 1024 * 512 * 2, WB_S = WB_OUT + (size_t)1024 * 1024 * 2, WB_END = WB_S + (size_t)4 * 128 * 128 * 2;
static_assert(WB_END <= 30 * MiB, "weights");
constexpr size_t WS_H = 31 * MiB, WS_ZY = 95 * MiB, WS_ZT = 223 * MiB, WS_Q = 375 * MiB, WS_KN = 423 * MiB, WS_V = 455 * MiB, WS_KR = 487 * MiB;
constexpr size_t WS_ROPE = 489 * MiB, WS_PQ = 493 * MiB, WS_PKV = WS_PQ + MiB / 2, WS_PVS = 494 * MiB, WS_GIF = 496 * MiB, WS_MLS = 497 * MiB, WS_PO = 499 * MiB, WS_MSUM = 501 * MiB, WS_END = 512 * MiB;
constexpr size_t WS_S = WS_ZT, WS_MG = WS_ZT + 64 * MiB, WS_MO = WS_ZY;
static_assert(WS_ZT + (size_t)M * ZT_LD * 2 <= WS_Q && WS_ZY + (size_t)M * ZY_LD * 2 <= WS_ZT && WS_H + (size_t)M * D * 2 <= WS_ZY && WS_MG + (size_t)M * D * 2 <= WS_Q, "ws map");
constexpr int CW_TMO = 0, CW_BAR = 4096;

constexpr int RING_OFF = 0, RING_BYTES = 131072, LDSCTL_OFF = RING_BYTES, MISC_OFF = LDSCTL_OFF + 320, LDS_BYTES = 147456;

#define GAS __attribute__((address_space(1)))
#define LAS __attribute__((address_space(3)))
typedef unsigned short bf16;
typedef unsigned v4u __attribute__((ext_vector_type(4)));
typedef float f32x4 __attribute__((ext_vector_type(4)));
typedef short bf16x8 __attribute__((ext_vector_type(8)));
typedef GAS unsigned gu32;
typedef GAS unsigned long long gu64;
#define RLX_AGENT __ATOMIC_RELAXED, __HIP_MEMORY_SCOPE_AGENT
#define LDS_WAIT() asm volatile("s_waitcnt lgkmcnt(0)" ::: "memory")
#define VM_WAIT() asm volatile("s_waitcnt vmcnt(0)" ::: "memory")
__device__ __forceinline__ unsigned long long rt() { return __builtin_amdgcn_s_memrealtime(); }
__device__ __forceinline__ unsigned f2bf(float f) { unsigned u = __builtin_bit_cast(unsigned, f); return (u + 0x7fffu + ((u >> 16) & 1u)) >> 16; }
__device__ __forceinline__ unsigned pk2(float lo, float hi) { return f2bf(lo) | (f2bf(hi) << 16); }

#define XB_TMO      128
#define XB_XCNT(j)  (256  + 64 * (j))
#define XB_XSUB(j)  (1280 + 64 * (j))
#define XB_XGEN(j)  (2304 + 64 * (j))
#define XB_TOP      3328
#define XB_TOPGEN   3392
#define XCD_BAR_WORDS 3456
#define XB_SPIN_CAP (1u << 18)

__device__ __forceinline__ unsigned xb_ld(unsigned* p)              { return __hip_atomic_load(p, __ATOMIC_RELAXED, __HIP_MEMORY_SCOPE_AGENT); }
__device__ __forceinline__ unsigned xb_add(unsigned* p, unsigned v) { return __hip_atomic_fetch_add(p, v, __ATOMIC_RELAXED, __HIP_MEMORY_SCOPE_AGENT); }
__device__ __forceinline__ unsigned xb_xcc_id() { return (unsigned)__builtin_amdgcn_s_getreg((3 << 11) | 20) & 0xFu; }
#define XB_SPIN(cond, bar) do { unsigned _sp = 0; while (cond) { __builtin_amdgcn_s_sleep(1); \
    if ((++_sp & 255u) == 0u) { if (xb_ld(&(bar)[XB_TMO])) break; if (_sp > XB_SPIN_CAP) { atomicAdd(&(bar)[XB_TMO], 1u); break; } } } } while (0)

struct XcdBarrier {
    unsigned* bar; unsigned x;
    volatile LAS unsigned* st;
};

__device__ __forceinline__ XcdBarrier xcd_barrier_post(unsigned* bar, volatile LAS unsigned* st) {
    XcdBarrier b; b.bar = bar; b.x = xb_xcc_id(); b.st = st;
    if (threadIdx.x == 0) (void)xb_add(&bar[XB_XCNT(b.x)], 1u);
    return b;
}
__device__ __forceinline__ void xcd_barrier_complete(unsigned* bar, unsigned x, unsigned& nloc, unsigned& nx) {
    const unsigned G = gridDim.x * gridDim.y * gridDim.z;
    unsigned sum, cnt, mine, sp = 0u;
    for (;;) {
        sum = 0u; cnt = 0u; mine = 0u;
#pragma unroll
        for (unsigned j = 0; j < 16; ++j) { const unsigned c = xb_ld(&bar[XB_XCNT(j)]); sum += c; cnt += (c > 0u) ? 1u : 0u; mine = (j == x) ? c : mine; }
        if (sum == G) break;
        __builtin_amdgcn_s_sleep(1);
        if ((++sp & 255u) == 0u) { if (xb_ld(&bar[XB_TMO])) break; if (sp > XB_SPIN_CAP) { atomicAdd(&bar[XB_TMO], 1u); break; } }
    }
    nloc = mine > 0u ? mine : 1u; nx = cnt > 0u ? cnt : 1u;
}

__device__ __forceinline__ void xcd_barrier(const XcdBarrier& b) {
    asm volatile("s_waitcnt vmcnt(0)" ::: "memory");
    __syncthreads();
    if (threadIdx.x == 0) {
        unsigned* bar = b.bar;
        __builtin_amdgcn_s_waitcnt(0);
        unsigned nloc = b.st[0], nx = b.st[1];
        if (nloc == 0u) { xcd_barrier_complete(bar, b.x, nloc, nx); b.st[0] = nloc; b.st[1] = nx; }
        const unsigned old = xb_add(&bar[XB_XSUB(b.x)], 1u);
        const unsigned gen = old / nloc;
        if (old + 1u == (gen + 1u) * nloc) {
            __builtin_amdgcn_fence(__ATOMIC_RELEASE, "agent");
            asm volatile("s_waitcnt vmcnt(0)" ::: "memory");
            const unsigned og = xb_add(&bar[XB_TOP], 1u);
            const unsigned tg = og / nx;
            if (og + 1u == (tg + 1u) * nx) xb_add(&bar[XB_TOPGEN], 1u);
            else XB_SPIN(xb_ld(&bar[XB_TOPGEN]) == tg, bar);
            __builtin_amdgcn_fence(__ATOMIC_ACQUIRE, "agent");
            xb_add(&bar[XB_XGEN(b.x)], 1u);
            asm volatile("s_waitcnt vmcnt(0)" ::: "memory");
        } else {
            XB_SPIN(xb_ld(&bar[XB_XGEN(b.x)]) == gen, bar);
            __builtin_amdgcn_fence(__ATOMIC_ACQUIRE, "agent");
            asm volatile("s_waitcnt vmcnt(0)" ::: "memory");
        }
    }
    __syncthreads();
}

typedef float f32x2g __attribute__((ext_vector_type(2)));
typedef unsigned u32x2g __attribute__((ext_vector_type(2)));
__device__ __forceinline__ float fexp2g(float x) { return __builtin_amdgcn_exp2f(x); }
struct Args { const void* in[23]; float* out; unsigned char* ws; int ph_lo, ph_hi; };
struct Frame {
    LAS unsigned char* lds; volatile LAS unsigned* MISC; gu32* ctl; unsigned char* ws;
    int tid, lane, wave, G, gw, NGW;
};
#define WSP(T, off) ((T*)(F.ws + (off)))

template <int X> __device__ __forceinline__ float swz_xor(float v) { return __int_as_float(__builtin_amdgcn_ds_swizzle(__float_as_int(v), (X << 10) | 0x1f)); }
__device__ __forceinline__ float sum_xor32(float v) { auto r = __builtin_amdgcn_permlane32_swap(__float_as_uint(v), __float_as_uint(v), false, false); return __uint_as_float(r[0]) + __uint_as_float(r[1]); }
__device__ __forceinline__ float wave_sum(float v) { v += swz_xor<1>(v); v += swz_xor<2>(v); v += swz_xor<4>(v); v += swz_xor<8>(v); v += swz_xor<16>(v); return sum_xor32(v); }
__device__ __forceinline__ float lane_up(float v, int lane, int o) { return __int_as_float(__builtin_amdgcn_ds_bpermute(((lane - o) & 63) << 2, __float_as_int(v))); }
__device__ __forceinline__ float bf2f(bf16 h) { return __uint_as_float((unsigned)h << 16); }
__device__ __forceinline__ float blo(unsigned w) { return __uint_as_float(w << 16); }
__device__ __forceinline__ float bhi(unsigned w) { return __uint_as_float(w & 0xffff0000u); }

template <int MAP> __device__ __forceinline__ void cvt_item(const float* W, int K, int Nsrc, const float* kscale, bf16* WT, LAS float* scr, int item, int nblk, int lane) {
    const int kb = item / nblk, nb = item % nblk, k0 = 64 * kb, n0 = 32 * nb;
    float cs = 1.f; int sc; const int vc = n0 + (lane & 31);
    if (MAP == 0) sc = vc; else if (MAP == 1) sc = map_in(vc, cs); else if (MAP == 2) { sc = map_q(vc); cs = QSCALE; } else sc = map_kv(vc);
#pragma unroll 8
    for (int i = 0; i < 32; ++i) { const int kk = 2 * i + (lane >> 5); float v = 0.f;
        if (sc >= 0) { v = W[(size_t)(k0 + kk) * Nsrc + sc] * cs; if (kscale) v *= kscale[k0 + kk]; }
        scr[kk * 33 + (lane & 31)] = v; }
    LDS_WAIT(); asm volatile("" ::: "memory");
    const int c = lane & 7;
#pragma unroll
    for (int j = 0; j < 4; ++j) { const int n = (lane >> 3) + 8 * j; const LAS float* s = scr + (8 * c) * 33 + n;
        v4u o; o.x = pk2(s[0 * 33], s[1 * 33]); o.y = pk2(s[2 * 33], s[3 * 33]); o.z = pk2(s[4 * 33], s[5 * 33]); o.w = pk2(s[6 * 33], s[7 * 33]);
        *(GAS v4u*)(WT + (size_t)(n0 + n) * K + k0 + 8 * c) = o; }
    LDS_WAIT(); asm volatile("" ::: "memory");
}
__device__ __forceinline__ void p0_weights(Frame& F, const Args& A, int l) {
    LAS float* scr = (LAS float*)(F.lds + RING_OFF + F.wave * 16384);
    constexpr int I_IN = (1024 / 64) * (NV_IN / 32), I_G = 16 * 128, I_UQ = 4 * 24, I_UKV = 2 * 32, I_P = 8 * 32, I_O = 16 * 32;
    constexpr int NIT = I_IN + I_G + I_UQ + I_UKV + 4 * I_P + I_O;
    for (int it = F.gw; it < NIT; it += F.NGW) {
        int r = it;
        if (r < I_IN) { cvt_item<1>(((const float*)A.in[4]) + (size_t)l * 1024 * IN_DIM, 1024, IN_DIM, nullptr, WSP(bf16, WS_WB + WB_IN), scr, r, NV_IN / 32, F.lane); continue; } r -= I_IN;
        if (r < I_G) { cvt_item<0>(((const float*)A.in[5]) + (size_t)l * 1024 * 4096, 1024, 4096, nullptr, WSP(bf16, WS_WB + WB_GATE), scr, r, 128, F.lane); continue; } r -= I_G;
        if (r < I_UQ) { cvt_item<2>(((const float*)A.in[9]) + (size_t)l * 256 * 768, 256, 768, ((const float*)A.in[7]) + l * 256, WSP(bf16, WS_WB + WB_UQ), scr, r, 24, F.lane); continue; } r -= I_UQ;
        if (r < I_UKV) { cvt_item<3>(((const float*)A.in[10]) + (size_t)l * 128 * 1024, 128, 1024, ((const float*)A.in[8]) + l * 128, WSP(bf16, WS_WB + WB_UKV), scr, r, 32, F.lane); continue; } r -= I_UKV;
        if (r < 4 * I_P) { const int i = r / I_P; const float* wp = (const float*)A.in[18 + i]; cvt_item<0>(wp + (size_t)l * 512 * 1024, 512, 1024, nullptr, WSP(bf16, WS_WB + WB_P) + (size_t)i * 1024 * 512, scr, r % I_P, 32, F.lane); continue; } r -= 4 * I_P;
        cvt_item<0>(((const float*)A.in[22]) + (size_t)l * 1024 * 1024, 1024, 1024, nullptr, WSP(bf16, WS_WB + WB_OUT), scr, r, 32, F.lane);
    }
}
__device__ __forceinline__ void p0_rows(Frame& F, const Args& A, int stage) {
    for (int m = F.gw; m < M; m += F.NGW) {
        const float* xin = (stage == 2 ? A.out : ((const float*)A.in[0])) + (size_t)m * D;
        f32x4 v[4];
#pragma unroll
        for (int j = 0; j < 4; ++j) v[j] = *((const GAS f32x4*)xin + F.lane + 64 * j);
        if (stage >= 1) {
            float ss = F.lane < 16 ? WSP(float, WS_PO)[(size_t)m * 16 + F.lane] : 0.f; ss = wave_sum(ss);
            const float rs = 1.0f / sqrtf(ss * (1.f / 1024.f) + RMS_EPS); const float* gp = ((const float*)A.in[3]) + (stage - 1) * D;
#pragma unroll
            for (int j = 0; j < 4; ++j) { const u32x2g mo = *((const GAS u32x2g*)(WSP(bf16, WS_MO) + (size_t)m * D) + F.lane + 64 * j); const f32x4 g = *((const GAS f32x4*)gp + F.lane + 64 * j);
                v[j].x += blo(mo.x) * rs * g.x; v[j].y += bhi(mo.x) * rs * g.y; v[j].z += blo(mo.y) * rs * g.z; v[j].w += bhi(mo.y) * rs * g.w;
                *((GAS f32x4*)(A.out + (size_t)m * D) + F.lane + 64 * j) = v[j]; }
            if (stage == 2) continue;
        }
        float s2 = 0.f;
#pragma unroll
        for (int j = 0; j < 4; ++j) s2 += (v[j].x * v[j].x + v[j].y * v[j].y) + (v[j].z * v[j].z + v[j].w * v[j].w);
        const float rs = 1.0f / sqrtf(wave_sum(s2) * (1.f / D) + RMS_EPS); const float* gq = ((const float*)A.in[2]) + stage * D;
#pragma unroll
        for (int j = 0; j < 4; ++j) { const f32x4 g = *((const GAS f32x4*)gq + F.lane + 64 * j); u32x2g o; o.x = pk2(v[j].x * rs * g.x, v[j].y * rs * g.y); o.y = pk2(v[j].z * rs * g.z, v[j].w * rs * g.w);
            *((GAS u32x2g*)(WSP(bf16, WS_H) + (size_t)m * D) + F.lane + 64 * j) = o; }
    }
}
__device__ __forceinline__ void p0_rope(Frame& F, const Args& A) {
    const int gt = F.gw * 64 + F.lane, NT = F.NGW * 64;
    for (int i = gt; i < M * 16; i += NT) { const int row = i >> 4, j = i & 15;
        const float inv = powf(10000.0f, -(float)j * (1.f / 16.f)); const float ang = (float)((const int*)A.in[1])[row] * inv; const double ad = (double)ang; const float r = (float)(ad - rint(ad * 0.15915494309189535) * 6.283185307179586); const float s = sinf(r), c = cosf(r);
        f32x2g o; o.x = c; o.y = s; *(GAS f32x2g*)(WSP(float, WS_ROPE) + (size_t)i * 2) = o; }
}
__device__ __forceinline__ void p2_conv(Frame& F, const Args& A, int l) {
    const int gt = F.gw * 64 + F.lane, NT = F.NGW * 64; const float* wc = ((const float*)A.in[13]) + l * 3 * 512; const float* bc = ((const float*)A.in[14]) + l * 512;
    for (int i = gt; i < M * 64; i += NT) { const int row = i >> 6, c0 = (i & 63) * 8, t = row & (SEQ - 1);
        const v4u u2 = *(const GAS v4u*)(WSP(bf16, WS_ZT) + (size_t)row * ZT_LD + ZT_U + c0); v4u u1 = {0u, 0u, 0u, 0u}, u0 = {0u, 0u, 0u, 0u};
        if (t >= 1) u1 = *(const GAS v4u*)(WSP(bf16, WS_ZT) + (size_t)(row - 1) * ZT_LD + ZT_U + c0);
        if (t >= 2) u0 = *(const GAS v4u*)(WSP(bf16, WS_ZT) + (size_t)(row - 2) * ZT_LD + ZT_U + c0);
        GAS v4u* gp = (GAS v4u*)(WSP(bf16, WS_ZY) + (size_t)row * ZY_LD + YC + c0); const v4u g = *gp; v4u o;
#pragma unroll
        for (int q = 0; q < 4; ++q) { const int c = c0 + 2 * q;
            const float ylo = wc[c] * blo(u0[q]) + wc[512 + c] * blo(u1[q]) + wc[1024 + c] * blo(u2[q]) + bc[c];
            const float yhi = wc[c + 1] * bhi(u0[q]) + wc[512 + c + 1] * bhi(u1[q]) + wc[1024 + c + 1] * bhi(u2[q]) + bc[c + 1];
            o[q] = pk2(blo(g[q]) * ylo, bhi(g[q]) * yhi); }
        *gp = o; }
}
__device__ __forceinline__ float logsig(float x) { return fminf(x, 0.f) - log1pf(expf(-fabsf(x))); }
__device__ __forceinline__ void p2_mscan(Frame& F, const Args& A, int l) {
    if (F.gw >= 32) return;
    const int b = F.gw >> 2, h = F.gw & 3, lane = F.lane; const float fb = ((const float*)A.in[11])[l * 4 + h];
    const size_t r0 = (size_t)b * SEQ + lane * 64;
    float ls = 0.f;
    for (int i = 0; i < 64; ++i) ls += logsig(WSP(float, WS_GIF)[(r0 + i) * 8 + 4 + h] + fb);
    float incl = ls;
#pragma unroll
    for (int o = 1; o < 64; o <<= 1) { const float t = lane_up(incl, lane, o); if (lane >= o) incl += t; }
    const float Boff = incl - ls;
    float B = Boff, lm = -INFINITY;
    for (int i = 0; i < 64; ++i) { B += logsig(WSP(float, WS_GIF)[(r0 + i) * 8 + 4 + h] + fb); lm = fmaxf(lm, WSP(float, WS_GIF)[(r0 + i) * 8 + h] - B); }
    float im = lm;
#pragma unroll
    for (int o = 1; o < 64; o <<= 1) { const float t = lane_up(im, lane, o); if (lane >= o) im = fmaxf(im, t); }
    float run = lane_up(im, lane, 1); if (lane == 0) run = -INFINITY; run = fmaxf(run, 0.f);
    B = Boff;
    for (int i = 0; i < 64; ++i) { B += logsig(WSP(float, WS_GIF)[(r0 + i) * 8 + 4 + h] + fb); const float ap = WSP(float, WS_GIF)[(r0 + i) * 8 + h] - B; run = fmaxf(run, ap);
        f32x4 o; o.x = ap; o.y = run; o.z = B + run; o.w = 0.f; *(GAS f32x4*)(WSP(float, WS_MLS) + ((r0 + i) * 4 + h) * 4) = o; }
}
#if MK_NAIVE_SGU
__device__ __forceinline__ void p2_sgu_naive(Frame& F, const Args& A, int l) {
    LAS f32x2g* st = (LAS f32x2g*)(F.lds + RING_OFF);
    const int c = F.tid & 127, tq = F.tid >> 7;
    for (int u = blockIdx.x; u < 1024; u += F.G) { const int g = u & 3, bn = u >> 2; const size_t base = (size_t)bn * 128;
        if (F.tid < 128) { float s1 = 0.f, s2 = 0.f;
            for (int k = 0; k < 8; ++k) { const f32x2g p = *(const GAS f32x2g*)(WSP(float, WS_PVS) + ((base + F.tid) * 8 + k) * 2); s1 += p.x; s2 += p.y; }
            const float mean = s1 * (1.f / 512.f), var = fmaxf(s2 * (1.f / 512.f) - mean * mean, 0.f); f32x2g o; o.x = mean; o.y = 1.0f / sqrtf(var + RMS_EPS); st[F.tid] = o; }
        __syncthreads();
        const float* W = ((const float*)A.in[16]) + ((size_t)l * 4 + g) * 128 * 128;
        float acc[32];
#pragma unroll
        for (int i = 0; i < 32; ++i) acc[i] = 0.f;
        for (int s = 0; s < 128; ++s) { const f32x2g ms = st[s]; const float vn = (bf2f(WSP(bf16, WS_ZT)[(base + s) * ZT_LD + ZT_V + g * 128 + c]) - ms.x) * ms.y;
#pragma unroll
            for (int i = 0; i < 32; ++i) { const int tt = tq + 4 * i; if (tt >= s) acc[i] += W[tt * 128 + s] * vn; } }
        const float gs = ((const float*)A.in[15])[l * 512 + g * 128 + c];
#pragma unroll
        for (int i = 0; i < 32; ++i) { const int tt = tq + 4 * i; GAS bf16* p = (GAS bf16*)(WSP(bf16, WS_ZY) + (base + tt) * ZY_LD + YD + g * 128 + c);
            const float mixed = acc[i] * gs + ((const float*)A.in[17])[(l * 4 + g) * 128 + tt]; *p = (bf16)f2bf(bf2f(*p) * mixed); }
        __syncthreads();
    }
}
#endif
#if MK_NAIVE_ATTN
__device__ __forceinline__ void p3_attn_naive(Frame& F, const Args& A) {
    const int lane = F.lane;
    for (int pass = 0; pass < 2; ++pass) { const int u = pass == 0 ? F.gw : 4095 - F.gw; if (F.gw >= 2048) break;
        const int c = u & 63, h = (u >> 6) & 7, b = u >> 9; const size_t row = (size_t)b * SEQ + c * 64 + lane;
        v4u q[12];
#pragma unroll
        for (int i = 0; i < 12; ++i) q[i] = *(const GAS v4u*)(WSP(bf16, WS_Q) + row * 768 + h * 96 + 8 * i);
        float o[64];
#pragma unroll
        for (int i = 0; i < 64; ++i) o[i] = 0.f;
        float mx = -1e30f, lsum = 0.f; const int nk = 64 * (c + 1);
        for (int k0 = 0; k0 < nk; ++k0) { const size_t kr = (size_t)b * SEQ + k0; float a = 0.f;
#pragma unroll
            for (int i = 0; i < 8; ++i) { const v4u w = *(const GAS v4u*)(WSP(bf16, WS_KN) + kr * 512 + h * 64 + 8 * i);
#pragma unroll
                for (int k = 0; k < 4; ++k) a += blo(q[i][k]) * blo(w[k]) + bhi(q[i][k]) * bhi(w[k]); }
#pragma unroll
            for (int i = 0; i < 4; ++i) { const v4u w = *(const GAS v4u*)(WSP(bf16, WS_KR) + kr * 32 + 8 * i);
#pragma unroll
                for (int k = 0; k < 4; ++k) a += blo(q[8 + i][k]) * blo(w[k]) + bhi(q[8 + i][k]) * bhi(w[k]); }
            if (__any(a > mx)) { const float mn = fmaxf(a, mx), al = fexp2g(mx - mn); mx = mn; lsum *= al;
#pragma unroll
                for (int i = 0; i < 64; ++i) o[i] *= al; }
            const float p = fexp2g(a - mx); lsum += p;
#pragma unroll
            for (int i = 0; i < 8; ++i) { const v4u w = *(const GAS v4u*)(WSP(bf16, WS_V) + kr * 512 + h * 64 + 8 * i);
#pragma unroll
                for (int k = 0; k < 4; ++k) { o[8 * i + 2 * k] += p * blo(w[k]); o[8 * i + 2 * k + 1] += p * bhi(w[k]); } }
        }
        const float rl = 1.0f / lsum; GAS v4u* yp = (GAS v4u*)(WSP(bf16, WS_ZY) + row * ZY_LD + YA + h * 64);
#pragma unroll
        for (int i = 0; i < 8; ++i) { const v4u g = yp[i]; v4u w;
#pragma unroll
            for (int k = 0; k < 4; ++k) w[k] = pk2(o[8 * i + 2 * k] * rl * blo(g[k]), o[8 * i + 2 * k + 1] * rl * bhi(g[k]));
            yp[i] = w; }
    }
}
#endif
#if MK_NAIVE_MLSTM
__device__ __forceinline__ void p3_mlstm_naive(Frame& F, const Args& A, int l) {
    const int lane = F.lane, hf = lane >> 5;
    for (int pass = 0; pass < 2; ++pass) { const int u = pass == 0 ? F.gw : 4095 - F.gw; if (F.gw >= 2048) break;
        const int w = u & 127, h = (u >> 7) & 3, b = u >> 9; const int t = w * 32 + (lane & 31); const size_t row = (size_t)b * SEQ + t;
        v4u q[8];
#pragma unroll
        for (int i = 0; i < 8; ++i) q[i] = *(const GAS v4u*)(WSP(bf16, WS_ZT) + row * ZT_LD + ZT_MQ + h * 64 + 8 * i);
        float acc[64];
#pragma unroll
        for (int i = 0; i < 64; ++i) acc[i] = 0.f;
        const f32x4 me = *(const GAS f32x4*)(WSP(float, WS_MLS) + (row * 4 + h) * 4); const float At = me.y, mt = me.z; float den = 0.f;
        const int nk = 32 * (w + 1);
        for (int s = 0; s < nk; ++s) { const size_t sr = (size_t)b * SEQ + s; float dot = 0.f;
#pragma unroll
            for (int i = 0; i < 8; ++i) { const v4u x = *(const GAS v4u*)(WSP(bf16, WS_ZT) + sr * ZT_LD + ZT_MK + h * 64 + 8 * i);
#pragma unroll
                for (int k = 0; k < 4; ++k) dot += blo(q[i][k]) * blo(x[k]) + bhi(q[i][k]) * bhi(x[k]); }
            const float ap = WSP(float, WS_MLS)[(sr * 4 + h) * 4]; const float p = s <= t ? dot * fexp2g((ap - At) * 1.4426950409f) : 0.f; den += p;
#pragma unroll
            for (int i = 0; i < 8; ++i) { const v4u x = *(const GAS v4u*)(WSP(bf16, WS_ZT) + sr * ZT_LD + ZT_MV + h * 128 + hf * 64 + 8 * i);
#pragma unroll
                for (int k = 0; k < 4; ++k) { acc[8 * i + 2 * k] += p * blo(x[k]); acc[8 * i + 2 * k + 1] += p * bhi(x[k]); } } }
        const float rd = 1.0f / fmaxf(fabsf(den), fexp2g(-mt * 1.4426950409f)); float ss = 0.f;
#pragma unroll
        for (int i = 0; i < 64; ++i) ss += acc[i] * acc[i];
        ss = sum_xor32(ss);
        const float rn = rd * __builtin_amdgcn_rsqf(rd * rd * ss * (1.f / 128.f) + RMS_EPS);
        const float* gm = ((const float*)A.in[12]) + l * 512 + h * 128 + hf * 64;
        GAS v4u* yp = (GAS v4u*)(WSP(bf16, WS_ZY) + row * ZY_LD + YB + h * 128 + hf * 64);
#pragma unroll
        for (int i = 0; i < 8; ++i) { const v4u g = yp[i]; v4u o;
#pragma unroll
            for (int k = 0; k < 4; ++k) o[k] = pk2(acc[8 * i + 2 * k] * rn * gm[8 * i + 2 * k] * blo(g[k]), acc[8 * i + 2 * k + 1] * rn * gm[8 * i + 2 * k + 1] * bhi(g[k]));
            yp[i] = o; }
    }
}
#endif

__global__ void __launch_bounds__(NTHREADS, 2) mk_fwd(Args args) {
    extern __shared__ __attribute__((aligned(16))) unsigned char lds[];
    Frame F;
    F.lds = (LAS unsigned char*)lds; F.MISC = (volatile LAS unsigned*)(F.lds + MISC_OFF);
    F.tid = threadIdx.x; F.lane = F.tid & 63; F.wave = __builtin_amdgcn_readfirstlane(F.tid >> 6); F.G = gridDim.x; F.gw = blockIdx.x * NWAVES + F.wave; F.NGW = F.G * NWAVES;
    F.ws = args.ws; F.ctl = (gu32*)(F.ws + WS_CTL);
    const Args& A = args;
    for (int u = F.tid; u < (LDS_BYTES - LDSCTL_OFF) / 4; u += NTHREADS) ((LAS unsigned*)(F.lds + LDSCTL_OFF))[u] = 0u;
    __syncthreads();
    const int lo = args.ph_lo, hi = args.ph_hi;
    XcdBarrier bar; bar.bar = (unsigned*)(F.ctl + CW_BAR); bar.x = 0; bar.st = nullptr;
    if (hi - lo > 1) bar = xcd_barrier_post((unsigned*)(F.ctl + CW_BAR), F.MISC + 8);
#define IN(k) (lo <= (k) && (k) < hi)
#define FRESH() do { int z_ = 0; asm volatile("" : "+v"(z_)); F.ws = args.ws + __builtin_amdgcn_readfirstlane(z_); int t_ = threadIdx.x; asm volatile("" : "+v"(t_)); F.tid = t_; F.lane = t_ & 63; \
        F.wave = __builtin_amdgcn_readfirstlane(t_ >> 6); F.gw = blockIdx.x * NWAVES + F.wave; } while (0)
#define SEAM(k) do { if (IN(k) && IN((k) + 1)) xcd_barrier(bar); } while (0)
    typedef pg8::StaticOrder SO;
#define LAYER(l) do { \
        const int pb = 6 * l; \
        if (IN(pb + 0)) { FRESH(); if (l == 0) p0_rope(F, args); FRESH(); p0_rows(F, args, l); FRESH(); p0_weights(F, args, l); } \
        SEAM(pb + 0); \
        if (IN(pb + 1)) { FRESH(); \
            pg8::Gemm g{WSP(bf16, WS_H), WSP(bf16, WS_WB + WB_IN), M, NV_IN, 1024, 1024}; SO S; S.init(M, NV_IN, F.G, (int)blockIdx.x); \
            pg8::EpiIn E{WSP(bf16, WS_ZT), WSP(bf16, WS_ZY), WSP(bf16, WS_KR), WSP(float, WS_PQ), WSP(float, WS_PKV), WSP(float, WS_PVS), WSP(float, WS_GIF), WSP(float, WS_ROPE)}; \
            pg8::gemm_phase<pg8::EpiIn, SO, true, true>(F.lds + RING_OFF, g, S, E); \
        } \
        SEAM(pb + 1); \
        if (IN(pb + 2)) { FRESH(); \
            { pg8::Gemm g{WSP(bf16, WS_ZT) + ZT_CQ, WSP(bf16, WS_WB + WB_UQ), M, 768, 256, ZT_LD}; SO S; S.init(M, 768, F.G, (int)blockIdx.x); pg8::EpiUpQ E{WSP(bf16, WS_Q), WSP(float, WS_PQ), WSP(float, WS_ROPE)}; \
              pg8::gemm_phase<pg8::EpiUpQ, SO, true, true>(F.lds + RING_OFF, g, S, E); } \
            FRESH(); \
            { pg8::Gemm g{WSP(bf16, WS_ZT) + ZT_CKV, WSP(bf16, WS_WB + WB_UKV), M, 1024, 128, ZT_LD}; SO S; S.init(M, 1024, F.G, (int)blockIdx.x); pg8::EpiUpKV E{WSP(bf16, WS_KN), WSP(bf16, WS_V), WSP(float, WS_PKV)}; \
              pg8::gemm_phase<pg8::EpiUpKV, SO, true, true>(F.lds + RING_OFF, g, S, E); } \
            __syncthreads(); FRESH(); \
            p2_mscan(F, args, l); FRESH(); \
            p2_conv(F, args, l); FRESH(); \
            p2_sgu_naive(F, args, l); \
        } \
        SEAM(pb + 2); \
        if (IN(pb + 3)) { FRESH(); p3_attn_naive(F, args); FRESH(); p3_mlstm_naive(F, args, l); } \
        SEAM(pb + 3); \
        if (IN(pb + 4)) { FRESH(); \
_Pragma("unroll 1") \
            for (int i = 0; i < 4; ++i) { FRESH(); \
                { pg8::Gemm g{WSP(bf16, WS_H), WSP(bf16, WS_WB + WB_GATE) + (size_t)i * 1024 * 1024, M, 1024, 1024, 1024}; SO S; S.init(M, 1024, F.G, (int)blockIdx.x); pg8::EpiGate E{WSP(bf16, WS_S), ((const float*)A.in[6]) + l * 4096 + i * 1024}; \
                  pg8::gemm_phase<pg8::EpiGate, SO, true, true>(F.lds + RING_OFF, g, S, E); } \
                FRESH(); \
                { pg8::Gemm g{WSP(bf16, WS_ZY) + 512 * i, WSP(bf16, WS_WB + WB_P) + (size_t)i * 1024 * 512, M, 1024, 512, ZY_LD}; SO S; S.init(M, 1024, F.G, (int)blockIdx.x); pg8::EpiProj E{WSP(bf16, WS_S), WSP(bf16, WS_MG), i == 0}; \
                  pg8::gemm_phase<pg8::EpiProj, SO, true, true>(F.lds + RING_OFF, g, S, E); } \
            } \
        } \
        SEAM(pb + 4); \
        if (IN(pb + 5)) { FRESH(); \
            pg8::Gemm g{WSP(bf16, WS_MG), WSP(bf16, WS_WB + WB_OUT), M, 1024, 1024, 1024}; SO S; S.init(M, 1024, F.G, (int)blockIdx.x); pg8::EpiOut E{WSP(bf16, WS_MO), WSP(float, WS_PO)}; \
            pg8::gemm_phase<pg8::EpiOut, SO, true, true>(F.lds + RING_OFF, g, S, E); \
        } \
        SEAM(pb + 5); \
    } while (0)
    LAYER(0);
    LAYER(1);
#undef LAYER
    if (IN(12)) { FRESH(); p0_rows(F, args, 2); }
#undef IN
#undef SEAM
}

extern "C" void kernel_launch(void* const* d_in, const int* in_sizes, int n_in, void* d_out, int out_size, void* d_ws, size_t ws_size, hipStream_t stream) {
    static int grid = 0;
    if (grid == 0) {
        if (n_in != 23 || in_sizes[0] != M * D || out_size != M * D || ws_size < WS_END) { fprintf(stderr, "kernel_launch: unexpected shapes (n_in %d, in0 %d, out %d, ws %zu < %zu)\n", n_in, n_in > 0 ? in_sizes[0] : -1, out_size, ws_size, (size_t)WS_END); grid = -1; return; }
        int dev = 0, cus = 0, per_cu = 0;
        if (hipGetDevice(&dev) != hipSuccess || hipDeviceGetAttribute(&cus, hipDeviceAttributeMultiprocessorCount, dev) != hipSuccess) { grid = -1; return; }
        if (hipFuncSetAttribute((const void*)mk_fwd, hipFuncAttributeMaxDynamicSharedMemorySize, LDS_BYTES) != hipSuccess) { fprintf(stderr, "kernel_launch: hipFuncSetAttribute failed\n"); grid = -1; return; }
        if (hipOccupancyMaxActiveBlocksPerMultiprocessor(&per_cu, (const void*)mk_fwd, NTHREADS, LDS_BYTES) != hipSuccess || per_cu < 1) fprintf(stderr, "kernel_launch: occupancy query reports %d\n", per_cu);
        (void)hipGetLastError();
        grid = cus;
    }
    if (grid < 0) return;
    if (hipMemsetAsync((char*)d_ws + WS_CTL, 0, CTL_ZERO_BYTES, stream) != hipSuccess) return;
    Args a{};
    for (int i = 0; i < 23; ++i) a.in[i] = d_in[i];
    a.out = (float*)d_out; a.ws = (unsigned char*)d_ws;
#if MK_ONE_LAUNCH
    a.ph_lo = 0; a.ph_hi = N_PHASES;
    hipLaunchKernelGGL(mk_fwd, dim3(grid), dim3(NTHREADS), LDS_BYTES, stream, a);
#else
    for (int p = 0; p < N_PHASES; ++p) { a.ph_lo = p; a.ph_hi = p + 1; hipLaunchKernelGGL(mk_fwd, dim3(grid), dim3(NTHREADS), LDS_BYTES, stream, a); }
#endif
    const hipError_t le = hipPeekAtLastError();
    if (le != hipSuccess) fprintf(stderr, "kernel_launch: launch failed: %s\n", hipGetErrorName(le));
}
```

```cpp
#include <hip/hip_runtime.h>
#include <cstdio>
#include <cstdint>
#include <cmath>
constexpr int ZT_LD = 2432, ZT_CQ = 0, ZT_CKV = 256, ZT_MQ = 384, ZT_MK = 640, ZT_MV = 896, ZT_U = 1408, ZT_V = 1920;
constexpr int H_LD = 3072, ZY_LD = 3072, YA = 0, YB = 512, YC = 1024, YD = 1536;
constexpr float RMS_EPS = 1e-6f;
#ifndef MK_KI0
#define MK_KI0 512
#endif
#ifndef MK_KI1
#define MK_KI1 1024
#endif
constexpr int ki8_of(int l) { return l == 0 ? MK_KI0 : MK_KI1; }
namespace pg8 {
#define PG8_LAS __attribute__((address_space(3)))
typedef unsigned short bf16_t;
typedef short bf16x8 __attribute__((ext_vector_type(8)));
typedef float f32x4 __attribute__((ext_vector_type(4)));
typedef int i32x4 __attribute__((ext_vector_type(4)));
typedef unsigned u32x4 __attribute__((ext_vector_type(4)));
constexpr int BM = 256, BK = 64, HALF = 128, HTB = HALF * BK * 2  , STAGE_BYTES = 8 * HTB, NXCD = 8, WGM = 8;

__host__ __device__ __forceinline__ int lds_byte(int r, int c) { const int st = (r >> 4) * 2 + (c >> 5), rr = r & 15, cc = c & 31, ob = rr * 64 + cc * 2; return st * 1024 + (ob ^ (((ob >> 9) & 1) << 5)); }
__host__ __device__ __forceinline__ void stage_rc(int b, int& R, int& C) { const int st = b / 1024, sb = b % 1024, swz = sb ^ (((sb >> 9) & 1) << 5); R = (st >> 1) * 16 + swz / 64; C = (st & 1) * 32 + (swz % 64) / 2; }
__host__ __device__ __forceinline__ int perm32(int rho) { const int n = rho >> 4, i = rho & 15; return 8 * (i >> 2) + 4 * n + (i & 3); }

struct Unit { int pm, pn, nt, br, kind; unsigned aoff, boff; };
struct Gemm { const bf16_t* A; const bf16_t* Bt; int M, N, K, lda; };

struct StaticOrder {
    int nM, nN, nwg, G, c, nt; unsigned a0;
    __host__ __device__ __forceinline__ void init(int M, int N, int G_, int c_, int K_, unsigned a0_ = 0u) { nM = M / BM; nN = N / BM; nwg = nM * nN; G = G_; c = c_; nt = K_ / BK; a0 = a0_; }
    __host__ __device__ __forceinline__ bool next(int i, Unit& u) const {
        const long L = (long)i * G + c; if (L >= nwg) return false;
        int wgid = (int)L; { const int q = nwg / NXCD, r = nwg % NXCD, xcd = wgid % NXCD, off = wgid / NXCD; wgid = (xcd < r ? xcd * (q + 1) : r * (q + 1) + (xcd - r) * q) + off; }
        const int nig = WGM * nN, gid = wgid / nig, fm = gid * WGM, gsz = (nM - fm) < WGM ? (nM - fm) : WGM;
        u.pm = fm + ((wgid % nig) % gsz); u.pn = (wgid % nig) / gsz; u.nt = nt; u.br = 0; u.kind = 0; u.aoff = a0; u.boff = 0u; return true;
    }
    __device__ __forceinline__ void a_ready(const Unit&) const {}
    __device__ __forceinline__ void done(const Unit&) const {}
};

typedef __bf16 bf16x2_t __attribute__((ext_vector_type(2)));
__device__ __forceinline__ unsigned cvt_pk_bf16(float lo, float hi) { typedef float f32x2_t __attribute__((ext_vector_type(2))); f32x2_t v = {lo, hi}; bf16x2_t b = __builtin_convertvector(v, bf16x2_t); return __builtin_bit_cast(unsigned, b); }
typedef float f32x2 __attribute__((ext_vector_type(2)));
typedef unsigned u32x2 __attribute__((ext_vector_type(2)));
__device__ __forceinline__ float fexp2(float x) { return __builtin_amdgcn_exp2f(x); }
__device__ __forceinline__ float frcp(float x) { return __builtin_amdgcn_rcpf(x); }
__device__ __forceinline__ float sigm(float x) { return frcp(1.f + fexp2(-1.4426950409f * x)); }
__device__ __forceinline__ float silu(float x) { return x * sigm(x); }
__device__ __forceinline__ float gelu_t(float x) { const float u = x + 0.044715f * x * x * x; return x * frcp(1.f + fexp2(-2.302208198f * u)); }
__device__ __forceinline__ float bflo(unsigned w) { return __uint_as_float(w << 16); }
__device__ __forceinline__ float bfhi(unsigned w) { return __uint_as_float(w & 0xffff0000u); }
__device__ __forceinline__ u32x4 pack8(const float (&o)[8]) { u32x4 w; w.x = cvt_pk_bf16(o[0], o[1]); w.y = cvt_pk_bf16(o[2], o[3]); w.z = cvt_pk_bf16(o[4], o[5]); w.w = cvt_pk_bf16(o[6], o[7]); return w; }
__device__ __forceinline__ void st_nt(u32x4* p, u32x4 v) { __builtin_nontemporal_store(v, p); }
__device__ __forceinline__ float quad_sum(float s) {
    s += __int_as_float(__builtin_amdgcn_ds_swizzle(__float_as_int(s), (16 << 10) | 0x1f)); auto r = __builtin_amdgcn_permlane32_swap(__float_as_uint(s), __float_as_uint(s), false, false); return __uint_as_float(r[0]) + __uint_as_float(r[1]); }

template <int KI8> struct EpiIn {
    static constexpr bool PERM = true, AFTER_DRAIN = false, HAS_MID = false, HAS_I8 = true;
    static constexpr int SPLIT_T = KI8 / 128;
    bf16_t* ZT; bf16_t* ZY; bf16_t* KR; float* PQ; float* PKV; float* PVS; float* GIF; const float* ROPE; const float* rdq; const float* cdq;
    __device__ __forceinline__ void dequant(f32x4 (&acc)[2][2][4][2], const Unit& u, int wr, int wc, int fr_, int fq_) const {
        int fr = fr_, fq = fq_; asm volatile("" : "+v"(fr), "+v"(fq));
        const int row0 = u.pm * BM + wr * 64 + fr; const float* cp = cdq + u.pn * 256 + wc * 32 + 8 * fq;
        float rq[8];
#pragma unroll
        for (int g = 0; g < 8; ++g) rq[g] = rdq[row0 + (g >> 2) * HALF + (g & 3) * 16];
#pragma unroll
        for (int bj = 0; bj < 2; ++bj) { const f32x4 c0 = *(const f32x4*)(cp + bj * HALF), c1 = *(const f32x4*)(cp + bj * HALF + 4);
#pragma unroll
            for (int ai = 0; ai < 2; ++ai)
#pragma unroll
                for (int m = 0; m < 4; ++m)
#pragma unroll
                    for (int e = 0; e < 8; ++e) acc[ai][bj][m][e >> 2][e & 3] = (float)__float_as_int(acc[ai][bj][m][e >> 2][e & 3]) * rq[ai * 4 + m] * (e < 4 ? c0[e & 3] : c1[e & 3]); }
    }
    template <int KIND> __device__ __forceinline__ void pair_tile(const f32x4 (&acc)[2][2][4][2], bf16_t* dst, int ld, int row0, int c0) const {
#pragma unroll
        for (int ai = 0; ai < 2; ++ai)
#pragma unroll
            for (int m = 0; m < 4; ++m) { const size_t row = (size_t)(row0 + ai * HALF + m * 16); float o[8];
#pragma unroll
                for (int e = 0; e < 8; ++e) { const float a = acc[ai][0][m][e >> 2][e & 3], b = acc[ai][1][m][e >> 2][e & 3];
                    o[e] = KIND == 0 ? b * frcp((1.f + fexp2(-1.4426950409f * a)) * (1.f + fexp2(-1.4426950409f * b)))
                         : KIND == 1 ? a * b : KIND == 2 ? a * silu(b)
                         : a * b * frcp((1.f + fexp2(-2.302208198f * (a + 0.044715f * a * a * a))) * (1.f + fexp2(-1.4426950409f * b))); }
                st_nt((u32x4*)(dst + row * ld + c0), pack8(o)); }
    }
    template <int ACT, int ST> __device__ __forceinline__ void plain_tile(const f32x4 (&acc)[2][2][4][2], bf16_t* dst, int ld, int row0, int cw, int t, int wc, int fq) const {
#pragma unroll
        for (int ai = 0; ai < 2; ++ai)
#pragma unroll
            for (int m = 0; m < 4; ++m) { const size_t row = (size_t)(row0 + ai * HALF + m * 16); float s1 = 0.f, s2 = 0.f;
#pragma unroll
                for (int bj = 0; bj < 2; ++bj) { float o[8];
#pragma unroll
                    for (int e = 0; e < 8; ++e) { float v = acc[ai][bj][m][e >> 2][e & 3]; v = ACT == 1 ? silu(v) : ACT == 2 ? gelu_t(v) : v; o[e] = v; if (ST == 2) s1 += v; if (ST) s2 += v * v; }
                    st_nt((u32x4*)(dst + row * ld + bj * HALF + cw), pack8(o)); }
                if (ST == 1) { s2 = quad_sum(s2); if (fq == 0) PQ[row * 4 + wc] = s2; }
                if (ST == 2) { s1 = quad_sum(s1); s2 = quad_sum(s2); if (fq == 0) { f32x2 p; p.x = s1; p.y = s2; *(f32x2*)(PVS + (row * 8 + (t - 24) * 4 + wc) * 2) = p; } } }
    }
    __device__ __forceinline__ void operator()(const f32x4 (&acc)[2][2][4][2], const Unit& u, int wr, int wc, int fr_, int fq_) const {
        int fr = fr_, fq = fq_; asm volatile("" : "+v"(fr), "+v"(fq));
        const int t = u.pn, row0 = u.pm * BM + wr * 64 + fr, cw = wc * 32 + 8 * fq;
        if (t >= 8 && t < 24) {
            const int kind = (t - 8) >> 2, c0 = ((t - 8) & 3) * 128 + cw;
            if (kind == 0) pair_tile<0>(acc, ZY + YB, ZY_LD, row0, c0); else if (kind == 1) pair_tile<1>(acc, ZT + ZT_U, ZT_LD, row0, c0);
            else if (kind == 2) pair_tile<2>(acc, ZY + YC, ZY_LD, row0, c0); else pair_tile<3>(acc, ZY + YD, ZY_LD, row0, c0);
            return;
        }
        if (t == 1) {
#pragma unroll
            for (int ai = 0; ai < 2; ++ai)
#pragma unroll
                for (int m = 0; m < 4; ++m) { const size_t row = (size_t)(row0 + ai * HALF + m * 16); float o[8]; float ss = 0.f;
#pragma unroll
                    for (int e = 0; e < 8; ++e) { o[e] = acc[ai][0][m][e >> 2][e & 3]; ss += o[e] * o[e]; }
                    st_nt((u32x4*)(ZT + row * ZT_LD + ZT_CKV + cw), pack8(o));
                    ss = quad_sum(ss); if (fq == 0) PKV[row * 4 + wc] = ss;
                    if (wc == 0) { const f32x4 t1 = acc[ai][1][m][0], t2 = acc[ai][1][m][1];
                        const f32x4 cs0 = *(const f32x4*)(ROPE + row * 32 + 8 * fq), cs1 = *(const f32x4*)(ROPE + row * 32 + 8 * fq + 4);
                        const float c[4] = {cs0[0], cs0[2], cs1[0], cs1[2]}, s[4] = {cs0[1], cs0[3], cs1[1], cs1[3]};
                        u32x2 w1, w2; w1.x = cvt_pk_bf16(t1[0] * c[0] - t2[0] * s[0], t1[1] * c[1] - t2[1] * s[1]); w1.y = cvt_pk_bf16(t1[2] * c[2] - t2[2] * s[2], t1[3] * c[3] - t2[3] * s[3]);
                        w2.x = cvt_pk_bf16(t1[0] * s[0] + t2[0] * c[0], t1[1] * s[1] + t2[1] * c[1]); w2.y = cvt_pk_bf16(t1[2] * s[2] + t2[2] * c[2], t1[3] * s[3] + t2[3] * c[3]);
                        *(u32x2*)(KR + row * 32 + 4 * fq) = w1; *(u32x2*)(KR + row * 32 + 16 + 4 * fq) = w2; }
                    if (wc == 1 && fq == 0) { *(f32x4*)(GIF + row * 8) = acc[ai][1][m][0]; *(f32x4*)(GIF + row * 8 + 4) = acc[ai][1][m][1]; } }
            return;
        }
        if (t == 0) plain_tile<0, 1>(acc, ZT + ZT_CQ, ZT_LD, row0, cw, t, wc, fq);
        else if (t < 4) plain_tile<1, 0>(acc, ZY + YA + (t - 2) * 256, ZY_LD, row0, cw, t, wc, fq);
        else if (t < 8) plain_tile<0, 0>(acc, ZT + (t == 4 ? ZT_MQ : t == 5 ? ZT_MK : ZT_MV + (t - 6) * 256), ZT_LD, row0, cw, t, wc, fq);
        else plain_tile<2, 2>(acc, ZT + ZT_V + (t - 24) * 256, ZT_LD, row0, cw, t, wc, fq);
    }
};
struct EpiUpQ {
    static constexpr bool PERM = true, AFTER_DRAIN = false, HAS_MID = false, HAS_I8 = false; static constexpr int SPLIT_T = 0;
    bf16_t* Q; const float* PQ; const float* ROPE;
    __device__ __forceinline__ void operator()(const f32x4 (&acc)[2][2][4][2], const Unit& u, int wr, int wc, int fr_, int fq_) const {
        int fr = fr_, fq = fq_; asm volatile("" : "+v"(fr), "+v"(fq));
        const int t = u.pn, row0 = u.pm * BM + wr * 64 + fr;
        float rsv[8];
#pragma unroll
        for (int g = 0; g < 8; ++g) { const f32x4 pq = *(const f32x4*)(PQ + (size_t)(row0 + (g >> 2) * HALF + (g & 3) * 16) * 4); rsv[g] = __builtin_amdgcn_rsqf(((pq[0] + pq[1]) + (pq[2] + pq[3])) * (1.f / 256.f) + RMS_EPS); }
#pragma unroll
        for (int ai = 0; ai < 2; ++ai)
#pragma unroll
            for (int m = 0; m < 4; ++m) { const size_t row = (size_t)(row0 + ai * HALF + m * 16);
                const float rs = rsv[ai * 4 + m];
                if (t < 2) {
#pragma unroll
                    for (int bj = 0; bj < 2; ++bj) { float o[8];
#pragma unroll
                        for (int e = 0; e < 8; ++e) o[e] = acc[ai][bj][m][e >> 2][e & 3] * rs;
                        *(u32x4*)(Q + row * 768 + (4 * t + 2 * bj + (wc >> 1)) * 96 + (wc & 1) * 32 + 8 * fq) = pack8(o); }
                } else {
                    const int head = 2 * wc + (fq >> 1), j0 = 8 * (fq & 1);
#pragma unroll
                    for (int n = 0; n < 2; ++n) { const int j = j0 + 4 * n;
                        const f32x4 ca = *(const f32x4*)(ROPE + row * 32 + 2 * j), cb = *(const f32x4*)(ROPE + row * 32 + 2 * j + 4);
                        const f32x4 t1 = acc[ai][0][m][n] * rs, t2 = acc[ai][1][m][n] * rs;
                        u32x2 w1, w2; w1.x = cvt_pk_bf16(t1[0] * ca[0] - t2[0] * ca[1], t1[1] * ca[2] - t2[1] * ca[3]); w1.y = cvt_pk_bf16(t1[2] * cb[0] - t2[2] * cb[1], t1[3] * cb[2] - t2[3] * cb[3]);
                        w2.x = cvt_pk_bf16(t1[0] * ca[1] + t2[0] * ca[0], t1[1] * ca[3] + t2[1] * ca[2]); w2.y = cvt_pk_bf16(t1[2] * cb[1] + t2[2] * cb[0], t1[3] * cb[3] + t2[3] * cb[2]);
                        *(u32x2*)(Q + row * 768 + head * 96 + 64 + j) = w1; *(u32x2*)(Q + row * 768 + head * 96 + 80 + j) = w2; }
                } }
    }
};
struct EpiUpKV {
    static constexpr bool PERM = true, AFTER_DRAIN = false, HAS_MID = false, HAS_I8 = false; static constexpr int SPLIT_T = 0;
    bf16_t* KN; bf16_t* V; const float* PKV;
    __device__ __forceinline__ void operator()(const f32x4 (&acc)[2][2][4][2], const Unit& u, int wr, int wc, int fr_, int fq_) const {
        int fr = fr_, fq = fq_; asm volatile("" : "+v"(fr), "+v"(fq));
        const int t = u.pn, row0 = u.pm * BM + wr * 64 + fr, cw = wc * 32 + 8 * fq; bf16_t* dst = (t < 2 ? KN : V) + (t & 1) * 256;
        float rsv[8];
#pragma unroll
        for (int g = 0; g < 8; ++g) { const f32x4 pq = *(const f32x4*)(PKV + (size_t)(row0 + (g >> 2) * HALF + (g & 3) * 16) * 4); rsv[g] = __builtin_amdgcn_rsqf(((pq[0] + pq[1]) + (pq[2] + pq[3])) * (1.f / 128.f) + RMS_EPS); }
#pragma unroll
        for (int ai = 0; ai < 2; ++ai)
#pragma unroll
            for (int m = 0; m < 4; ++m) { const size_t row = (size_t)(row0 + ai * HALF + m * 16);
                const float rs = rsv[ai * 4 + m];
#pragma unroll
                for (int bj = 0; bj < 2; ++bj) { float o[8];
#pragma unroll
                    for (int e = 0; e < 8; ++e) o[e] = acc[ai][bj][m][e >> 2][e & 3] * rs;
                    st_nt((u32x4*)(dst + row * 512 + bj * HALF + cw), pack8(o)); } }
    }
};
struct P4Order {
    StaticOrder base; unsigned boff_p;
    __device__ __forceinline__ void init(int M, int G_, int c_, unsigned boff_p_) { base.init(M, 1024, G_, c_, 1024); boff_p = boff_p_; }
    __device__ __forceinline__ bool next(int j, Unit& u) const {
        const int tile = j / 6, sub = j - 6 * tile;
        if (!base.next(tile, u)) return false;
        const int pair = sub >= 3, q = sub - 3 * pair; u.nt = 16;
        if (q < 2) { u.kind = 0; u.nt = 8; u.br = 2 * pair + q; u.aoff = 0u; u.boff = (unsigned)u.br * (1024u * 1024u * 2u); }
        else { u.kind = 2; u.br = 2 * pair; u.aoff = (unsigned)(1024 + 1024 * pair) * 2u; u.boff = boff_p + (unsigned)pair * (1024u * 1024u * 2u); }
        return true;
    }
    __device__ __forceinline__ void a_ready(const Unit&) const {}
    __device__ __forceinline__ void done(const Unit&) const {}
};
struct EpiP4 {
    static constexpr bool PERM = true, AFTER_DRAIN = false, HAS_MID = true, HAS_I8 = true; static constexpr int SPLIT_T = 0;
    unsigned char* S; bf16_t* MG; const float* bias; const float* rdq; const float* cdq;
    static __device__ __forceinline__ float ub(unsigned w, int i) { return (float)((w >> (8 * i)) & 0xffu); }
    static __device__ __forceinline__ void swap16(unsigned& a, unsigned& b) { auto r = __builtin_amdgcn_permlane16_swap(a, b, false, false); a = r[0]; b = r[1]; }
    static __device__ __forceinline__ u32x4 join16(u32x2 w0, u32x2 w1) { unsigned a = w0.x, b = w0.y, c = w1.x, d = w1.y; swap16(a, c); swap16(b, d); return (u32x4){a, b, c, d}; }
    static __device__ __forceinline__ void split16(u32x4 v, u32x2& w0, u32x2& w1) { unsigned a = v.x, b = v.y, c = v.z, d = v.w; swap16(a, c); swap16(b, d); w0 = (u32x2){a, b}; w1 = (u32x2){c, d}; }
    __device__ __forceinline__ void mid(f32x4 (&acc)[2][2][4][2], const Unit& u, int wr, int wc, int fr_, int fq_) const {
        int fr = fr_, fq = fq_; asm volatile("" : "+v"(fr), "+v"(fq));
        const int row0 = u.pm * BM + wr * 64 + fr, col0 = u.pn * BM + wc * 32 + 8 * fq, soff = (fq & 1) ? HALF - 8 : 0;
        const unsigned char* Sa = S; const unsigned char* Sb = S + (size_t)32768 * 1024;
        u32x4 la[8], lb[8];
#pragma unroll
        for (int g = 0; g < 8; ++g) { const size_t off_ = (size_t)(row0 + (g >> 2) * HALF + (g & 3) * 16) * 1024 + col0 + soff; la[g] = *(const u32x4*)(Sa + off_); lb[g] = *(const u32x4*)(Sb + off_); }
#pragma unroll
        for (int g = 0; g < 8; ++g) { const int ai = g >> 2, mm = g & 3; u32x2 sa[2], sb[2]; split16(la[g], sa[0], sa[1]); split16(lb[g], sb[0], sb[1]);
#pragma unroll
            for (int bj = 0; bj < 2; ++bj)
#pragma unroll
                for (int e = 0; e < 8; ++e) { const unsigned wa = e < 4 ? sa[bj].x : sa[bj].y, wb = e < 4 ? sb[bj].x : sb[bj].y;
                    acc[ai][bj][mm][e >> 2][e & 3] *= ub(wa, e & 3) * frcp(ub(wb, e & 3)); } }
    }
    __device__ __forceinline__ void operator()(const f32x4 (&acc)[2][2][4][2], const Unit& u, int wr, int wc, int fr_, int fq_) const {
        int fr = fr_, fq = fq_; asm volatile("" : "+v"(fr), "+v"(fq));
        const int row0 = u.pm * BM + wr * 64 + fr, col0 = u.pn * BM + wc * 32 + 8 * fq, soff = (fq & 1) ? HALF - 8 : 0;
        if (u.kind == 0) {
            unsigned char* Sme = S + (size_t)(u.br & 1) * ((size_t)32768 * 1024);
            const float* bp = bias + u.br * 1024 + col0; const float* cp = cdq + u.br * 1024 + col0; float rq[8];
#pragma unroll
            for (int g = 0; g < 8; ++g) rq[g] = rdq[row0 + (g >> 2) * HALF + (g & 3) * 16];
            u32x2 w0[8];
#pragma unroll
            for (int bj = 0; bj < 2; ++bj) { f32x2 bv[4], cv[4];
#pragma unroll
                for (int n = 0; n < 2; ++n) { const f32x4 b4 = *(const f32x4*)(bp + bj * HALF + 4 * n), c4 = *(const f32x4*)(cp + bj * HALF + 4 * n);
                    bv[2 * n] = (f32x2){b4.x, b4.y} * -1.4426950409f; bv[2 * n + 1] = (f32x2){b4.z, b4.w} * -1.4426950409f; cv[2 * n] = (f32x2){c4.x, c4.y} * -1.4426950409f; cv[2 * n + 1] = (f32x2){c4.z, c4.w} * -1.4426950409f; }
#pragma unroll
                for (int g = 0; g < 8; ++g) { const int ai = g >> 2, m = g & 3; const float rs = rq[g]; u32x2 w = {0u, 0u};
#pragma unroll
                    for (int p = 0; p < 4; ++p) { const f32x4 a4 = acc[ai][bj][m][p >> 1];
                        f32x2 t = {(float)__float_as_int(a4[2 * (p & 1)]), (float)__float_as_int(a4[2 * (p & 1) + 1])};
                        t = (t * rs) * cv[p] + bv[p];
                        f32x2 d = {fexp2(t.x), fexp2(t.y)}; d = d * (1.f / 255.f) + (1.f / 255.f);
                        const float s0 = fmaxf(frcp(d.x), 1.f), s1 = fmaxf(frcp(d.y), 1.f);
                        if (p < 2) { w.x = __builtin_amdgcn_cvt_pk_u8_f32(s0, 2 * p, w.x); w.x = __builtin_amdgcn_cvt_pk_u8_f32(s1, 2 * p + 1, w.x); }
                        else { w.y = __builtin_amdgcn_cvt_pk_u8_f32(s0, 2 * p - 4, w.y); w.y = __builtin_amdgcn_cvt_pk_u8_f32(s1, 2 * p - 3, w.y); } }
                    if (bj == 0) w0[g] = w;
                    else *(u32x4*)(Sme + (size_t)(row0 + ai * HALF + m * 16) * 1024 + col0 + soff) = join16(w0[g], w); } }
            return;
        }
        const int first = u.br == 0; const unsigned char* Sb = S + (size_t)32768 * 1024;
#pragma unroll
        for (int h = 0; h < 2; ++h) { u32x4 ls[4]; u32x4 mv[4][2];
#pragma unroll
            for (int q = 0; q < 4; ++q) { const size_t off_ = (size_t)(row0 + h * HALF + q * 16) * 1024 + col0;
                ls[q] = *(const u32x4*)(Sb + off_ + soff);
                if (!first) { mv[q][0] = *(const u32x4*)(MG + off_); mv[q][1] = *(const u32x4*)(MG + off_ + HALF); } else { mv[q][0] = (u32x4){0u, 0u, 0u, 0u}; mv[q][1] = (u32x4){0u, 0u, 0u, 0u}; } }
#pragma unroll
            for (int q = 0; q < 4; ++q) { const size_t off = (size_t)(row0 + h * HALF + q * 16) * 1024 + col0; u32x2 sv[2]; split16(ls[q], sv[0], sv[1]);
#pragma unroll
                for (int bj = 0; bj < 2; ++bj) { float o[8];
#pragma unroll
                    for (int e = 0; e < 8; ++e) { const unsigned sw = e < 4 ? sv[bj].x : sv[bj].y; const float s = ub(sw, e & 3) * (1.f / 255.f);
                        const unsigned mw = mv[q][bj][e >> 1]; const float mprev = (e & 1) ? bfhi(mw) : bflo(mw);
                        o[e] = mprev + s * acc[h][bj][q][e >> 2][e & 3]; }
                    *(u32x4*)(MG + off + bj * HALF) = pack8(o); } } }
    }
};
struct EpiOut {
    static constexpr bool PERM = true, AFTER_DRAIN = false, HAS_MID = false, HAS_I8 = false; static constexpr int SPLIT_T = 0;
    bf16_t* MO; float* PO;
    __device__ __forceinline__ void operator()(const f32x4 (&acc)[2][2][4][2], const Unit& u, int wr, int wc, int fr_, int fq_) const {
        int fr = fr_, fq = fq_; asm volatile("" : "+v"(fr), "+v"(fq));
        const int row0 = u.pm * BM + wr * 64 + fr, col0 = u.pn * BM + wc * 32 + 8 * fq;
#pragma unroll
        for (int ai = 0; ai < 2; ++ai)
#pragma unroll
            for (int m = 0; m < 4; ++m) { const size_t row = (size_t)(row0 + ai * HALF + m * 16); float ss = 0.f;
#pragma unroll
                for (int bj = 0; bj < 2; ++bj) { float o[8];
#pragma unroll
                    for (int e = 0; e < 8; ++e) { o[e] = acc[ai][bj][m][e >> 2][e & 3]; ss += o[e] * o[e]; }
                    st_nt((u32x4*)(MO + row * 1024 + col0 + bj * HALF), pack8(o)); }
                ss = quad_sum(ss); if (fq == 0) PO[row * 16 + u.pn * 4 + wc] = ss; }
    }
};
template <class Epi, class Sched, bool ALIGN_EPI = false, bool SP2 = false>
__device__ __forceinline__ void gemm_phase(PG8_LAS unsigned char* lds, const Gemm g, const Sched& S, const Epi& E) {
    int tid_ = threadIdx.x; asm volatile("" : "+v"(tid_));
    const int tid = tid_, wid = __builtin_amdgcn_readfirstlane(tid >> 6), lane = tid & 63, wr = wid >> 2, wc = wid & 3, fr = lane & 15, fq = lane >> 4;
    const int K = g.K;
    unsigned voffA[2], voffB[2];
#pragma unroll
    for (int i = 0; i < 2; ++i) { int R, C; stage_rc(tid * 16 + i * 8192, R, C); const int Rb = Epi::PERM ? ((R & ~31) + perm32(R & 31)) : R;
        voffA[i] = (unsigned)(R * g.lda + C) * 2u; voffB[i] = (unsigned)(Rb * K + C) * 2u; }
    const size_t kstep = (size_t)(BK * 2);
    const size_t hstepB = (size_t)HALF * K * 2, hstepA = (size_t)HALF * g.lda * 2;
    const size_t tstepA = 2 * hstepA, tstepB = 2 * hstepB;
    const unsigned ldsw = (unsigned)wid * 1024u;
    const int aoff = lds_byte(wr * 64 + fr, fq * 8), boff = lds_byte(wc * 32 + fr, fq * 8);
#define PG8_SA(b, h) (((b) * 2 + (h)) * HTB)
#define PG8_SB(b, h) ((4 + (b) * 2 + (h)) * HTB)
#define PG8_STAGE(bufoff, gbase, voff) do { _Pragma("unroll") for (int _i = 0; _i < 2; ++_i) { unsigned vo_ = (voff)[_i]; asm volatile("" : "+v"(vo_));     \
        __builtin_amdgcn_global_load_lds((const unsigned*)((const char*)(gbase) + vo_), (PG8_LAS unsigned*)(lds + (bufoff) + ldsw + _i * 8192), 16, 0, 0); } } while (0)
#define PG8_LDA(dst, b, h) do { _Pragma("unroll") for (int m = 0; m < 4; ++m) _Pragma("unroll") for (int k = 0; k < 2; ++k) dst[m][k] = *(const PG8_LAS bf16x8*)(lds + PG8_SA(b, h) + aoff + m * 2048 + k * 1024); } while (0)
#define PG8_LDB(dst, b, h) do { _Pragma("unroll") for (int n = 0; n < 2; ++n) _Pragma("unroll") for (int k = 0; k < 2; ++k) dst[n][k] = *(const PG8_LAS bf16x8*)(lds + PG8_SB(b, h) + boff + n * 2048 + k * 1024); } while (0)
#define PG8_MMA(ai, bj, At, Bt) do { __builtin_amdgcn_s_setprio(1); _Pragma("unroll") for (int m = 0; m < 4; ++m) _Pragma("unroll") for (int n = 0; n < 2; ++n) _Pragma("unroll") for (int k = 0; k < 2; ++k) \
        acc[ai][bj][m][n] = __builtin_amdgcn_mfma_f32_16x16x32_bf16(Bt[n][k], At[m][k], acc[ai][bj][m][n], 0, 0, 0); __builtin_amdgcn_s_setprio(0); } while (0)
#define PG8_MMA_I8(ai, bj, At, Bt) do { __builtin_amdgcn_s_setprio(1); _Pragma("unroll") for (int m = 0; m < 4; ++m) _Pragma("unroll") for (int n = 0; n < 2; ++n) _Pragma("unroll") for (int k = 0; k < 2; ++k) \
        acc[ai][bj][m][n] = __builtin_bit_cast(f32x4, __builtin_amdgcn_mfma_i32_16x16x64_i8(__builtin_bit_cast(i32x4, Bt[n][k]), __builtin_bit_cast(i32x4, At[m][k]), __builtin_bit_cast(i32x4, acc[ai][bj][m][n]), 0, 0, 0)); __builtin_amdgcn_s_setprio(0); } while (0)
#define PG8_WAIT_V(n) asm volatile("s_waitcnt vmcnt(" #n ")" ::: "memory")
#define PG8_WAIT_L(n) asm volatile("s_waitcnt lgkmcnt(" #n ")" ::: "memory")
#define PG8_BAR __builtin_amdgcn_s_barrier()
#define PG8_SCHED __builtin_amdgcn_sched_barrier(0)
#define PG8_KLOOP(MMAX, T0, T1) \
        for (int t = (T0); t < (T1); t += 2) { \
            const bool last = (t == nt - 2); \
            const char* a1 = cA + (size_t)(t + 1) * kstep; \
            const char* a2 = last ? nA : cA + (size_t)(t + 2) * kstep; const char* b2 = last ? nB : cB + (size_t)(t + 2) * kstep; \
            const char* a3 = a2 + kstep; const char* b3 = b2 + kstep; \
            if (last && has_next) S.a_ready(nxt); \
            if constexpr (Epi::HAS_MID) { if (t == 8 && cur.kind == 2) E.mid(acc, cur, wr, wc, fr, fq); } \
            PG8_LDB(B0, 0, 0); PG8_LDB(B1, 0, 1); PG8_SCHED; PG8_LDA(At, 0, 0); PG8_STAGE(PG8_SA(1, 1), a1 + hstepA, voffA); \
            PG8_WAIT_V(8); PG8_WAIT_L(0); PG8_BAR; MMAX(0, 0, At, B0); MMAX(0, 1, At, B1); PG8_BAR; PG8_SCHED; \
            PG8_LDA(At, 0, 1); PG8_STAGE(PG8_SB(0, 0), b2, voffB); PG8_STAGE(PG8_SB(0, 1), b2 + hstepB, voffB); PG8_STAGE(PG8_SA(0, 0), a2, voffA); \
            PG8_WAIT_V(8); PG8_WAIT_L(0); PG8_BAR; MMAX(1, 0, At, B0); MMAX(1, 1, At, B1); PG8_BAR; PG8_SCHED; \
            PG8_LDB(B0, 1, 0); PG8_LDB(B1, 1, 1); PG8_SCHED; PG8_LDA(At, 1, 0); PG8_STAGE(PG8_SA(0, 1), a2 + hstepA, voffA); \
            PG8_WAIT_V(8); PG8_WAIT_L(0); PG8_BAR; MMAX(0, 0, At, B0); MMAX(0, 1, At, B1); PG8_BAR; PG8_SCHED; \
            PG8_LDA(At, 1, 1); PG8_STAGE(PG8_SB(1, 0), b3, voffB); PG8_STAGE(PG8_SB(1, 1), b3 + hstepB, voffB); PG8_STAGE(PG8_SA(1, 0), a3, voffA); \
            PG8_WAIT_V(8); PG8_WAIT_L(0); PG8_BAR; MMAX(1, 0, At, B0); MMAX(1, 1, At, B1); PG8_BAR; PG8_SCHED; \
        }
    Unit cur, nxt; int ui = 0;
    if (!S.next(0, cur)) return;
    f32x4 acc[2][2][4][2];
#pragma unroll
    for (int a = 0; a < 2; ++a)
#pragma unroll
        for (int b = 0; b < 2; ++b)
#pragma unroll
            for (int m = 0; m < 4; ++m)
#pragma unroll
                for (int n = 0; n < 2; ++n) acc[a][b][m][n] = (f32x4){0.f, 0.f, 0.f, 0.f};
    bf16x8 At[4][2], B0[2][2], B1[2][2];
    const char* cA = (const char*)g.A + (size_t)cur.pm * tstepA + cur.aoff; const char* cB = (const char*)g.Bt + (size_t)cur.pn * tstepB + cur.boff;
    S.a_ready(cur);
    if constexpr (SP2) {
        PG8_STAGE(PG8_SB(0, 0), cB, voffB); PG8_STAGE(PG8_SB(0, 1), cB + hstepB, voffB); PG8_STAGE(PG8_SA(0, 0), cA, voffA); PG8_STAGE(PG8_SA(0, 1), cA + hstepA, voffA);
        if (wr == 1) PG8_BAR;
        PG8_WAIT_V(2); PG8_BAR;
        PG8_STAGE(PG8_SB(1, 0), cB + kstep, voffB); PG8_STAGE(PG8_SA(1, 0), cA + kstep, voffA); PG8_STAGE(PG8_SB(1, 1), cB + hstepB + kstep, voffB);
        PG8_WAIT_V(6); PG8_BAR;
    } else {
        PG8_STAGE(PG8_SB(0, 0), cB, voffB); PG8_STAGE(PG8_SA(0, 0), cA, voffA); PG8_STAGE(PG8_SB(0, 1), cB + hstepB, voffB); PG8_STAGE(PG8_SA(0, 1), cA + hstepA, voffA);
        if (wr == 1) PG8_BAR;
        PG8_WAIT_V(4); PG8_BAR;
        PG8_STAGE(PG8_SB(1, 0), cB + kstep, voffB); PG8_STAGE(PG8_SA(1, 0), cA + kstep, voffA); PG8_STAGE(PG8_SB(1, 1), cB + hstepB + kstep, voffB);
        PG8_WAIT_V(6); PG8_BAR;
    }
    for (;;) {
        const bool has_next = S.next(ui + 1, nxt);
        const char* nA = has_next ? (const char*)g.A + (size_t)nxt.pm * tstepA + nxt.aoff : cA; const char* nB = has_next ? (const char*)g.Bt + (size_t)nxt.pn * tstepB + nxt.boff : cB;
        const int nt = cur.nt; const bool i8u = Epi::HAS_I8 && cur.kind == 0;
        static_assert(SP2, "only the two-super-phase K-loop is kept");
        if (Epi::HAS_I8 && i8u) {
            if constexpr (Epi::SPLIT_T > 0) {
                PG8_KLOOP(PG8_MMA_I8, 0, Epi::SPLIT_T) E.dequant(acc, cur, wr, wc, fr, fq); PG8_KLOOP(PG8_MMA, Epi::SPLIT_T, nt)
            } else { PG8_KLOOP(PG8_MMA_I8, 0, nt) }
        } else { PG8_KLOOP(PG8_MMA, 0, nt) }
        if constexpr (ALIGN_EPI) { if (wr == 0) PG8_BAR; }
        if constexpr (!Epi::AFTER_DRAIN) { E(acc, cur, wr, wc, fr, fq); S.done(cur); }
        if (!has_next) break;
#pragma unroll
        for (int a = 0; a < 2; ++a)
#pragma unroll
            for (int b = 0; b < 2; ++b)
#pragma unroll
                for (int m = 0; m < 4; ++m)
#pragma unroll
                    for (int n = 0; n < 2; ++n) acc[a][b][m][n] = (f32x4){0.f, 0.f, 0.f, 0.f};
        cur = nxt; cA = nA; cB = nB; ++ui;
        if constexpr (ALIGN_EPI) { if (wr == 1) PG8_BAR; }
    }
    PG8_WAIT_V(0);
    if constexpr (!ALIGN_EPI) { if (wr == 0) PG8_BAR; }
    PG8_BAR;
    if constexpr (Epi::AFTER_DRAIN) { E.fused(acc, cur, wr, wc, fr, fq, lds, wid, lane); S.done(cur); }
#undef PG8_SA
#undef PG8_SB
#undef PG8_STAGE
#undef PG8_LDA
#undef PG8_LDB
#undef PG8_MMA
#undef PG8_MMA_I8
#undef PG8_KLOOP
#undef PG8_WAIT_V
#undef PG8_WAIT_L
#undef PG8_BAR
#undef PG8_SCHED
}
}

constexpr int NWAVES = 8, NTHREADS = 512;
constexpr int NB = 8, SEQ = 4096, D = 1024, M = NB * SEQ, DEPTH = 2;
constexpr int IN_DIM = 6568, NV_IN = 6656;
constexpr int O_CQ = 0, O_CKV = 256, O_KR = 384, O_GA = 416, O_MQ = 928, O_MK = 1184, O_MV = 1440, O_MI = 1952, O_MF = 1956, O_MO = 1960, O_GB = 2472,
              O_CX = 2984, O_CB = 3496, O_CC = 4008, O_GC = 4520, O_DU = 5032, O_DV = 5544, O_GD = 6056;
constexpr float QSCALE = 0.10206207261596577f * 1.4426950408889634f;
constexpr int N_PHASES = 13;
#ifndef MK_ONE_LAUNCH
#define MK_ONE_LAUNCH 1
#endif
#ifndef MK_PROBE
#define MK_PROBE 0
#endif
#ifndef MK_ATTN_V2
#define MK_ATTN_V2 1
#endif
#ifndef MK_NAIVE_ATTN
#define MK_NAIVE_ATTN 0
#endif
#ifndef MK_NAIVE_MLSTM
#define MK_NAIVE_MLSTM 0
#endif
#ifndef MK_NAIVE_SGU
#define MK_NAIVE_SGU 0
#endif

__host__ __device__ __forceinline__ int map_in(int vc, float& cs) {
    const int t = vc >> 8, j = vc & 255; cs = 1.f;
    if (t == 0) return O_CQ + j;
    if (t == 1) { if (j < 128) return O_CKV + j; const int jp = j - 128;
        if (jp < 32) { const int g = jp >> 3, w = jp & 7; return O_KR + (w < 4 ? 4 * g + w : 16 + 4 * g + (w - 4)); }
        if (jp < 36) return O_MI + (jp - 32); if (jp < 40) return O_MF + (jp - 36); return -1; }
    if (t < 4) return O_GA + 256 * (t - 2) + j;
    if (t == 4) { cs = 0.125f; return O_MQ + j; }
    if (t == 5) return O_MK + j;
    if (t < 8) return O_MV + 256 * (t - 6) + j;
    if (t < 24) { const int kind = (t - 8) >> 2, c0 = ((t - 8) & 3) * 128, jj = j & 127, hi = j >> 7;
        const int a = kind == 0 ? O_MO : kind == 1 ? O_CX : kind == 2 ? O_CB : O_DU, b = kind == 0 ? O_GB : kind == 1 ? O_CC : kind == 2 ? O_GC : O_GD;
        return (hi ? b : a) + c0 + jj; }
    return O_DV + 256 * (t - 24) + j;
}
__host__ __device__ __forceinline__ int map_q(int vc) { if (vc < 512) return (vc >> 6) * 96 + (vc & 63); const int j = vc - 512, hi = j >> 7, jj = j & 127; return (jj >> 4) * 96 + 64 + 16 * hi + (jj & 15); }
__host__ __device__ __forceinline__ int map_kv(int vc) { const int isv = vc >> 9, j = vc & 511; return (j >> 6) * 128 + 64 * isv + (j & 63); }

constexpr size_t MiB = 1u << 20;
constexpr size_t WS_CTL = 0, CTL_ZERO_BYTES = 64 * 1024;
constexpr size_t WS_WB = 1 * MiB;
constexpr size_t WB_IN = 0, WB_GATE = WB_IN + (size_t)NV_IN * 1024 * 2, WB_P = WB_GATE + (size_t)4096 * 1024 * 2  , WB_UQ = WB_P + (size_t)4 * 1024 * 1024 * 2,
                 WB_UKV = WB_UQ + (size_t)768 * 256 * 2, WB_S = WB_UKV + (size_t)1024 * 128 * 2, WB_END = WB_S + (size_t)4 * 128 * 128 * 2;
static_assert(WB_END <= 30 * MiB, "weights");
constexpr size_t WS_H = 31 * MiB  , WS_ZY = WS_H + 2048, WS_ZT = 223 * MiB, WS_Q = 375 * MiB, WS_KN = 423 * MiB, WS_V = 455 * MiB, WS_KR = 487 * MiB;
constexpr size_t WS_ROPE = 489 * MiB, WS_PQ = 493 * MiB, WS_PKV = WS_PQ + MiB / 2, WS_PVS = 494 * MiB, WS_GIF = 496 * MiB, WS_MLS = 497 * MiB, WS_PO = 499 * MiB, WS_MSUM = 501 * MiB, WS_WOUT = 509 * MiB + MiB / 2  , WS_END = 512 * MiB;
constexpr size_t WS_S = WS_ZT, WS_MG = WS_ZT + 64 * MiB, WS_MO = WS_S;
static_assert(WS_ZT + (size_t)M * ZT_LD * 2 <= WS_Q && WS_H + (size_t)M * H_LD * 2 <= WS_ZT && WS_MG + (size_t)M * D * 2 <= WS_Q && WS_WOUT + (size_t)1024 * 1024 * 2 <= WS_END, "ws map");
constexpr int CW_TMO = 0, CW_BAR = 4096;
constexpr size_t WS_RDQ = WS_CTL + 256 * 1024  , WS_CDQ = WS_CTL + 512 * 1024  , WS_CDQI = WS_CTL + 768 * 1024  ;

constexpr int RING_OFF = 0, RING_BYTES = 131072, LDSCTL_OFF = RING_BYTES, MISC_OFF = LDSCTL_OFF + 320, LDS_BYTES = 147456;

#define GAS __attribute__((address_space(1)))
#define LAS __attribute__((address_space(3)))
typedef unsigned short bf16;
typedef unsigned v4u __attribute__((ext_vector_type(4)));
typedef float f32x4 __attribute__((ext_vector_type(4)));
typedef short bf16x8 __attribute__((ext_vector_type(8)));
typedef GAS unsigned gu32;
typedef GAS unsigned long long gu64;
#define RLX_AGENT __ATOMIC_RELAXED, __HIP_MEMORY_SCOPE_AGENT
#define LDS_WAIT() asm volatile("s_waitcnt lgkmcnt(0)" ::: "memory")
#define VM_WAIT() asm volatile("s_waitcnt vmcnt(0)" ::: "memory")
__device__ __forceinline__ unsigned long long rt() { return __builtin_amdgcn_s_memrealtime(); }
__device__ __forceinline__ unsigned f2bf(float f) { unsigned u = __builtin_bit_cast(unsigned, f); return (u + 0x7fffu + ((u >> 16) & 1u)) >> 16; }
__device__ __forceinline__ unsigned pk2(float lo, float hi) { return f2bf(lo) | (f2bf(hi) << 16); }

#define XB_TMO      128
#define XB_XCNT(j)  (256  + 64 * (j))
#define XB_XSUB(j)  (1280 + 64 * (j))
#define XB_XGEN(j)  (2304 + 64 * (j))
#define XB_TOP      3328
#define XB_TOPGEN   3392
#define XCD_BAR_WORDS 3456
#define XB_SPIN_CAP (1u << 18)

__device__ __forceinline__ unsigned xb_ld(unsigned* p)              { return __hip_atomic_load(p, __ATOMIC_RELAXED, __HIP_MEMORY_SCOPE_AGENT); }
__device__ __forceinline__ unsigned xb_add(unsigned* p, unsigned v) { return __hip_atomic_fetch_add(p, v, __ATOMIC_RELAXED, __HIP_MEMORY_SCOPE_AGENT); }
__device__ __forceinline__ unsigned xb_xcc_id() { return (unsigned)__builtin_amdgcn_s_getreg((3 << 11) | 20) & 0xFu; }
#define XB_SPIN(cond, bar) do { unsigned _sp = 0; while (cond) { __builtin_amdgcn_s_sleep(1); \
    if ((++_sp & 255u) == 0u) { if (xb_ld(&(bar)[XB_TMO])) break; if (_sp > XB_SPIN_CAP) { atomicAdd(&(bar)[XB_TMO], 1u); break; } } } } while (0)

struct XcdBarrier {
    unsigned* bar; unsigned x;
    volatile LAS unsigned* st;
};

__device__ __forceinline__ XcdBarrier xcd_barrier_post(unsigned* bar, volatile LAS unsigned* st) {
    XcdBarrier b; b.bar = bar; b.x = xb_xcc_id(); b.st = st;
    if (threadIdx.x == 0) (void)xb_add(&bar[XB_XCNT(b.x)], 1u);
    return b;
}
__device__ __forceinline__ void xcd_barrier_complete(unsigned* bar, unsigned x, unsigned& nloc, unsigned& nx) {
    const unsigned G = gridDim.x * gridDim.y * gridDim.z;
    unsigned sum, cnt, mine, sp = 0u;
    for (;;) {
        sum = 0u; cnt = 0u; mine = 0u;
#pragma unroll
        for (unsigned j = 0; j < 16; ++j) { const unsigned c = xb_ld(&bar[XB_XCNT(j)]); sum += c; cnt += (c > 0u) ? 1u : 0u; mine = (j == x) ? c : mine; }
        if (sum == G) break;
        __builtin_amdgcn_s_sleep(1);
        if ((++sp & 255u) == 0u) { if (xb_ld(&bar[XB_TMO])) break; if (sp > XB_SPIN_CAP) { atomicAdd(&bar[XB_TMO], 1u); break; } }
    }
    nloc = mine > 0u ? mine : 1u; nx = cnt > 0u ? cnt : 1u;
}

__device__ __forceinline__ void xcd_barrier(const XcdBarrier& b) {
    asm volatile("s_waitcnt vmcnt(0)" ::: "memory");
    __syncthreads();
    if (threadIdx.x == 0) {
        unsigned* bar = b.bar;
        __builtin_amdgcn_s_waitcnt(0);
        unsigned nloc = b.st[0], nx = b.st[1];
        if (nloc == 0u) { xcd_barrier_complete(bar, b.x, nloc, nx); b.st[0] = nloc; b.st[1] = nx; }
        const unsigned old = xb_add(&bar[XB_XSUB(b.x)], 1u);
        const unsigned gen = old / nloc;
        if (old + 1u == (gen + 1u) * nloc) {
            __builtin_amdgcn_fence(__ATOMIC_RELEASE, "agent");
            asm volatile("s_waitcnt vmcnt(0)" ::: "memory");
            const unsigned og = xb_add(&bar[XB_TOP], 1u);
            const unsigned tg = og / nx;
            if (og + 1u == (tg + 1u) * nx) xb_add(&bar[XB_TOPGEN], 1u);
            else XB_SPIN(xb_ld(&bar[XB_TOPGEN]) == tg, bar);
            __builtin_amdgcn_fence(__ATOMIC_ACQUIRE, "agent");
            xb_add(&bar[XB_XGEN(b.x)], 1u);
            asm volatile("s_waitcnt vmcnt(0)" ::: "memory");
        } else {
            XB_SPIN(xb_ld(&bar[XB_XGEN(b.x)]) == gen, bar);
            __builtin_amdgcn_fence(__ATOMIC_ACQUIRE, "agent");
            asm volatile("s_waitcnt vmcnt(0)" ::: "memory");
        }
    }
    __syncthreads();
}
namespace att {
using bf16x8 = __attribute__((ext_vector_type(8))) short;
using s16x4  = __attribute__((ext_vector_type(4))) short;
using f32x16 = __attribute__((ext_vector_type(16))) float;
using u32x4  = __attribute__((ext_vector_type(4))) unsigned;
constexpr int NW = 8, QBLK = 32, KVBLK = 64;
constexpr float THR2 = 11.5f;
constexpr int SHM_V = 16384, SHM_K = 16384, SHM_ATTN = 2 * SHM_V + 2 * SHM_K + NW * 64 * 4;
#define KSWZ(row, colB) ((row) * 256 + ((colB) ^ (((row) & 7) << 4)))
#define SBAR() __builtin_amdgcn_sched_barrier(0)
__device__ __forceinline__ int crow(int r, int hi) { return (r & 3) + 8 * (r >> 2) + 4 * hi; }
__device__ __forceinline__ unsigned cvtpk(float lo, float hi) { typedef float f2 __attribute__((ext_vector_type(2))); typedef __bf16 b2 __attribute__((ext_vector_type(2))); f2 v = {lo, hi}; b2 b = __builtin_convertvector(v, b2); return __builtin_bit_cast(unsigned, b); }
__device__ __forceinline__ void partialSM(f32x16& p0, f32x16& p1, float& m_reg, float& mn, float& alpha) {
  float pmax = p0[0];
#pragma unroll
  for (int r = 1; r < 16; ++r) pmax = fmaxf(pmax, p0[r]);
#pragma unroll
  for (int r = 0; r < 16; ++r) pmax = fmaxf(pmax, p1[r]);
  { auto rr = __builtin_amdgcn_permlane32_swap(__float_as_uint(pmax), __float_as_uint(pmax), false, false); pmax = fmaxf(__uint_as_float(rr[0]), __uint_as_float(rr[1])); }
  if (__builtin_expect(__all(pmax - m_reg <= THR2), 1)) { mn = m_reg; alpha = 1.f; }
  else { mn = fmaxf(m_reg, pmax); alpha = __builtin_amdgcn_exp2f(m_reg - mn); m_reg = mn; }
#pragma unroll
  for (int r = 0; r < 16; ++r) p0[r] = p0[r] - mn;
#pragma unroll
  for (int r = 0; r < 16; ++r) p1[r] = p1[r] - mn;
#pragma unroll
  for (int r = 0; r < 16; ++r) p0[r] = __builtin_amdgcn_exp2f(p0[r]);
}
__device__ __forceinline__ void finishSM(f32x16& p0, f32x16& p1, float alpha, float& l_reg, bf16x8& pa0, bf16x8& pa1, bf16x8& pa2, bf16x8& pa3) {
#pragma unroll
  for (int r = 0; r < 16; ++r) p1[r] = __builtin_amdgcn_exp2f(p1[r]);
  float ps = 0;
#pragma unroll
  for (int r = 0; r < 16; ++r) ps += p0[r];
#pragma unroll
  for (int r = 0; r < 16; ++r) ps += p1[r];
  { auto rr = __builtin_amdgcn_permlane32_swap(__float_as_uint(ps), __float_as_uint(ps), false, false); ps = __uint_as_float(rr[0]) + __uint_as_float(rr[1]); }
  l_reg = l_reg * alpha + ps;
#define PK4(P, BASE, OUT) do { unsigned a0 = cvtpk(P[BASE + 0], P[BASE + 1]), a1 = cvtpk(P[BASE + 2], P[BASE + 3]);   \
    unsigned b0 = cvtpk(P[BASE + 4], P[BASE + 5]), b1 = cvtpk(P[BASE + 6], P[BASE + 7]);                              \
    auto r0 = __builtin_amdgcn_permlane32_swap(a0, b0, false, false); auto r1 = __builtin_amdgcn_permlane32_swap(a1, b1, false, false); \
    u32x4 w = {r0[0], r1[0], r0[1], r1[1]}; OUT = __builtin_bit_cast(bf16x8, w); } while (0)
  PK4(p0, 0, pa0); PK4(p0, 8, pa1); PK4(p1, 0, pa2); PK4(p1, 8, pa3);
#undef PK4
}
template <int ND0> __device__ __forceinline__ void qkt(f32x16& p0, f32x16& p1, const char* Ks, const bf16x8* qr, int r32, int hi) {
  bf16x8 kf[2 * ND0];
#pragma unroll
  for (int d0 = 0; d0 < ND0; ++d0) { const int cb = (d0 * 16 + hi * 8) * 2;
    kf[2 * d0] = *reinterpret_cast<const bf16x8*>(Ks + KSWZ(r32, cb)); kf[2 * d0 + 1] = *reinterpret_cast<const bf16x8*>(Ks + KSWZ(32 + r32, cb)); }
  SBAR();
  p0 = f32x16{}; p1 = f32x16{};
#pragma unroll
  for (int d0 = 0; d0 < ND0; ++d0) { p0 = __builtin_amdgcn_mfma_f32_32x32x16_bf16(kf[2 * d0], qr[d0], p0, 0, 0, 0); p1 = __builtin_amdgcn_mfma_f32_32x32x16_bf16(kf[2 * d0 + 1], qr[d0], p1, 0, 0, 0); }
}
__device__ __forceinline__ int v_st(int k, int c) { const int kk = (k & ~0xC) | ((k & 4) << 1) | ((k & 8) >> 1); return ((kk >> 3) * 4 + (c >> 5)) * 512 + ((kk & 7) * 32 + (c & 31)) * 2; }
__device__ __forceinline__ int v_rd_base(int lane) { return ((lane & 3) << 3) | (((lane >> 2) & 3) << 6) | (((lane >> 4) & 1) << 5) | (((lane >> 5) & 1) << 8); }
constexpr int v_rd_off(int d0, int ks, int half) { return d0 * 512 + ks * 4096 + half * 2048; }
template <int OFF> __device__ __forceinline__ s16x4 tr_read(int vb) { s16x4 r; asm volatile("ds_read_b64_tr_b16 %0, %1 offset:%2" : "=&v"(r) : "v"(vb), "i"(OFF) : "memory"); return r; }
template <int D0, bool SWAP> __device__ __forceinline__ void pv_one(f32x16& od, int vb, bf16x8 pa0, bf16x8 pa1, bf16x8 pa2, bf16x8 pa3) {
  const s16x4 l0 = tr_read<v_rd_off(D0, 0, 0)>(vb), h0 = tr_read<v_rd_off(D0, 0, 1)>(vb), l1 = tr_read<v_rd_off(D0, 1, 0)>(vb), h1 = tr_read<v_rd_off(D0, 1, 1)>(vb);
  const s16x4 l2 = tr_read<v_rd_off(D0, 2, 0)>(vb), h2 = tr_read<v_rd_off(D0, 2, 1)>(vb), l3 = tr_read<v_rd_off(D0, 3, 0)>(vb), h3 = tr_read<v_rd_off(D0, 3, 1)>(vb);
  asm volatile("s_waitcnt lgkmcnt(0)" ::: "memory"); SBAR();
#define PK(L, H) (bf16x8){L[0], L[1], L[2], L[3], H[0], H[1], H[2], H[3]}
  if (SWAP) {
    od = __builtin_amdgcn_mfma_f32_32x32x16_bf16(PK(l0, h0), pa0, od, 0, 0, 0); od = __builtin_amdgcn_mfma_f32_32x32x16_bf16(PK(l1, h1), pa1, od, 0, 0, 0);
    od = __builtin_amdgcn_mfma_f32_32x32x16_bf16(PK(l2, h2), pa2, od, 0, 0, 0); od = __builtin_amdgcn_mfma_f32_32x32x16_bf16(PK(l3, h3), pa3, od, 0, 0, 0);
  } else {
    od = __builtin_amdgcn_mfma_f32_32x32x16_bf16(pa0, PK(l0, h0), od, 0, 0, 0); od = __builtin_amdgcn_mfma_f32_32x32x16_bf16(pa1, PK(l1, h1), od, 0, 0, 0);
    od = __builtin_amdgcn_mfma_f32_32x32x16_bf16(pa2, PK(l2, h2), od, 0, 0, 0); od = __builtin_amdgcn_mfma_f32_32x32x16_bf16(pa3, PK(l3, h3), od, 0, 0, 0);
  }
#undef PK
}

__device__ __forceinline__ void pv2(f32x16& o0, f32x16& o1, int vb, bf16x8 pa0, bf16x8 pa1, bf16x8 pa2, bf16x8 pa3) {
  const s16x4 l0 = tr_read<v_rd_off(0, 0, 0)>(vb), h0 = tr_read<v_rd_off(0, 0, 1)>(vb), m0 = tr_read<v_rd_off(1, 0, 0)>(vb), n0 = tr_read<v_rd_off(1, 0, 1)>(vb);
  const s16x4 l1 = tr_read<v_rd_off(0, 1, 0)>(vb), h1 = tr_read<v_rd_off(0, 1, 1)>(vb), m1 = tr_read<v_rd_off(1, 1, 0)>(vb), n1 = tr_read<v_rd_off(1, 1, 1)>(vb);
  const s16x4 l2 = tr_read<v_rd_off(0, 2, 0)>(vb), h2 = tr_read<v_rd_off(0, 2, 1)>(vb), m2 = tr_read<v_rd_off(1, 2, 0)>(vb), n2 = tr_read<v_rd_off(1, 2, 1)>(vb);
  const s16x4 l3 = tr_read<v_rd_off(0, 3, 0)>(vb), h3 = tr_read<v_rd_off(0, 3, 1)>(vb), m3 = tr_read<v_rd_off(1, 3, 0)>(vb), n3 = tr_read<v_rd_off(1, 3, 1)>(vb);
  asm volatile("s_waitcnt lgkmcnt(0)" ::: "memory"); SBAR();
#define PK(L, H) (bf16x8){L[0], L[1], L[2], L[3], H[0], H[1], H[2], H[3]}
  o0 = __builtin_amdgcn_mfma_f32_32x32x16_bf16(pa0, PK(l0, h0), o0, 0, 0, 0); o1 = __builtin_amdgcn_mfma_f32_32x32x16_bf16(pa0, PK(m0, n0), o1, 0, 0, 0);
  o0 = __builtin_amdgcn_mfma_f32_32x32x16_bf16(pa1, PK(l1, h1), o0, 0, 0, 0); o1 = __builtin_amdgcn_mfma_f32_32x32x16_bf16(pa1, PK(m1, n1), o1, 0, 0, 0);
  o0 = __builtin_amdgcn_mfma_f32_32x32x16_bf16(pa2, PK(l2, h2), o0, 0, 0, 0); o1 = __builtin_amdgcn_mfma_f32_32x32x16_bf16(pa2, PK(m2, n2), o1, 0, 0, 0);
  o0 = __builtin_amdgcn_mfma_f32_32x32x16_bf16(pa3, PK(l3, h3), o0, 0, 0, 0); o1 = __builtin_amdgcn_mfma_f32_32x32x16_bf16(pa3, PK(m3, n3), o1, 0, 0, 0);
#undef PK
}
__device__ __forceinline__ void finishSM2(f32x16& p0, f32x16& p1, bf16x8& pa0, bf16x8& pa1, bf16x8& pa2, bf16x8& pa3) {
#pragma unroll
  for (int r = 0; r < 16; ++r) p1[r] = __builtin_amdgcn_exp2f(p1[r]);
#define PK4(P, BASE, OUT) do { unsigned a0 = cvtpk(P[BASE + 0], P[BASE + 1]), a1 = cvtpk(P[BASE + 2], P[BASE + 3]);   \
    unsigned b0 = cvtpk(P[BASE + 4], P[BASE + 5]), b1 = cvtpk(P[BASE + 6], P[BASE + 7]);                              \
    auto r0 = __builtin_amdgcn_permlane32_swap(a0, b0, false, false); auto r1 = __builtin_amdgcn_permlane32_swap(a1, b1, false, false); \
    u32x4 w = {r0[0], r1[0], r0[1], r1[1]}; OUT = __builtin_bit_cast(bf16x8, w); } while (0)
  PK4(p0, 0, pa0); PK4(p0, 8, pa1); PK4(p1, 0, pa2); PK4(p1, 8, pa3);
#undef PK4
}
__device__ __forceinline__ void pv2l(f32x16& o0, f32x16& o1, f32x16& ls, int vb, bf16x8 pa0, bf16x8 pa1, bf16x8 pa2, bf16x8 pa3) {
  const s16x4 l0 = tr_read<v_rd_off(0, 0, 0)>(vb), h0 = tr_read<v_rd_off(0, 0, 1)>(vb), m0 = tr_read<v_rd_off(1, 0, 0)>(vb), n0 = tr_read<v_rd_off(1, 0, 1)>(vb);
  const s16x4 l1 = tr_read<v_rd_off(0, 1, 0)>(vb), h1 = tr_read<v_rd_off(0, 1, 1)>(vb), m1 = tr_read<v_rd_off(1, 1, 0)>(vb), n1 = tr_read<v_rd_off(1, 1, 1)>(vb);
  const s16x4 l2 = tr_read<v_rd_off(0, 2, 0)>(vb), h2 = tr_read<v_rd_off(0, 2, 1)>(vb), m2 = tr_read<v_rd_off(1, 2, 0)>(vb), n2 = tr_read<v_rd_off(1, 2, 1)>(vb);
  const s16x4 l3 = tr_read<v_rd_off(0, 3, 0)>(vb), h3 = tr_read<v_rd_off(0, 3, 1)>(vb), m3 = tr_read<v_rd_off(1, 3, 0)>(vb), n3 = tr_read<v_rd_off(1, 3, 1)>(vb);
  const short one = 0x3f80; const bf16x8 ones = {one, one, one, one, one, one, one, one};
  asm volatile("s_waitcnt lgkmcnt(0)" ::: "memory"); SBAR();
#define PK(L, H) (bf16x8){L[0], L[1], L[2], L[3], H[0], H[1], H[2], H[3]}
  o0 = __builtin_amdgcn_mfma_f32_32x32x16_bf16(pa0, PK(l0, h0), o0, 0, 0, 0); o1 = __builtin_amdgcn_mfma_f32_32x32x16_bf16(pa0, PK(m0, n0), o1, 0, 0, 0); ls = __builtin_amdgcn_mfma_f32_32x32x16_bf16(pa0, ones, ls, 0, 0, 0);
  o0 = __builtin_amdgcn_mfma_f32_32x32x16_bf16(pa1, PK(l1, h1), o0, 0, 0, 0); o1 = __builtin_amdgcn_mfma_f32_32x32x16_bf16(pa1, PK(m1, n1), o1, 0, 0, 0); ls = __builtin_amdgcn_mfma_f32_32x32x16_bf16(pa1, ones, ls, 0, 0, 0);
  o0 = __builtin_amdgcn_mfma_f32_32x32x16_bf16(pa2, PK(l2, h2), o0, 0, 0, 0); o1 = __builtin_amdgcn_mfma_f32_32x32x16_bf16(pa2, PK(m2, n2), o1, 0, 0, 0); ls = __builtin_amdgcn_mfma_f32_32x32x16_bf16(pa2, ones, ls, 0, 0, 0);
  o0 = __builtin_amdgcn_mfma_f32_32x32x16_bf16(pa3, PK(l3, h3), o0, 0, 0, 0); o1 = __builtin_amdgcn_mfma_f32_32x32x16_bf16(pa3, PK(m3, n3), o1, 0, 0, 0); ls = __builtin_amdgcn_mfma_f32_32x32x16_bf16(pa3, ones, ls, 0, 0, 0);
#undef PK
}
__device__ __forceinline__ void pv_kv(f32x16& acc, int vbk, int vbv) {
  const s16x4 al0 = tr_read<v_rd_off(0, 0, 0)>(vbk), ah0 = tr_read<v_rd_off(0, 0, 1)>(vbk), al1 = tr_read<v_rd_off(0, 1, 0)>(vbk), ah1 = tr_read<v_rd_off(0, 1, 1)>(vbk);
  const s16x4 al2 = tr_read<v_rd_off(0, 2, 0)>(vbk), ah2 = tr_read<v_rd_off(0, 2, 1)>(vbk), al3 = tr_read<v_rd_off(0, 3, 0)>(vbk), ah3 = tr_read<v_rd_off(0, 3, 1)>(vbk);
  const s16x4 bl0 = tr_read<v_rd_off(0, 0, 0)>(vbv), bh0 = tr_read<v_rd_off(0, 0, 1)>(vbv), bl1 = tr_read<v_rd_off(0, 1, 0)>(vbv), bh1 = tr_read<v_rd_off(0, 1, 1)>(vbv);
  const s16x4 bl2 = tr_read<v_rd_off(0, 2, 0)>(vbv), bh2 = tr_read<v_rd_off(0, 2, 1)>(vbv), bl3 = tr_read<v_rd_off(0, 3, 0)>(vbv), bh3 = tr_read<v_rd_off(0, 3, 1)>(vbv);
  asm volatile("s_waitcnt lgkmcnt(0)" ::: "memory"); SBAR();
#define PK(L, H) (bf16x8){L[0], L[1], L[2], L[3], H[0], H[1], H[2], H[3]}
  acc = __builtin_amdgcn_mfma_f32_32x32x16_bf16(PK(al0, ah0), PK(bl0, bh0), acc, 0, 0, 0); acc = __builtin_amdgcn_mfma_f32_32x32x16_bf16(PK(al1, ah1), PK(bl1, bh1), acc, 0, 0, 0);
  acc = __builtin_amdgcn_mfma_f32_32x32x16_bf16(PK(al2, ah2), PK(bl2, bh2), acc, 0, 0, 0); acc = __builtin_amdgcn_mfma_f32_32x32x16_bf16(PK(al3, ah3), PK(bl3, bh3), acc, 0, 0, 0);
#undef PK
}
__device__ __forceinline__ void attn_unit(int b, int h, int qb, const bf16* Q, const bf16* __restrict__ KN, const bf16* __restrict__ KR, const bf16* __restrict__ V, bf16* Y, char* lds) {
  int tid = threadIdx.x; asm volatile("" : "+v"(tid));
  const int wid = __builtin_amdgcn_readfirstlane(tid >> 6), lane = tid & 63, r32 = lane & 31, hi = lane >> 5;
  char* V_lds = lds; char* K_lds = lds + 2 * SHM_V;
  float* ws = (float*)(lds + 2 * SHM_V + 2 * SHM_K) + wid * 64; float* li_l = ws; float* al_l = ws + 32;
  float m_reg = -1e30f, l_reg = 0; f32x16 o[2] = {}; bf16x8 qr[6];
  const size_t rowbase = (size_t)b * SEQ; const int q0 = qb * 256;
  const bf16* Qw = Q + (rowbase + q0 + wid * QBLK + r32) * 768 + h * 96 + hi * 8;
#pragma unroll
  for (int d0 = 0; d0 < 6; ++d0) qr[d0] = *reinterpret_cast<const bf16x8*>(Qw + d0 * 16);
  const int sr = tid >> 4, sc = (tid & 15) * 8, vst0 = v_st(sr, sc & 63), vst1 = v_st(32 + sr, sc & 63);
  const bool doK = sc < 96, doV = sc < 64;
  const bf16* ksrc = sc < 64 ? KN + rowbase * 512 + h * 64 + sc : KR + rowbase * 32 + (sc - 64); const int kld = sc < 64 ? 512 : 32;
  const bf16* vsrc = V + rowbase * 512 + h * 64 + (sc & 63);
  const int vb0 = (int)(uintptr_t)V_lds + v_rd_base(lane);
  struct { bf16x8 vs0, vs1, ks0, ks1; } sr_[2];
#define SLOAD(i, k0) do { if (doV) { sr_[i].vs0 = *(const bf16x8*)(vsrc + (size_t)((k0) + sr) * 512); sr_[i].vs1 = *(const bf16x8*)(vsrc + (size_t)((k0) + 32 + sr) * 512); } \
    if (doK) { sr_[i].ks0 = *(const bf16x8*)(ksrc + (size_t)((k0) + sr) * kld); sr_[i].ks1 = *(const bf16x8*)(ksrc + (size_t)((k0) + 32 + sr) * kld); } } while (0)
#define SWRITE(bb, i) do { if (doV) { *(bf16x8*)(V_lds + (bb) * SHM_V + vst0) = sr_[i].vs0; *(bf16x8*)(V_lds + (bb) * SHM_V + vst1) = sr_[i].vs1; } \
    if (doK) { const int kc = sc * 2; *(bf16x8*)(K_lds + (bb) * SHM_K + KSWZ(sr, kc)) = sr_[i].ks0; *(bf16x8*)(K_lds + (bb) * SHM_K + KSWZ(32 + sr, kc)) = sr_[i].ks1; } } while (0)
#define SWAIT() asm volatile("s_waitcnt vmcnt(4)" ::: "memory")
#define RESC(a) do { if (__any((a) < 1.f)) { if (hi == 0) al_l[r32] = (a); asm volatile("s_waitcnt lgkmcnt(0)" ::: "memory"); \
    _Pragma("unroll") for (int d = 0; d < 2; ++d) _Pragma("unroll") for (int r = 0; r < 16; ++r) o[d][r] *= al_l[crow(r, hi)]; } } while (0)
#define MASK(P0, P1, j) do { if ((j) >= NTw) { _Pragma("unroll") for (int r = 0; r < 16; ++r) { P0[r] = -INFINITY; P1[r] = -INFINITY; } } } while (0)
  f32x16 pA0, pA1, pB0, pB1; float mnA, mnB, alA, alB; bf16x8 pa0, pa1, pa2, pa3;
  const int NT = 4 * qb + 4, NTw = 4 * qb + (wid >> 1) + 1;
  constexpr int SE = 0, SO = 1;
  SLOAD(SE, 0); asm volatile("s_waitcnt vmcnt(0)" ::: "memory"); SWRITE(0, SE); __syncthreads();
  qkt<6>(pA0, pA1, K_lds, qr, r32, hi); partialSM(pA0, pA1, m_reg, mnA, alA);
  SLOAD(SO, KVBLK); if (2 < NT) SLOAD(SE, 2 * KVBLK);
  SWAIT(); SWRITE(1, SO); __syncthreads();
  for (int j = 1; j + 1 < NT; j += 2) {
    SBAR(); qkt<6>(pB0, pB1, K_lds + SHM_K, qr, r32, hi); MASK(pB0, pB1, j);
    finishSM(pA0, pA1, alA, l_reg, pa0, pa1, pa2, pa3); SBAR();
    SLOAD(SO, (j + 2) * KVBLK); SBAR();
    pv_one<0, false>(o[0], vb0, pa0, pa1, pa2, pa3); pv_one<1, false>(o[1], vb0, pa0, pa1, pa2, pa3); partialSM(pB0, pB1, m_reg, mnB, alB);
    __syncthreads(); SWAIT(); SWRITE(0, SE);
    RESC(alB); __syncthreads();
    SBAR(); qkt<6>(pA0, pA1, K_lds, qr, r32, hi); MASK(pA0, pA1, j + 1);
    finishSM(pB0, pB1, alB, l_reg, pa0, pa1, pa2, pa3); SBAR();
    if (j + 3 < NT) SLOAD(SE, (j + 3) * KVBLK); SBAR();
    pv_one<0, false>(o[0], vb0 + SHM_V, pa0, pa1, pa2, pa3); pv_one<1, false>(o[1], vb0 + SHM_V, pa0, pa1, pa2, pa3); partialSM(pA0, pA1, m_reg, mnA, alA);
    __syncthreads(); SWAIT(); SWRITE(1, SO);
    RESC(alA); __syncthreads();
  }
  SBAR(); qkt<6>(pB0, pB1, K_lds + SHM_K, qr, r32, hi); MASK(pB0, pB1, NT - 1);
  finishSM(pA0, pA1, alA, l_reg, pa0, pa1, pa2, pa3); SBAR();
  pv_one<0, false>(o[0], vb0, pa0, pa1, pa2, pa3); pv_one<1, false>(o[1], vb0, pa0, pa1, pa2, pa3); partialSM(pB0, pB1, m_reg, mnB, alB);
  __syncthreads(); RESC(alB);
  finishSM(pB0, pB1, alB, l_reg, pa0, pa1, pa2, pa3); SBAR();
  pv_one<0, false>(o[0], vb0 + SHM_V, pa0, pa1, pa2, pa3); pv_one<1, false>(o[1], vb0 + SHM_V, pa0, pa1, pa2, pa3);
  if (hi == 0) li_l[r32] = l_reg; asm volatile("s_waitcnt lgkmcnt(0)" ::: "memory");
  bf16* Yw = Y + (rowbase + q0 + wid * QBLK) * ZY_LD + YA + h * 64;
#pragma unroll
  for (int r = 0; r < 16; ++r) { const int orow = crow(r, hi); const float rl = __builtin_amdgcn_rcpf(li_l[orow]);
#pragma unroll
    for (int d0 = 0; d0 < 2; ++d0) { bf16* p = Yw + (size_t)orow * ZY_LD + d0 * 32 + r32; const float g = __uint_as_float((unsigned)*p << 16); *p = (bf16)f2bf(o[d0][r] * rl * g); } }
  __syncthreads();
#undef SLOAD
#undef SWRITE
#undef SWAIT
#undef RESC
#undef MASK
}

__device__ __forceinline__ void glds16(const void* gsrc, unsigned lds_dst) { unsigned keep;
  asm volatile("s_mov_b32 %0, m0\n\ts_mov_b32 m0, %2\n\ts_nop 0\n\tglobal_load_lds_dwordx4 %1, off\n\ts_mov_b32 m0, %0" : "=&s"(keep) : "v"(gsrc), "s"(lds_dst) : "memory"); }
#define WAIT_BAR(N) asm volatile("s_waitcnt vmcnt(" #N ") lgkmcnt(0)\n\ts_barrier" ::: "memory")
template <int ND0> __device__ __forceinline__ void qkt_c(f32x16& p0, f32x16& p1, const f32x16& c, const char* Ks, const bf16x8* qr, int r32, int hi) {
  bf16x8 kf[2 * ND0];
#pragma unroll
  for (int d0 = 0; d0 < ND0; ++d0) { const int cb = (d0 * 16 + hi * 8) * 2;
    kf[2 * d0] = *reinterpret_cast<const bf16x8*>(Ks + KSWZ(r32, cb)); kf[2 * d0 + 1] = *reinterpret_cast<const bf16x8*>(Ks + KSWZ(32 + r32, cb)); }
  SBAR();
#pragma unroll
  for (int d0 = 0; d0 < ND0; ++d0) {
    if (d0 == 0) { p0 = __builtin_amdgcn_mfma_f32_32x32x16_bf16(kf[0], qr[0], c, 0, 0, 0); p1 = __builtin_amdgcn_mfma_f32_32x32x16_bf16(kf[1], qr[0], c, 0, 0, 0); }
    else { p0 = __builtin_amdgcn_mfma_f32_32x32x16_bf16(kf[2 * d0], qr[d0], p0, 0, 0, 0); p1 = __builtin_amdgcn_mfma_f32_32x32x16_bf16(kf[2 * d0 + 1], qr[d0], p1, 0, 0, 0); } }
}
__device__ __forceinline__ void partialSM2(f32x16& p0, f32x16& p1, float& m_reg, f32x16& negm, float& alpha, bool first) {
  float pmax = p0[0];
#pragma unroll
  for (int r = 1; r < 16; ++r) pmax = fmaxf(pmax, p0[r]);
#pragma unroll
  for (int r = 0; r < 16; ++r) pmax = fmaxf(pmax, p1[r]);
  { auto rr = __builtin_amdgcn_permlane32_swap(__float_as_uint(pmax), __float_as_uint(pmax), false, false); pmax = fmaxf(__uint_as_float(rr[0]), __uint_as_float(rr[1])); }
  alpha = 1.f;
  if (__builtin_expect(first || __any(pmax > THR2), 0)) { const float dl = first ? pmax : fmaxf(pmax, 0.f); m_reg += dl; alpha = __builtin_amdgcn_exp2f(-dl);
#pragma unroll
    for (int r = 0; r < 16; ++r) { p0[r] -= dl; p1[r] -= dl; negm[r] = -m_reg; } }
#pragma unroll
  for (int r = 0; r < 16; ++r) p0[r] = __builtin_amdgcn_exp2f(p0[r]);
}

__device__ __forceinline__ void attn_unit2(int b, int h, int qb, const bf16* Q, const bf16* __restrict__ KN, const bf16* __restrict__ KR, const bf16* __restrict__ V, bf16* Y, char* lds,
                                           bf16x8 (&qr)[6], bool have_q, bool has_next, int nb, int nh, int nqb) {
  int tid = threadIdx.x; asm volatile("" : "+v"(tid));
  const int wid = __builtin_amdgcn_readfirstlane(tid >> 6), lane = tid & 63, r32 = lane & 31, hi = lane >> 5;
  constexpr int OFF_K = 0, OFF_V = 3 * SHM_K, OFF_WS = 3 * SHM_K + 3 * SHM_V;
  const unsigned lds0 = (unsigned)(uintptr_t)lds;
  float* ws = (float*)(lds + OFF_WS) + wid * 64; float* li_l = ws; float* al_l = ws + 32;
  const size_t rowbase = (size_t)b * SEQ; const int q0 = qb * 256;
  const bf16* ksrc[2]; bool kval[2];
#pragma unroll
  for (int i = 0; i < 2; ++i) { const int row = 8 * wid + 4 * i + (lane >> 4), gc = (lane & 15) ^ (row & 7); kval[i] = gc < 12;
    ksrc[i] = gc < 8 ? KN + (rowbase + row) * 512 + h * 64 + gc * 8 : KR + (rowbase + row) * 32 + ((gc - 8) & 3) * 8; }
  const int kstr0 = 512 * 64, kstr1 = 32 * 64;
  const bf16* vsrc; { const int kk = 8 * wid + ((lane & 31) >> 2), k = (kk & ~0xC) | ((kk & 4) << 1) | ((kk & 8) >> 1); vsrc = V + (rowbase + k) * 512 + h * 64 + (lane >> 5) * 32 + (lane & 3) * 8; }
  const unsigned kdst = lds0 + OFF_K + wid * 2048, vdst = lds0 + OFF_V + wid * 2048;
#define DMA_K(t, slot) do { _Pragma("unroll") for (int i_ = 0; i_ < 2; ++i_) { const bool isn = ((lane & 15) ^ ((4 * i_ + (lane >> 4)) & 7)) < 8; \
    if (kval[i_]) glds16(ksrc[i_] + (size_t)(t) * (isn ? kstr0 : kstr1), (unsigned)__builtin_amdgcn_readfirstlane(kdst + (slot) * SHM_K + i_ * 1024)); } } while (0)
#define DMA_V(t, slot) glds16(vsrc + (size_t)(t) * (512 * 64), (unsigned)__builtin_amdgcn_readfirstlane(vdst + (slot) * SHM_V))
  const int vb0 = (int)(lds0 + OFF_V) + v_rd_base(lane);
  float m_reg = 0.f; f32x16 o[2] = {}; f32x16 lacc = {}; f32x16 negm = {}; asm volatile("" : "+v"(negm));
  f32x16 pA0, pA1, pB0, pB1; float alA = 1.f, alB = 1.f; bf16x8 pa0, pa1, pa2, pa3;
  const int NT = 4 * qb + 4, NTw = 4 * qb + (wid >> 1) + 1;
#define RESC(a) do { if (__any((a) < 1.f)) { if (hi == 0) al_l[r32] = (a); asm volatile("s_waitcnt lgkmcnt(0)" ::: "memory"); \
    _Pragma("unroll") for (int r = 0; r < 16; ++r) { const float f_ = al_l[crow(r, hi)]; o[0][r] *= f_; o[1][r] *= f_; lacc[r] *= f_; } } } while (0)
  int sk = 0, sv = 2;
#define ROT3(s) ((s) == 2 ? 0 : (s) + 1)
#define STEP(C0, C1, ALC, P0, P1, ALP, t, FIRST) do { \
    const int nk_ = ((t) + 2 < NT) ? 2 : 0, nv_ = ((t) + 1 < NT) ? 1 : 0; \
    if (nk_) DMA_K((t) + 2, (sk == 0 ? 2 : sk - 1)); if (nv_) DMA_V((t) + 1, (sv == 0 ? 2 : sv - 1)); \
    const bool vc_ = (t) < NTw, vp_ = !(FIRST) && ((t) - 1) < NTw; \
    if (vc_) { SBAR(); qkt_c<6>(C0, C1, negm, lds + OFF_K + sk * SHM_K, qr, r32, hi); } \
    if (vp_) { finishSM2(P0, P1, pa0, pa1, pa2, pa3); SBAR(); pv2l(o[0], o[1], lacc, vb0 + sv * SHM_V, pa0, pa1, pa2, pa3); } \
    if (vc_) { partialSM2(C0, C1, m_reg, negm, ALC, (FIRST)); RESC(ALC); } \
    if (nk_ + nv_ == 3) WAIT_BAR(3); else if (nk_ + nv_ == 1) WAIT_BAR(1); else WAIT_BAR(0); \
    sk = ROT3(sk); sv = ROT3(sv); } while (0)
  DMA_K(0, 0); DMA_V(0, 0); DMA_K(1, 1);
  if (!have_q) { const bf16* Qw = Q + (rowbase + q0 + wid * QBLK + r32) * 768 + h * 96 + hi * 8;
#pragma unroll
    for (int d0 = 0; d0 < 6; ++d0) qr[d0] = *reinterpret_cast<const bf16x8*>(Qw + d0 * 16);
#pragma unroll
    for (int d0 = 0; d0 < 6; ++d0) asm volatile("" : "+v"(qr[d0])); }
  WAIT_BAR(0);
  STEP(pA0, pA1, alA, pB0, pB1, alB, 0, true);
  for (int t = 1; t + 1 < NT; t += 2) {
    STEP(pB0, pB1, alB, pA0, pA1, alA, t, false);
    STEP(pA0, pA1, alA, pB0, pB1, alB, t + 1, false);
  }
  STEP(pB0, pB1, alB, pA0, pA1, alA, NT - 1, false);
  if (NT - 1 < NTw) { finishSM2(pB0, pB1, pa0, pa1, pa2, pa3); SBAR(); pv2l(o[0], o[1], lacc, vb0 + sv * SHM_V, pa0, pa1, pa2, pa3); }
  asm volatile("s_waitcnt vmcnt(0) lgkmcnt(0)\n\ts_barrier" ::: "memory");
  { char* T = lds + OFF_K + wid * 4608;
    bf16* Yw = Y + (rowbase + q0 + wid * QBLK) * ZY_LD + YA + h * 64;
    typedef unsigned u32x4a __attribute__((ext_vector_type(4)));
    u32x4a gv[4];
#pragma unroll
    for (int i = 0; i < 4; ++i) { const int c = lane + 64 * i; gv[i] = *(const u32x4a*)(Yw + (size_t)(c >> 3) * ZY_LD + (c & 7) * 8); }
    bf16x8 qn[6];
    if (has_next) { const bf16* Qn = Q + ((size_t)nb * SEQ + nqb * 256 + wid * QBLK + r32) * 768 + nh * 96 + hi * 8;
#pragma unroll
      for (int d0 = 0; d0 < 6; ++d0) qn[d0] = *reinterpret_cast<const bf16x8*>(Qn + d0 * 16); }
#pragma unroll
    for (int r = 0; r < 16; ++r) { const int orow = crow(r, hi); const float rl = __builtin_amdgcn_rcpf(lacc[r]);
#pragma unroll
      for (int d0 = 0; d0 < 2; ++d0) *(bf16*)(T + orow * 144 + (d0 * 32 + r32) * 2) = (bf16)f2bf(o[d0][r] * rl); }
    asm volatile("s_waitcnt lgkmcnt(0)" ::: "memory");
#pragma unroll
    for (int i = 0; i < 4; ++i) { const int c = lane + 64 * i; const u32x4a tv = *(const u32x4a*)(T + (c >> 3) * 144 + (c & 7) * 16); u32x4a ov;
#pragma unroll
      for (int k = 0; k < 4; ++k) { const float lo = __uint_as_float(tv[k] << 16) * __uint_as_float(gv[i][k] << 16), hi2 = __uint_as_float(tv[k] & 0xffff0000u) * __uint_as_float(gv[i][k] & 0xffff0000u);
        ov[k] = (unsigned)f2bf(lo) | ((unsigned)f2bf(hi2) << 16); }
      *(u32x4a*)(Yw + (size_t)(c >> 3) * ZY_LD + (c & 7) * 8) = ov; }
    if (has_next) {
#pragma unroll
      for (int d0 = 0; d0 < 6; ++d0) qr[d0] = qn[d0]; } }
  asm volatile("s_waitcnt vmcnt(0) lgkmcnt(0)\n\ts_barrier" ::: "memory");
#undef DMA_K
#undef DMA_V
#undef RESC
#undef ROT3
#undef STEP
}
#undef WAIT_BAR
#undef KSWZ
#undef SBAR
}
namespace mls {
using att::bf16x8; using att::s16x4; using att::f32x16; using att::u32x4;
typedef unsigned u32x2g __attribute__((ext_vector_type(2)));
__device__ __forceinline__ float blo(unsigned w) { return __uint_as_float(w << 16); }
__device__ __forceinline__ float bhi(unsigned w) { return __uint_as_float(w & 0xffff0000u); }
constexpr int SHM_V = 16384, SHM_K = 16384, SHM_AP = 256, OFF_ST = 2 * SHM_V + 2 * SHM_K + 2 * SHM_AP + 512  , OFF_NS = OFF_ST + 16384, OFF_MX = OFF_NS + 256, SHM_TOT = OFF_MX + 64;
#define KSWZ(row, colB) ((row) * 256 + ((colB) ^ (((row) & 7) << 4)))
__device__ __forceinline__ void mlstm_unit(int b, int h, int qb, const bf16* __restrict__ ZT, const float* __restrict__ MLS, const float* __restrict__ gmh, const bf16* __restrict__ CK, const float* __restrict__ NK, const float* __restrict__ ML, bf16* Y, char* lds) {
  int tid = threadIdx.x; asm volatile("" : "+v"(tid));
  const int wid = __builtin_amdgcn_readfirstlane(tid >> 6), lane = tid & 63, r32 = lane & 31, hi = lane >> 5;
  char* V_lds = lds; char* K_lds = lds + 2 * SHM_V; float* AP = (float*)(lds + 2 * SHM_V + 2 * SHM_K);
  const size_t rowbase = (size_t)b * SEQ; const int q0 = qb * 256, tq = q0 + wid * 32 + r32; const size_t qrow = rowbase + tq;
  bf16x8 qr[4];
#pragma unroll
  for (int d0 = 0; d0 < 4; ++d0) qr[d0] = *reinterpret_cast<const bf16x8*>(ZT + qrow * ZT_LD + ZT_MQ + h * 64 + d0 * 16 + hi * 8);
  const f32x4 me = *(const f32x4*)(MLS + (qrow * 4 + h) * 4); const float At2 = me.y * 1.4426950409f, mt = me.z;
  const int sr = tid >> 4, sc = (tid & 15) * 8, vst0 = att::v_st(sr, sc), vst1 = att::v_st(32 + sr, sc); const bool doK = sc < 64;
  const bf16* ksrc = ZT + rowbase * ZT_LD + ZT_MK + h * 64 + (sc & 63); const bf16* vsrc = ZT + rowbase * ZT_LD + ZT_MV + h * 128 + sc;
  const int vb0 = (int)(uintptr_t)V_lds + att::v_rd_base(lane);
  bf16x8 vs0, vs1, ks0, ks1; float aps = 0.f;
#define SLOAD(k0) do { vs0 = *(const bf16x8*)(vsrc + (size_t)((k0) + sr) * ZT_LD); vs1 = *(const bf16x8*)(vsrc + (size_t)((k0) + 32 + sr) * ZT_LD); \
    if (doK) { ks0 = *(const bf16x8*)(ksrc + (size_t)((k0) + sr) * ZT_LD); ks1 = *(const bf16x8*)(ksrc + (size_t)((k0) + 32 + sr) * ZT_LD); } \
    if (tid < 64) aps = MLS[((rowbase + (k0) + tid) * 4 + h) * 4] * 1.4426950409f; } while (0)
#define SWRITE(bb) do { *(bf16x8*)(V_lds + (bb) * SHM_V + vst0) = vs0; *(bf16x8*)(V_lds + (bb) * SHM_V + vst1) = vs1; \
    if (doK) { const int kc = sc * 2; *(bf16x8*)(K_lds + (bb) * SHM_K + KSWZ(sr, kc)) = ks0; *(bf16x8*)(K_lds + (bb) * SHM_K + KSWZ(32 + sr, kc)) = ks1; } \
    if (tid < 64) AP[(bb) * 64 + tid] = aps; } while (0)
  f32x16 o[4] = {}; float den = 0.f;
  const int J0 = 4 * qb, NT = 4 * qb + 4, jd = 4 * qb + (wid >> 1);
  SLOAD(J0 * 64);
  if (qb > 0) {
    float* MX = (float*)(lds + OFF_MX); float* NS = (float*)(lds + OFF_NS); const int u0 = (b * 4 + h) * 16;
    if (tid < 16) { float Mj = -INFINITY; if (tid < qb) { float Bst = 0.f; if (tid > 0) { const f32x4 pr = *(const f32x4*)(MLS + ((rowbase + tid * 256 - 1) * 4 + h) * 4); Bst = pr.z - pr.y; } Mj = ML[u0 + tid] - Bst; } MX[tid] = Mj * 1.4426950409f; }
    __syncthreads();
    float Mp = MX[0];
    for (int j = 1; j < qb; ++j) Mp = fmaxf(Mp, MX[j]);
    float c0[8], c1[8]; float ns = 0.f;
#pragma unroll
    for (int e = 0; e < 8; ++e) { c0[e] = 0.f; c1[e] = 0.f; }
    for (int j0 = 0; j0 < qb; j0 += 4) {
      v4u x0[4], x1[4]; float fj[4], nk[4];
#pragma unroll
      for (int d = 0; d < 4; ++d) { const int j = j0 + d; const bool ok = j < qb; const int jj = ok ? j : j0; fj[d] = ok ? __builtin_amdgcn_exp2f(MX[jj] - Mp) : 0.f;
        const bf16* cj = CK + (size_t)(u0 + jj) * 8192 + sc; x0[d] = *(const v4u*)(cj + sr * 128); x1[d] = *(const v4u*)(cj + (32 + sr) * 128); nk[d] = tid < 64 ? NK[(u0 + jj) * 64 + tid] : 0.f; }
#pragma unroll
      for (int d = 0; d < 4; ++d) { const float f = fj[d];
#pragma unroll
        for (int k = 0; k < 4; ++k) { c0[2 * k] += f * blo(x0[d][k]); c0[2 * k + 1] += f * bhi(x0[d][k]); c1[2 * k] += f * blo(x1[d][k]); c1[2 * k + 1] += f * bhi(x1[d][k]); }
        ns += f * nk[d]; } }
    { v4u w0, w1;
#pragma unroll
      for (int k = 0; k < 4; ++k) { w0[k] = pk2(c0[2 * k], c0[2 * k + 1]); w1[k] = pk2(c1[2 * k], c1[2 * k + 1]); }
      *(v4u*)(lds + OFF_ST + vst0) = w0; *(v4u*)(lds + OFF_ST + vst1) = w1; if (tid < 64) NS[tid] = ns; }
    __syncthreads();
    const float ft = __builtin_amdgcn_exp2f(Mp - At2); bf16x8 qs[4]; float dn = 0.f;
#pragma unroll
    for (int d0 = 0; d0 < 4; ++d0) { const u32x4 qw = __builtin_bit_cast(u32x4, qr[d0]); u32x4 sw; const f32x4 n0 = *(const f32x4*)(NS + 16 * d0 + 8 * hi), n1 = *(const f32x4*)(NS + 16 * d0 + 8 * hi + 4);
      const float nn[8] = {n0[0], n0[1], n0[2], n0[3], n1[0], n1[1], n1[2], n1[3]};
#pragma unroll
      for (int k = 0; k < 4; ++k) { const float a = blo(qw[k]), c = bhi(qw[k]); dn += a * nn[2 * k] + c * nn[2 * k + 1]; sw[k] = pk2(ft * a, ft * c); }
      qs[d0] = __builtin_bit_cast(bf16x8, sw); }
    den += ft * dn;
    const int vbs = (int)(uintptr_t)(lds + OFF_ST) + att::v_rd_base(lane);
    att::pv_one<0, true>(o[0], vbs, qs[0], qs[1], qs[2], qs[3]); att::pv_one<1, true>(o[1], vbs, qs[0], qs[1], qs[2], qs[3]);
    att::pv_one<2, true>(o[2], vbs, qs[0], qs[1], qs[2], qs[3]); att::pv_one<3, true>(o[3], vbs, qs[0], qs[1], qs[2], qs[3]);
  }
  SWRITE(J0 & 1); __syncthreads();
  for (int j = J0; j < NT; ++j) { const int bb = j & 1;
    if (j + 1 < NT) SLOAD((j + 1) * 64);
    if (j <= jd) {
      f32x16 p0, p1; att::qkt<4>(p0, p1, K_lds + bb * SHM_K, qr, r32, hi);
      const float* ap = AP + bb * 64;
#pragma unroll
      for (int g = 0; g < 4; ++g) { const f32x4 a0 = *(const f32x4*)(ap + 8 * g + 4 * hi), a1 = *(const f32x4*)(ap + 32 + 8 * g + 4 * hi);
#pragma unroll
        for (int e = 0; e < 4; ++e) { p0[4 * g + e] *= __builtin_amdgcn_exp2f(a0[e] - At2); p1[4 * g + e] *= __builtin_amdgcn_exp2f(a1[e] - At2); } }
      if (j == jd) { const int kb = 64 * j + 4 * hi;
#pragma unroll
        for (int r = 0; r < 16; ++r) { const int kv = kb + (r & 3) + 8 * (r >> 2); if (kv > tq) p0[r] = 0.f; if (kv + 32 > tq) p1[r] = 0.f; } }
      float ps = 0.f;
#pragma unroll
      for (int r = 0; r < 16; ++r) ps += p0[r] + p1[r];
      den += ps;
      bf16x8 pa0, pa1, pa2, pa3;
#define PK4(P, BASE, OUT) do { unsigned a0_ = att::cvtpk(P[BASE + 0], P[BASE + 1]), a1_ = att::cvtpk(P[BASE + 2], P[BASE + 3]);   \
    unsigned b0_ = att::cvtpk(P[BASE + 4], P[BASE + 5]), b1_ = att::cvtpk(P[BASE + 6], P[BASE + 7]);                              \
    auto r0 = __builtin_amdgcn_permlane32_swap(a0_, b0_, false, false); auto r1 = __builtin_amdgcn_permlane32_swap(a1_, b1_, false, false); \
    u32x4 w = {r0[0], r1[0], r0[1], r1[1]}; OUT = __builtin_bit_cast(bf16x8, w); } while (0)
      PK4(p0, 0, pa0); PK4(p0, 8, pa1); PK4(p1, 0, pa2); PK4(p1, 8, pa3);
#undef PK4
      const int vb = vb0 + bb * SHM_V;
      att::pv_one<0, true>(o[0], vb, pa0, pa1, pa2, pa3); att::pv_one<1, true>(o[1], vb, pa0, pa1, pa2, pa3);
      att::pv_one<2, true>(o[2], vb, pa0, pa1, pa2, pa3); att::pv_one<3, true>(o[3], vb, pa0, pa1, pa2, pa3);
    }
    if (j + 1 < NT) SWRITE(bb ^ 1);
    __syncthreads();
  }
  { auto rr = __builtin_amdgcn_permlane32_swap(__float_as_uint(den), __float_as_uint(den), false, false); den = __uint_as_float(rr[0]) + __uint_as_float(rr[1]); }
  const float rd = __builtin_amdgcn_rcpf(fmaxf(fabsf(den), __builtin_amdgcn_exp2f(-mt * 1.4426950409f)));
  float ss = 0.f;
#pragma unroll
  for (int d = 0; d < 4; ++d)
#pragma unroll
    for (int r = 0; r < 16; ++r) ss += o[d][r] * o[d][r];
  { auto rr = __builtin_amdgcn_permlane32_swap(__float_as_uint(ss), __float_as_uint(ss), false, false); ss = __uint_as_float(rr[0]) + __uint_as_float(rr[1]); }
  const float rn = rd * __builtin_amdgcn_rsqf(rd * rd * ss * (1.f / 128.f) + RMS_EPS);
  { const float* gm = gmh + h * 128; char* T = lds + wid * 8704;
    bf16* yw = Y + (rowbase + q0 + wid * 32) * ZY_LD + YB + h * 128;
    typedef unsigned u32x4m __attribute__((ext_vector_type(4)));
    u32x4m og[8];
#pragma unroll
    for (int i = 0; i < 8; ++i) { const int c = lane + 64 * i; og[i] = *(const u32x4m*)(yw + (size_t)(c >> 4) * ZY_LD + (c & 15) * 8); }
#pragma unroll
    for (int d = 0; d < 4; ++d)
#pragma unroll
      for (int g = 0; g < 4; ++g) { const int c = 32 * d + 8 * g + 4 * hi; const f32x4 gv = *(const f32x4*)(gm + c); u32x2g w;
        w.x = pk2(o[d][4 * g] * rn * gv[0], o[d][4 * g + 1] * rn * gv[1]); w.y = pk2(o[d][4 * g + 2] * rn * gv[2], o[d][4 * g + 3] * rn * gv[3]);
        *(u32x2g*)(T + r32 * 272 + c * 2) = w; }
    asm volatile("s_waitcnt lgkmcnt(0)" ::: "memory");
#pragma unroll
    for (int i = 0; i < 8; ++i) { const int c = lane + 64 * i; const u32x4m tv = *(const u32x4m*)(T + (c >> 4) * 272 + (c & 15) * 16); u32x4m ov;
#pragma unroll
      for (int k = 0; k < 4; ++k) ov[k] = pk2(blo(tv[k]) * blo(og[i][k]), bhi(tv[k]) * bhi(og[i][k]));
      *(u32x4m*)(yw + (size_t)(c >> 4) * ZY_LD + (c & 15) * 8) = ov; } }
  __syncthreads();
#undef SLOAD
#undef SWRITE
}

__device__ __forceinline__ void mlstm_summary(int u, int h, size_t r0, const bf16* __restrict__ ZT, const float* __restrict__ GIF, float fb, bf16* CK, float* NK, float* ML, char* lds) {
  int tid = threadIdx.x; asm volatile("" : "+v"(tid));
  const int wid = __builtin_amdgcn_readfirstlane(tid >> 6), lane = tid & 63, r32 = lane & 31, hi = lane >> 5;
  char* Kt = lds; char* Vt = lds + 16384; float* WL = (float*)(lds + 32768); float* RED = (float*)(lds + 32768 + 1024); float* NKP = (float*)(lds + 32768 + 2048);
  float lf = 0.f, ai = 0.f; if (tid < 256) { const float f = GIF[(r0 + tid) * 8 + 4 + h] + fb; lf = fminf(f, 0.f) - 0.69314718056f * __builtin_amdgcn_logf(1.f + __builtin_amdgcn_exp2f(-1.4426950409f * fabsf(f))); ai = GIF[(r0 + tid) * 8 + h]; }
  float incl = lf;
#pragma unroll
  for (int o = 1; o < 64; o <<= 1) { const float t = __int_as_float(__builtin_amdgcn_ds_bpermute(((lane - o) & 63) << 2, __float_as_int(incl))); if (lane >= o) incl += t; }
  if (lane == 63) RED[wid] = incl;
  __syncthreads();
  float B = incl;
#pragma unroll
  for (int w = 0; w < 4; ++w) if (w < wid) B += RED[w];
  float a = tid < 256 ? ai - B : -INFINITY, mx = a;
  mx = fmaxf(mx, __int_as_float(__builtin_amdgcn_ds_swizzle(__float_as_int(mx), (1 << 10) | 0x1f))); mx = fmaxf(mx, __int_as_float(__builtin_amdgcn_ds_swizzle(__float_as_int(mx), (2 << 10) | 0x1f)));
  mx = fmaxf(mx, __int_as_float(__builtin_amdgcn_ds_swizzle(__float_as_int(mx), (4 << 10) | 0x1f))); mx = fmaxf(mx, __int_as_float(__builtin_amdgcn_ds_swizzle(__float_as_int(mx), (8 << 10) | 0x1f)));
  mx = fmaxf(mx, __int_as_float(__builtin_amdgcn_ds_swizzle(__float_as_int(mx), (16 << 10) | 0x1f)));
  { auto rr = __builtin_amdgcn_permlane32_swap(__float_as_uint(mx), __float_as_uint(mx), false, false); mx = fmaxf(__uint_as_float(rr[0]), __uint_as_float(rr[1])); }
  if (lane == 0) RED[8 + wid] = mx;
  __syncthreads();
  const float Mloc = fmaxf(fmaxf(RED[8], RED[9]), fmaxf(RED[10], RED[11]));
  if (tid < 256) WL[tid] = __builtin_amdgcn_exp2f((a - Mloc) * 1.4426950409f);
  __syncthreads();
  const int sr = tid >> 4, sc = (tid & 15) * 8, vst0 = att::v_st(sr, sc), vst1 = att::v_st(32 + sr, sc); const bool doK = sc < 64;
  const int ab = wid & 1, db = wid >> 1;
  const int vbk = (int)(uintptr_t)Kt + att::v_rd_base(lane) + ab * 512, vbv = (int)(uintptr_t)Vt + att::v_rd_base(lane) + db * 512;
  f32x16 acc = {}; float nk8[8];
#pragma unroll
  for (int e = 0; e < 8; ++e) nk8[e] = 0.f;
  v4u vs0, vs1, x0 = {0u, 0u, 0u, 0u}, x1 = {0u, 0u, 0u, 0u};
#define MS_LOAD(st_) do { const size_t ra_ = r0 + (st_) * 64 + sr, rb_ = ra_ + 32; vs0 = *(const v4u*)(ZT + ra_ * ZT_LD + ZT_MV + h * 128 + sc); vs1 = *(const v4u*)(ZT + rb_ * ZT_LD + ZT_MV + h * 128 + sc); \
    if (doK) { x0 = *(const v4u*)(ZT + ra_ * ZT_LD + ZT_MK + h * 64 + sc); x1 = *(const v4u*)(ZT + rb_ * ZT_LD + ZT_MK + h * 64 + sc); } } while (0)
  MS_LOAD(0);
  for (int st = 0; st < 4; ++st) { v4u k0 = {0u, 0u, 0u, 0u}, k1 = {0u, 0u, 0u, 0u}; const v4u w0v = vs0, w1v = vs1;
    if (doK) { const float w0 = WL[st * 64 + sr], w1 = WL[st * 64 + 32 + sr];
#pragma unroll
      for (int k = 0; k < 4; ++k) { const float a0 = w0 * blo(x0[k]), b0 = w0 * bhi(x0[k]), a1 = w1 * blo(x1[k]), b1 = w1 * bhi(x1[k]); nk8[2 * k] += a0 + a1; nk8[2 * k + 1] += b0 + b1; k0[k] = pk2(a0, b0); k1[k] = pk2(a1, b1); } }
    if (st > 0) __syncthreads();
    *(v4u*)(Vt + vst0) = w0v; *(v4u*)(Vt + vst1) = w1v; if (doK) { *(v4u*)(Kt + vst0) = k0; *(v4u*)(Kt + vst1) = k1; }
    if (st + 1 < 4) MS_LOAD(st + 1);
    __syncthreads();
    att::pv_kv(acc, vbk, vbv); }
#undef MS_LOAD
  if (doK) { *(f32x4*)(NKP + sr * 64 + sc) = (f32x4){nk8[0], nk8[1], nk8[2], nk8[3]}; *(f32x4*)(NKP + sr * 64 + sc + 4) = (f32x4){nk8[4], nk8[5], nk8[6], nk8[7]}; }
  __syncthreads();
  bf16* ck = CK + (size_t)u * 8192 + (ab * 32) * 128 + db * 32 + r32;
#pragma unroll
  for (int r = 0; r < 16; ++r) ck[att::crow(r, hi) * 128] = (bf16)f2bf(acc[r]);
  if (tid < 64) { float s = 0.f;
#pragma unroll 8
    for (int q = 0; q < 32; ++q) s += NKP[q * 64 + tid];
    NK[u * 64 + tid] = s; }
  if (tid == 0) ML[u] = Mloc;
  __syncthreads();
}
#undef KSWZ
}
namespace sgu {
using att::bf16x8; using att::f32x16;
typedef float f32x2s __attribute__((ext_vector_type(2)));
typedef unsigned u32x2s __attribute__((ext_vector_type(2)));
__device__ __forceinline__ float blo(unsigned w) { return __uint_as_float(w << 16); }
__device__ __forceinline__ float bhi(unsigned w) { return __uint_as_float(w & 0xffff0000u); }
__device__ __forceinline__ void sgu_unit(int bn, int g, const bf16* __restrict__ ZT, const float* __restrict__ PVS, const bf16* __restrict__ WS, const float* __restrict__ gsv, const float* __restrict__ bs, bf16* Y, char* lds) {
  int tid = threadIdx.x; asm volatile("" : "+v"(tid));
  const int wid = __builtin_amdgcn_readfirstlane(tid >> 6), lane = tid & 63, r32 = lane & 31, hi = lane >> 5;
  char* V_lds = lds; f32x2s* st = (f32x2s*)(lds + 32768);
  const size_t base = (size_t)bn * 128;
  const int sr = tid >> 4, sc = (tid & 15) * 8;
  const int tb = wid & 3, ch = wid >> 2, t = 32 * tb + r32;
  v4u xv[4];
#pragma unroll
  for (int q = 0; q < 4; ++q) xv[q] = __builtin_nontemporal_load((const v4u*)(ZT + (base + 32 * q + sr) * ZT_LD + ZT_V + g * 128 + sc));
  f32x2s pp[8];
  if (tid < 128) {
#pragma unroll
    for (int k = 0; k < 8; ++k) pp[k] = *(const f32x2s*)(PVS + ((base + tid) * 8 + k) * 2); }
  bf16* yw = Y + (base + 32 * tb) * ZY_LD + YD + g * 128 + 64 * ch;
  v4u ugv[4];
#pragma unroll
  for (int i = 0; i < 4; ++i) { const int c = lane + 64 * i; ugv[i] = *(const v4u*)(yw + (size_t)(c >> 3) * ZY_LD + (c & 7) * 8); }
  if (tid < 128) { float s1 = 0.f, s2 = 0.f;
#pragma unroll
    for (int k = 0; k < 8; ++k) { s1 += pp[k].x; s2 += pp[k].y; }
    const float mean = s1 * (1.f / 512.f), var = fmaxf(s2 * (1.f / 512.f) - mean * mean, 0.f); f32x2s o; o.x = mean; o.y = __builtin_amdgcn_rsqf(var + RMS_EPS); st[tid] = o; }
  __syncthreads();
#pragma unroll
  for (int q = 0; q < 4; ++q) { const int s = 32 * q + sr; const f32x2s ms = st[s]; const v4u x = xv[q]; v4u w;
#pragma unroll
    for (int k = 0; k < 4; ++k) w[k] = pk2((blo(x[k]) - ms.x) * ms.y, (bhi(x[k]) - ms.x) * ms.y);
    *(v4u*)(V_lds + (q >> 1) * 16384 + att::v_st(32 * (q & 1) + sr, sc)) = w; }
  __syncthreads();
  f32x16 o[2] = {};
  const bf16* wrow = WS + ((size_t)g * 128 + t) * 128 + hi * 8;
  const int vb = (int)(uintptr_t)V_lds + att::v_rd_base(lane);
#pragma unroll
  for (int st_ = 0; st_ < 2; ++st_) { if (st_ == 1 && tb < 2) break;
    const bf16x8 pa0 = *(const bf16x8*)(wrow + 64 * st_), pa1 = *(const bf16x8*)(wrow + 64 * st_ + 16), pa2 = *(const bf16x8*)(wrow + 64 * st_ + 32), pa3 = *(const bf16x8*)(wrow + 64 * st_ + 48);
    if (ch == 0) { att::pv_one<0, true>(o[0], vb + st_ * 16384, pa0, pa1, pa2, pa3); att::pv_one<1, true>(o[1], vb + st_ * 16384, pa0, pa1, pa2, pa3); }
    else         { att::pv_one<2, true>(o[0], vb + st_ * 16384, pa0, pa1, pa2, pa3); att::pv_one<3, true>(o[1], vb + st_ * 16384, pa0, pa1, pa2, pa3); } }
  const float bt = bs[g * 128 + t]; const float* gp = gsv + g * 128 + 64 * ch;
  char* T = lds + 34816 + wid * 4608;
#pragma unroll
  for (int d = 0; d < 2; ++d)
#pragma unroll
    for (int q = 0; q < 4; ++q) { const int c = 32 * d + 8 * q + 4 * hi; const f32x4 gv = *(const f32x4*)(gp + c); u32x2s w;
      w.x = pk2(o[d][4 * q] * gv[0] + bt, o[d][4 * q + 1] * gv[1] + bt); w.y = pk2(o[d][4 * q + 2] * gv[2] + bt, o[d][4 * q + 3] * gv[3] + bt);
      *(u32x2s*)(T + r32 * 144 + c * 2) = w; }
  asm volatile("s_waitcnt lgkmcnt(0)" ::: "memory");
#pragma unroll
  for (int i = 0; i < 4; ++i) { const int c = lane + 64 * i; const v4u tv = *(const v4u*)(T + (c >> 3) * 144 + (c & 7) * 16); v4u ov;
#pragma unroll
    for (int k = 0; k < 4; ++k) ov[k] = pk2(blo(tv[k]) * blo(ugv[i][k]), bhi(tv[k]) * bhi(ugv[i][k]));
    *(v4u*)(yw + (size_t)(c >> 3) * ZY_LD + (c & 7) * 8) = ov; }
  __syncthreads();
}
}

typedef float f32x2g __attribute__((ext_vector_type(2)));
typedef unsigned u32x2g __attribute__((ext_vector_type(2)));
__device__ __forceinline__ float fexp2g(float x) { return __builtin_amdgcn_exp2f(x); }
struct Args { const void* in[23]; float* out; unsigned char* ws; int ph_lo, ph_hi; };
struct Frame {
    LAS unsigned char* lds; volatile LAS unsigned* MISC; gu32* ctl; unsigned char* ws;
    int tid, lane, wave, G, gw, NGW;
};
#define WSP(T, off) ((T*)(F.ws + (off)))

template <int X> __device__ __forceinline__ float swz_xor(float v) { return __int_as_float(__builtin_amdgcn_ds_swizzle(__float_as_int(v), (X << 10) | 0x1f)); }
__device__ __forceinline__ float sum_xor32(float v) { auto r = __builtin_amdgcn_permlane32_swap(__float_as_uint(v), __float_as_uint(v), false, false); return __uint_as_float(r[0]) + __uint_as_float(r[1]); }
__device__ __forceinline__ float wave_sum(float v) { v += swz_xor<1>(v); v += swz_xor<2>(v); v += swz_xor<4>(v); v += swz_xor<8>(v); v += swz_xor<16>(v); return sum_xor32(v); }
__device__ __forceinline__ float lane_up(float v, int lane, int o) { return __int_as_float(__builtin_amdgcn_ds_bpermute(((lane - o) & 63) << 2, __float_as_int(v))); }
__device__ __forceinline__ float bf2f(bf16 h) { return __uint_as_float((unsigned)h << 16); }
__device__ __forceinline__ float blo(unsigned w) { return __uint_as_float(w << 16); }
__device__ __forceinline__ float bhi(unsigned w) { return __uint_as_float(w & 0xffff0000u); }

template <int MAP> __device__ __forceinline__ void cvt_item(const float* W, int K, int Nsrc, const float* kscale, bf16* WT, LAS float* scr, int item, int nblk, int lane, int ldk = 0) {
    if (ldk == 0) ldk = K;
    const int kb = item / nblk, nb = item % nblk, k0 = 64 * kb, n0 = 32 * nb;
    float cs = 1.f; int sc; const int vc = n0 + 4 * (lane & 7);
    if (MAP == 0) sc = vc; else if (MAP == 1) sc = map_in(vc, cs); else if (MAP == 2) { sc = map_q(vc); cs = QSCALE; } else sc = map_kv(vc);
#pragma unroll
    for (int i = 0; i < 8; ++i) { const int kk = 8 * i + (lane >> 3); f32x4 v = {0.f, 0.f, 0.f, 0.f};
        if (sc >= 0) { v = __builtin_nontemporal_load((const GAS f32x4*)(W + (size_t)(k0 + kk) * Nsrc + sc)); float s = cs; if (kscale) s *= kscale[k0 + kk]; v = v * s; }
        LAS float* d = scr + kk * 33 + 4 * (lane & 7); d[0] = v.x; d[1] = v.y; d[2] = v.z; d[3] = v.w; }
    LDS_WAIT(); asm volatile("" ::: "memory");
    const int c = lane & 7;
#pragma unroll
    for (int j = 0; j < 4; ++j) { const int n = (lane >> 3) + 8 * j; const LAS float* s = scr + (8 * c) * 33 + n;
        v4u o; o.x = pk2(s[0 * 33], s[1 * 33]); o.y = pk2(s[2 * 33], s[3 * 33]); o.z = pk2(s[4 * 33], s[5 * 33]); o.w = pk2(s[6 * 33], s[7 * 33]);
        *(GAS v4u*)(WT + (size_t)(n0 + n) * ldk + k0 + 8 * c) = o; }
    LDS_WAIT(); asm volatile("" ::: "memory");
}
__device__ __forceinline__ void p0_weights_part(Frame& F, const Args& A, int l, int part, int w0, int nw) {
    LAS float* scr = (LAS float*)(F.lds + RING_OFF + F.wave * 16384);
    constexpr int I_UQ = 4 * 24, I_UKV = 2 * 32, I_P = 8 * 32, I_O = 16 * 32;
    if (part == 0) {
        for (int it = w0; it < I_UQ + I_UKV; it += nw) { int r = it;
            if (r < I_UQ) { cvt_item<2>(((const float*)A.in[9]) + (size_t)l * 256 * 768, 256, 768, ((const float*)A.in[7]) + l * 256, WSP(bf16, WS_WB + WB_UQ), scr, r, 24, F.lane); continue; } r -= I_UQ;
            cvt_item<3>(((const float*)A.in[10]) + (size_t)l * 128 * 1024, 128, 1024, ((const float*)A.in[8]) + l * 128, WSP(bf16, WS_WB + WB_UKV), scr, r, 32, F.lane); }
        const float* wsrc = ((const float*)A.in[16]) + (size_t)l * 65536; bf16* wd = WSP(bf16, WS_WB + WB_S);
        for (int i = w0 * 64 + F.lane; i < 65536; i += nw * 64) { const int t = (i >> 7) & 127, s = i & 127; wd[i] = (bf16)f2bf(s <= t ? wsrc[i] : 0.f); }
    } else {
        for (int it = w0; it < 4 * I_P + I_O; it += nw) { int r = it;
            if (r < 4 * I_P) { const int i = r / I_P; const float* wp = (const float*)A.in[18 + i]; cvt_item<0>(wp + (size_t)l * 512 * 1024, 512, 1024, nullptr, WSP(bf16, WS_WB + WB_P) + (size_t)(i >> 1) * 1024 * 1024 + (i & 1) * 512, scr, r % I_P, 32, F.lane, 1024); continue; } r -= 4 * I_P;
            cvt_item<0>(((const float*)A.in[22]) + (size_t)l * 1024 * 1024, 1024, 1024, nullptr, WSP(bf16, WS_WOUT), scr, r, 32, F.lane); }
    }
}
__device__ __forceinline__ void p0_weights(Frame& F, const Args& A, int l) {
    p0_weights_part(F, A, l, 0, F.gw, F.NGW);
    if (F.G != 256) p0_weights_part(F, A, l, 1, F.gw, F.NGW);
}
__device__ __forceinline__ void p2_wlate(Frame& F, const Args& A, int l) {
    if (F.G != 256 || blockIdx.x < 128) return;
    p0_weights_part(F, A, l, 1, ((int)blockIdx.x - 128) * NWAVES + F.wave, 128 * NWAVES);
    __syncthreads();
}
__device__ __forceinline__ float max_xor32(float v) { auto r = __builtin_amdgcn_permlane32_swap(__float_as_uint(v), __float_as_uint(v), false, false); return fmaxf(__uint_as_float(r[0]), __uint_as_float(r[1])); }
__device__ __forceinline__ float wave_max(float v) { v = fmaxf(v, swz_xor<1>(v)); v = fmaxf(v, swz_xor<2>(v)); v = fmaxf(v, swz_xor<4>(v)); v = fmaxf(v, swz_xor<8>(v)); v = fmaxf(v, swz_xor<16>(v)); return max_xor32(v); }
__device__ __forceinline__ unsigned pk4_i8(float a, float b, float c, float d) {
    const int ia = (int)__builtin_rintf(a), ib = (int)__builtin_rintf(b), ic = (int)__builtin_rintf(c), id = (int)__builtin_rintf(d);
    return ((unsigned)ia & 0xffu) | (((unsigned)ib & 0xffu) << 8) | (((unsigned)ic & 0xffu) << 16) | ((unsigned)id << 24); }
template <int MAP, int KI, int ROT> __device__ __forceinline__ void quant_cols(Frame& F, const float* W, int Nsrc, int nitems, unsigned char* dst, float* cdq) {
    LAS float* red = (LAS float*)(F.lds + RING_OFF);
    for (int it = blockIdx.x; it < nitems; it += F.G) {
        const int cg = F.tid & 7, n0 = it * 32 + 4 * cg, kg = F.tid >> 3, k0 = kg * 16; float cs = 1.f; const int sc = MAP == 1 ? map_in(n0, cs) : n0;
        const bool q8 = k0 < KI;
        f32x4 v[16]; f32x4 mx = {0.f, 0.f, 0.f, 0.f};
#pragma unroll
        for (int i = 0; i < 16; ++i) { v[i] = sc >= 0 ? __builtin_nontemporal_load((const GAS f32x4*)(W + (size_t)(k0 + i) * Nsrc + sc)) : (f32x4){0.f, 0.f, 0.f, 0.f};
            if (q8) { mx.x = fmaxf(mx.x, fabsf(v[i].x)); mx.y = fmaxf(mx.y, fabsf(v[i].y)); mx.z = fmaxf(mx.z, fabsf(v[i].z)); mx.w = fmaxf(mx.w, fabsf(v[i].w)); } }
#pragma unroll
        for (int c = 0; c < 4; ++c) { float t = mx[c]; t = fmaxf(t, swz_xor<8>(t)); t = fmaxf(t, swz_xor<16>(t)); mx[c] = max_xor32(t); }
        __syncthreads();
        if (F.lane < 8) { LAS float* d = red + F.wave * 32 + 4 * F.lane; d[0] = mx.x; d[1] = mx.y; d[2] = mx.z; d[3] = mx.w; }
        __syncthreads();
        f32x4 cm = {0.f, 0.f, 0.f, 0.f};
#pragma unroll
        for (int w = 0; w < 8; ++w) { const LAS float* s = red + w * 32 + 4 * cg; cm.x = fmaxf(cm.x, s[0]); cm.y = fmaxf(cm.y, s[1]); cm.z = fmaxf(cm.z, s[2]); cm.w = fmaxf(cm.w, s[3]); }
#pragma unroll
        for (int c = 0; c < 4; ++c) { unsigned char* drow = dst + (size_t)(n0 + c) * 2048;
            if (q8) { const float s = cm[c] > 0.f ? 127.f / cm[c] : 0.f; v4u o;
                o.x = pk4_i8(v[0][c] * s, v[1][c] * s, v[2][c] * s, v[3][c] * s); o.y = pk4_i8(v[4][c] * s, v[5][c] * s, v[6][c] * s, v[7][c] * s);
                o.z = pk4_i8(v[8][c] * s, v[9][c] * s, v[10][c] * s, v[11][c] * s); o.w = pk4_i8(v[12][c] * s, v[13][c] * s, v[14][c] * s, v[15][c] * s);
                *(GAS v4u*)(drow + ((k0 + ROT) & 1023)) = o;
                if (kg == 0) cdq[n0 + c] = cs * cm[c] * (1.f / 127.f); }
            else { v4u o0, o1; o0.x = pk2(v[0][c] * cs, v[1][c] * cs); o0.y = pk2(v[2][c] * cs, v[3][c] * cs); o0.z = pk2(v[4][c] * cs, v[5][c] * cs); o0.w = pk2(v[6][c] * cs, v[7][c] * cs);
                o1.x = pk2(v[8][c] * cs, v[9][c] * cs); o1.y = pk2(v[10][c] * cs, v[11][c] * cs); o1.z = pk2(v[12][c] * cs, v[13][c] * cs); o1.w = pk2(v[14][c] * cs, v[15][c] * cs);
                GAS v4u* d2 = (GAS v4u*)(drow + KI + 2 * (k0 - KI)); d2[0] = o0; d2[1] = o1; } }
    }
    __syncthreads();
}
struct QItem { const float* W; int Nsrc, n0, sc, KI, ROT; float cs; unsigned char* dst; float* cdq; };
constexpr int Q_NITEMS = NV_IN / 32 + 4096 / 32;
template <int KI8> __device__ __forceinline__ QItem q_item(Frame& F, const Args& A, int l, int it) {
    QItem q; const int cg = F.tid & 7; q.cs = 1.f;
    if (it < NV_IN / 32) { q.W = ((const float*)A.in[4]) + (size_t)l * 1024 * IN_DIM; q.Nsrc = IN_DIM; q.n0 = it * 32 + 4 * cg; q.sc = map_in(q.n0, q.cs); q.KI = KI8; q.ROT = 0; q.dst = WSP(unsigned char, WS_WB + WB_IN); q.cdq = WSP(float, WS_CDQI); }
    else { q.W = ((const float*)A.in[5]) + (size_t)l * 1024 * 4096; q.Nsrc = 4096; q.n0 = (it - NV_IN / 32) * 32 + 4 * cg; q.sc = q.n0; q.KI = 1024; q.ROT = 1024 - KI8; q.dst = WSP(unsigned char, WS_WB + WB_GATE); q.cdq = WSP(float, WS_CDQ); }
    return q;
}
__device__ __forceinline__ void q_load(Frame& F, const QItem& q, f32x4 (&v)[16]) {
    const int k0 = (F.tid >> 3) * 16;
#pragma unroll
    for (int i = 0; i < 16; ++i) v[i] = q.sc >= 0 ? __builtin_nontemporal_load((const GAS f32x4*)(q.W + (size_t)(k0 + i) * q.Nsrc + q.sc)) : (f32x4){0.f, 0.f, 0.f, 0.f};
}
__device__ __forceinline__ void q_finish(Frame& F, const QItem& q, f32x4 (&v)[16]) {
    LAS float* red = (LAS float*)(F.lds + RING_OFF);
    const int cg = F.tid & 7, kg = F.tid >> 3, k0 = kg * 16; const bool q8 = k0 < q.KI;
    f32x4 mx = {0.f, 0.f, 0.f, 0.f};
    if (q8) {
#pragma unroll
        for (int i = 0; i < 16; ++i) { mx.x = fmaxf(mx.x, fabsf(v[i].x)); mx.y = fmaxf(mx.y, fabsf(v[i].y)); mx.z = fmaxf(mx.z, fabsf(v[i].z)); mx.w = fmaxf(mx.w, fabsf(v[i].w)); } }
#pragma unroll
    for (int c = 0; c < 4; ++c) { float t = mx[c]; t = fmaxf(t, swz_xor<8>(t)); t = fmaxf(t, swz_xor<16>(t)); mx[c] = max_xor32(t); }
    __syncthreads();
    if (F.lane < 8) { LAS float* d = red + F.wave * 32 + 4 * F.lane; d[0] = mx.x; d[1] = mx.y; d[2] = mx.z; d[3] = mx.w; }
    __syncthreads();
    f32x4 cm = {0.f, 0.f, 0.f, 0.f};
#pragma unroll
    for (int w = 0; w < 8; ++w) { const LAS float* s = red + w * 32 + 4 * cg; cm.x = fmaxf(cm.x, s[0]); cm.y = fmaxf(cm.y, s[1]); cm.z = fmaxf(cm.z, s[2]); cm.w = fmaxf(cm.w, s[3]); }
#pragma unroll
    for (int c = 0; c < 4; ++c) { unsigned char* drow = q.dst + (size_t)(q.n0 + c) * 2048; const float cs = q.cs;
        if (q8) { const float s = cm[c] > 0.f ? 127.f / cm[c] : 0.f; v4u o;
            o.x = pk4_i8(v[0][c] * s, v[1][c] * s, v[2][c] * s, v[3][c] * s); o.y = pk4_i8(v[4][c] * s, v[5][c] * s, v[6][c] * s, v[7][c] * s);
            o.z = pk4_i8(v[8][c] * s, v[9][c] * s, v[10][c] * s, v[11][c] * s); o.w = pk4_i8(v[12][c] * s, v[13][c] * s, v[14][c] * s, v[15][c] * s);
            *(GAS v4u*)(drow + ((k0 + q.ROT) & 1023)) = o;
            if (kg == 0) q.cdq[q.n0 + c] = cs * cm[c] * (1.f / 127.f); }
        else { v4u o0, o1; o0.x = pk2(v[0][c] * cs, v[1][c] * cs); o0.y = pk2(v[2][c] * cs, v[3][c] * cs); o0.z = pk2(v[4][c] * cs, v[5][c] * cs); o0.w = pk2(v[6][c] * cs, v[7][c] * cs);
            o1.x = pk2(v[8][c] * cs, v[9][c] * cs); o1.y = pk2(v[10][c] * cs, v[11][c] * cs); o1.z = pk2(v[12][c] * cs, v[13][c] * cs); o1.w = pk2(v[14][c] * cs, v[15][c] * cs);
            GAS v4u* d2 = (GAS v4u*)(drow + q.KI + 2 * (k0 - q.KI)); d2[0] = o0; d2[1] = o1; } }
}
template <int KI8> __device__ __forceinline__ void p0_rows(Frame& F, const Args& A, int stage) {
    const float* xsrc = stage == 2 ? A.out : ((const float*)A.in[0]);
    f32x4 gpo[4], gpr[4];
#pragma unroll
    for (int j = 0; j < 4; ++j) { gpo[j] = stage >= 1 ? *((const GAS f32x4*)(((const float*)A.in[3]) + (stage - 1) * D) + F.lane + 64 * j) : (f32x4){0.f, 0.f, 0.f, 0.f};
        gpr[j] = stage < 2 ? *((const GAS f32x4*)(((const float*)A.in[2]) + stage * D) + F.lane + 64 * j) : (f32x4){0.f, 0.f, 0.f, 0.f}; }
    f32x4 v[4], vn[4]; u32x2g mo[4], mon[4]; float po = 0.f, pon = 0.f;
#define ROW_LOAD(V, MO, PO, m_) do { if (stage == 2) { _Pragma("unroll") for (int j = 0; j < 4; ++j) { const u32x2g xb_ = __builtin_nontemporal_load((const GAS u32x2g*)((const char*)A.out + (size_t)(m_) * 4096) + F.lane + 64 * j); V[j].x = __uint_as_float(xb_.x); V[j].y = __uint_as_float(xb_.y); } } \
        else { _Pragma("unroll") for (int j = 0; j < 4; ++j) V[j] = __builtin_nontemporal_load((const GAS f32x4*)(xsrc + (size_t)(m_) * D) + F.lane + 64 * j); } \
        if (stage >= 1) { _Pragma("unroll") for (int j = 0; j < 4; ++j) MO[j] = __builtin_nontemporal_load((const GAS u32x2g*)(WSP(bf16, WS_MO) + (size_t)(m_) * D) + F.lane + 64 * j); PO = F.lane < 16 ? WSP(float, WS_PO)[(size_t)(m_) * 16 + F.lane] : 0.f; } } while (0)
    int m = F.gw; if (m < M) ROW_LOAD(v, mo, po, m);
    for (; m < M; m += F.NGW) {
        const int mn = m + F.NGW; if (mn < M) ROW_LOAD(vn, mon, pon, mn);
        if (stage == 2) {
#pragma unroll
            for (int j = 0; j < 4; ++j) { const unsigned w0 = __float_as_uint(v[j].x), w1 = __float_as_uint(v[j].y); v[j].x = blo(w0); v[j].y = bhi(w0); v[j].z = blo(w1); v[j].w = bhi(w1); } }
        if (stage >= 1) {
            const float rs = __builtin_amdgcn_rsqf(wave_sum(po) * (1.f / 1024.f) + RMS_EPS);
#pragma unroll
            for (int j = 0; j < 4; ++j) { v[j].x += blo(mo[j].x) * rs * gpo[j].x; v[j].y += bhi(mo[j].x) * rs * gpo[j].y; v[j].z += blo(mo[j].y) * rs * gpo[j].z; v[j].w += bhi(mo[j].y) * rs * gpo[j].w;
                if (stage == 1) { u32x2g o; o.x = pk2(v[j].x, v[j].y); o.y = pk2(v[j].z, v[j].w); __builtin_nontemporal_store(o, (GAS u32x2g*)((char*)A.out + (size_t)m * 4096) + F.lane + 64 * j); }
                else __builtin_nontemporal_store(v[j], (GAS f32x4*)(A.out + (size_t)m * D) + F.lane + 64 * j); }
        }
        if (stage < 2) {
            float s2 = 0.f;
#pragma unroll
            for (int j = 0; j < 4; ++j) s2 += (v[j].x * v[j].x + v[j].y * v[j].y) + (v[j].z * v[j].z + v[j].w * v[j].w);
            const float rs = __builtin_amdgcn_rsqf(wave_sum(s2) * (1.f / D) + RMS_EPS);
#pragma unroll
            for (int j = 0; j < 4; ++j) { v[j].x *= rs * gpr[j].x; v[j].y *= rs * gpr[j].y; v[j].z *= rs * gpr[j].z; v[j].w *= rs * gpr[j].w; }
            float mx = 0.f;
#pragma unroll
            for (int j = 0; j < 4; ++j) mx = fmaxf(fmaxf(mx, fmaxf(fabsf(v[j].x), fabsf(v[j].y))), fmaxf(fabsf(v[j].z), fabsf(v[j].w)));
            mx = wave_max(mx); const float qs = mx > 0.f ? 127.f / mx : 0.f;
#pragma unroll
            for (int j = 0; j < 4; ++j) { unsigned char* hrow = WSP(unsigned char, WS_H) + (size_t)m * (H_LD * 2); const int k = 256 * j + 4 * F.lane;
                *(GAS unsigned*)(hrow + ((k + 1024 - KI8) & 1023)) = pk4_i8(v[j].x * qs, v[j].y * qs, v[j].z * qs, v[j].w * qs);
                if (256 * j >= KI8) { u32x2g o; o.x = pk2(v[j].x, v[j].y); o.y = pk2(v[j].z, v[j].w); *(GAS u32x2g*)(hrow + 1024 + 2 * (k - KI8)) = o; } }
            if (F.lane == 0) WSP(float, WS_RDQ)[m] = mx * (1.f / 127.f);
        }
#pragma unroll
        for (int j = 0; j < 4; ++j) { v[j] = vn[j]; mo[j] = mon[j]; } po = pon;
    }
#undef ROW_LOAD
}
template <int KI8> __device__ __forceinline__ void p0_all(Frame& F, const Args& A, int l) {
    const int nit = F.G == 256 ? NV_IN / 32 : Q_NITEMS;
    const int it0 = blockIdx.x; f32x4 qv[16]; QItem q0 = q_item<KI8>(F, A, l, it0 < nit ? it0 : 0);
    if (it0 < nit) q_load(F, q0, qv);
    p0_rows<KI8>(F, A, l);
    p0_weights(F, A, l);
    if (it0 < nit) q_finish(F, q0, qv);
    for (int it = it0 + F.G; it < nit; it += F.G) { QItem q = q_item<KI8>(F, A, l, it); q_load(F, q, qv); q_finish(F, q, qv); }
    __syncthreads();
}
template <int KI8> __device__ __forceinline__ void p2_gateq(Frame& F, const Args& A, int l) {
    if (F.G != 256 || blockIdx.x < 128) return;
    f32x4 qv[16]; QItem q = q_item<KI8>(F, A, l, NV_IN / 32 + ((int)blockIdx.x - 128)); q_load(F, q, qv); q_finish(F, q, qv);
    __syncthreads();
}
__device__ __forceinline__ void p0_rope(Frame& F, const Args& A) {
    const int gt = F.gw * 64 + F.lane, NT = F.NGW * 64;
    for (int i = gt; i < M * 16; i += NT) { const int row = i >> 4, j = i & 15;
        const float inv = exp2f(-(float)j * 0.83048202372184058f);     const float ang = (float)((const int*)A.in[1])[row] * inv; const double rv = (double)ang * 0.15915494309189535; const float fr = (float)(rv - rint(rv)); const float s = __builtin_amdgcn_sinf(fr), c = __builtin_amdgcn_cosf(fr);
        f32x2g o; o.x = c; o.y = s; *(GAS f32x2g*)(WSP(float, WS_ROPE) + (size_t)i * 2) = o; }
}
__device__ __forceinline__ void p2_conv(Frame& F, const Args& A, int l) {
    const float* wc = ((const float*)A.in[13]) + l * 3 * 512; const float* bc = ((const float*)A.in[14]) + l * 512; const int c0 = F.lane * 8;
    float w0[8], w1[8], w2[8], bb[8];
    { const f32x4 a0 = *(const GAS f32x4*)(wc + c0), a1 = *(const GAS f32x4*)(wc + c0 + 4), b0 = *(const GAS f32x4*)(wc + 512 + c0), b1 = *(const GAS f32x4*)(wc + 512 + c0 + 4),
                  d0 = *(const GAS f32x4*)(wc + 1024 + c0), d1 = *(const GAS f32x4*)(wc + 1024 + c0 + 4), e0 = *(const GAS f32x4*)(bc + c0), e1 = *(const GAS f32x4*)(bc + c0 + 4);
#pragma unroll
      for (int q = 0; q < 4; ++q) { w0[q] = a0[q]; w0[4 + q] = a1[q]; w1[q] = b0[q]; w1[4 + q] = b1[q]; w2[q] = d0[q]; w2[4 + q] = d1[q]; bb[q] = e0[q]; bb[4 + q] = e1[q]; } }
    for (int r0 = F.gw * 16; r0 < M; r0 += F.NGW * 16) {
        const int t0 = r0 & (SEQ - 1);
        const bf16* up = WSP(bf16, WS_ZT) + (size_t)r0 * ZT_LD + ZT_U + c0; bf16* gp = WSP(bf16, WS_ZY) + (size_t)r0 * ZY_LD + YC + c0;
        v4u um2 = {0u, 0u, 0u, 0u}, um1 = {0u, 0u, 0u, 0u};
        if (t0 > 0) { um2 = *(const GAS v4u*)(up - 2 * ZT_LD); um1 = *(const GAS v4u*)(up - ZT_LD); }
#pragma unroll
        for (int hb = 0; hb < 2; ++hb) { v4u uu[8], gg[8];
#pragma unroll
            for (int i = 0; i < 8; ++i) { uu[i] = __builtin_nontemporal_load((const GAS v4u*)(up + (size_t)(8 * hb + i) * ZT_LD)); gg[i] = __builtin_nontemporal_load((const GAS v4u*)(gp + (size_t)(8 * hb + i) * ZY_LD)); }
#pragma unroll
            for (int i = 0; i < 8; ++i) { v4u o;
#pragma unroll
                for (int q = 0; q < 4; ++q) {
                    const float ylo = w0[2 * q] * blo(um2[q]) + w1[2 * q] * blo(um1[q]) + w2[2 * q] * blo(uu[i][q]) + bb[2 * q];
                    const float yhi = w0[2 * q + 1] * bhi(um2[q]) + w1[2 * q + 1] * bhi(um1[q]) + w2[2 * q + 1] * bhi(uu[i][q]) + bb[2 * q + 1];
                    o[q] = pk2(blo(gg[i][q]) * ylo, bhi(gg[i][q]) * yhi); }
                *(GAS v4u*)(gp + (size_t)(8 * hb + i) * ZY_LD) = o; um2 = um1; um1 = uu[i]; } }
    }
}
__device__ __forceinline__ float logsig(float x) { return fminf(x, 0.f) - 0.69314718056f * __builtin_amdgcn_logf(1.f + __builtin_amdgcn_exp2f(-1.4426950409f * fabsf(x))); }
__device__ __forceinline__ void p2_mscan(Frame& F, const Args& A, int l) {
    if (blockIdx.x >= 32) return;
    const int b = blockIdx.x >> 2, h = blockIdx.x & 3, lane = F.lane, wave = F.wave; const float fb = ((const float*)A.in[11])[l * 4 + h];
    const size_t r0 = (size_t)b * SEQ + F.tid * 8; const float* G = WSP(float, WS_GIF); LAS float* X = (LAS float*)(F.lds + RING_OFF);
    float lf[8], ai[8];
#pragma unroll
    for (int i = 0; i < 8; ++i) { lf[i] = G[(r0 + i) * 8 + 4 + h]; ai[i] = G[(r0 + i) * 8 + h]; }
    float ls = 0.f;
#pragma unroll
    for (int i = 0; i < 8; ++i) { lf[i] = logsig(lf[i] + fb); ls += lf[i]; }
    float incl = ls;
#pragma unroll
    for (int o = 1; o < 64; o <<= 1) { const float t = lane_up(incl, lane, o); if (lane >= o) incl += t; }
    if (lane == 63) X[wave] = incl;
    __syncthreads();
    float B = incl - ls;
#pragma unroll
    for (int w = 0; w < 8; ++w) if (w < wave) B += X[w];
    float lm = -INFINITY;
#pragma unroll
    for (int i = 0; i < 8; ++i) { B += lf[i]; ai[i] -= B; lf[i] = B; lm = fmaxf(lm, ai[i]); }
    float im = lm;
#pragma unroll
    for (int o = 1; o < 64; o <<= 1) { const float t = lane_up(im, lane, o); if (lane >= o) im = fmaxf(im, t); }
    if (lane == 63) X[8 + wave] = im;
    __syncthreads();
    float run = lane_up(im, lane, 1); if (lane == 0) run = -INFINITY; run = fmaxf(run, 0.f);
#pragma unroll
    for (int w = 0; w < 8; ++w) if (w < wave) run = fmaxf(run, X[8 + w]);
    float* O = WSP(float, WS_MLS);
#pragma unroll
    for (int i = 0; i < 8; ++i) { run = fmaxf(run, ai[i]); f32x4 o; o.x = ai[i]; o.y = run; o.z = lf[i] + run; o.w = 0.f; *(GAS f32x4*)(O + ((r0 + i) * 4 + h) * 4) = o; }
    __syncthreads();
}
#if MK_NAIVE_SGU
__device__ __forceinline__ void p2_sgu_naive(Frame& F, const Args& A, int l) {
    LAS f32x2g* st = (LAS f32x2g*)(F.lds + RING_OFF);
    const int c = F.tid & 127, tq = F.tid >> 7;
    for (int u = blockIdx.x; u < 1024; u += F.G) { const int g = u & 3, bn = u >> 2; const size_t base = (size_t)bn * 128;
        if (F.tid < 128) { float s1 = 0.f, s2 = 0.f;
            for (int k = 0; k < 8; ++k) { const f32x2g p = *(const GAS f32x2g*)(WSP(float, WS_PVS) + ((base + F.tid) * 8 + k) * 2); s1 += p.x; s2 += p.y; }
            const float mean = s1 * (1.f / 512.f), var = fmaxf(s2 * (1.f / 512.f) - mean * mean, 0.f); f32x2g o; o.x = mean; o.y = 1.0f / sqrtf(var + RMS_EPS); st[F.tid] = o; }
        __syncthreads();
        const float* W = ((const float*)A.in[16]) + ((size_t)l * 4 + g) * 128 * 128;
        float acc[32];
#pragma unroll
        for (int i = 0; i < 32; ++i) acc[i] = 0.f;
        for (int s = 0; s < 128; ++s) { const f32x2g ms = st[s]; const float vn = (bf2f(WSP(bf16, WS_ZT)[(base + s) * ZT_LD + ZT_V + g * 128 + c]) - ms.x) * ms.y;
#pragma unroll
            for (int i = 0; i < 32; ++i) { const int tt = tq + 4 * i; if (tt >= s) acc[i] += W[tt * 128 + s] * vn; } }
        const float gs = ((const float*)A.in[15])[l * 512 + g * 128 + c];
#pragma unroll
        for (int i = 0; i < 32; ++i) { const int tt = tq + 4 * i; GAS bf16* p = (GAS bf16*)(WSP(bf16, WS_ZY) + (base + tt) * ZY_LD + YD + g * 128 + c);
            const float mixed = acc[i] * gs + ((const float*)A.in[17])[(l * 4 + g) * 128 + tt]; *p = (bf16)f2bf(bf2f(*p) * mixed); }
        __syncthreads();
    }
}
#endif
#if !MK_NAIVE_SGU
__device__ __forceinline__ void p2_sgu(Frame& F, const Args& A, int l) {
    for (int u = blockIdx.x; u < 1024; u += F.G)
        sgu::sgu_unit(u >> 2, u & 3, WSP(bf16, WS_ZT), WSP(float, WS_PVS), WSP(bf16, WS_WB + WB_S), ((const float*)A.in[15]) + l * 512, ((const float*)A.in[17]) + l * 512, WSP(bf16, WS_ZY), (char*)F.lds + RING_OFF);
}
#endif
#if MK_NAIVE_ATTN
__device__ __forceinline__ void p3_attn_naive(Frame& F, const Args& A, bf16* Yunused) {
    const int lane = F.lane;
    for (int pass = 0; pass < 2; ++pass) { const int u = pass == 0 ? F.gw : 4095 - F.gw; if (F.gw >= 2048) break;
        const int c = u & 63, h = (u >> 6) & 7, b = u >> 9; const size_t row = (size_t)b * SEQ + c * 64 + lane;
        v4u q[12];
#pragma unroll
        for (int i = 0; i < 12; ++i) q[i] = *(const GAS v4u*)(WSP(bf16, WS_Q) + row * 768 + h * 96 + 8 * i);
        float o[64];
#pragma unroll
        for (int i = 0; i < 64; ++i) o[i] = 0.f;
        float mx = -1e30f, lsum = 0.f; const int nk = 64 * (c + 1);
        for (int k0 = 0; k0 < nk; ++k0) { const size_t kr = (size_t)b * SEQ + k0; float a = 0.f;
#pragma unroll
            for (int i = 0; i < 8; ++i) { const v4u w = *(const GAS v4u*)(WSP(bf16, WS_KN) + kr * 512 + h * 64 + 8 * i);
#pragma unroll
                for (int k = 0; k < 4; ++k) a += blo(q[i][k]) * blo(w[k]) + bhi(q[i][k]) * bhi(w[k]); }
#pragma unroll
            for (int i = 0; i < 4; ++i) { const v4u w = *(const GAS v4u*)(WSP(bf16, WS_KR) + kr * 32 + 8 * i);
#pragma unroll
                for (int k = 0; k < 4; ++k) a += blo(q[8 + i][k]) * blo(w[k]) + bhi(q[8 + i][k]) * bhi(w[k]); }
            if (__any(a > mx)) { const float mn = fmaxf(a, mx), al = fexp2g(mx - mn); mx = mn; lsum *= al;
#pragma unroll
                for (int i = 0; i < 64; ++i) o[i] *= al; }
            const float p = fexp2g(a - mx); lsum += p;
#pragma unroll
            for (int i = 0; i < 8; ++i) { const v4u w = *(const GAS v4u*)(WSP(bf16, WS_V) + kr * 512 + h * 64 + 8 * i);
#pragma unroll
                for (int k = 0; k < 4; ++k) { o[8 * i + 2 * k] += p * blo(w[k]); o[8 * i + 2 * k + 1] += p * bhi(w[k]); } }
        }
        const float rl = 1.0f / lsum; GAS v4u* yp = (GAS v4u*)(WSP(bf16, WS_ZY) + row * ZY_LD + YA + h * 64);
#pragma unroll
        for (int i = 0; i < 8; ++i) { const v4u g = yp[i]; v4u w;
#pragma unroll
            for (int k = 0; k < 4; ++k) w[k] = pk2(o[8 * i + 2 * k] * rl * blo(g[k]), o[8 * i + 2 * k + 1] * rl * bhi(g[k]));
            yp[i] = w; }
    }
}
#endif
#if !MK_NAIVE_ATTN
#if MK_ATTN_V2 == 2
#define ATTN_UNIT attn_unit3
#elif MK_ATTN_V2
#define ATTN_UNIT attn_unit2
#else
#define ATTN_UNIT attn_unit
#endif
__device__ __forceinline__ void p3_attn(Frame& F, const Args& A, bf16* Y) {
    const int bx = blockIdx.x, vcu = (F.G % 8 == 0) ? (bx % 8) * (F.G / 8) + bx / 8 : bx;
    att::bf16x8 qr[6]; bool have_q = false;
    for (int u = vcu; u < 1024; u += F.G) { const int v = u & 255, i = u >> 8, bh = v >> 2, s = v & 3, qb = i == 0 ? s : i == 1 ? 7 - s : i == 2 ? 8 + s : 15 - s;
        const int un = u + F.G; const bool hn = un < 1024; const int vn = un & 255, in_ = un >> 8, bhn = vn >> 2, sn = vn & 3, qbn = in_ == 0 ? sn : in_ == 1 ? 7 - sn : in_ == 2 ? 8 + sn : 15 - sn;
        att::attn_unit2(bh >> 3, bh & 7, qb, WSP(bf16, WS_Q), WSP(bf16, WS_KN), WSP(bf16, WS_KR), WSP(bf16, WS_V), Y, (char*)F.lds + RING_OFF, qr, have_q, hn, bhn >> 3, bhn & 7, qbn);
        have_q = hn; }
}
#endif
#if MK_NAIVE_MLSTM
__device__ __forceinline__ void p3_mlstm_naive(Frame& F, const Args& A, int l, bf16* Yunused) {
    const int lane = F.lane, hf = lane >> 5;
    for (int pass = 0; pass < 2; ++pass) { const int u = pass == 0 ? F.gw : 4095 - F.gw; if (F.gw >= 2048) break;
        const int w = u & 127, h = (u >> 7) & 3, b = u >> 9; const int t = w * 32 + (lane & 31); const size_t row = (size_t)b * SEQ + t;
        v4u q[8];
#pragma unroll
        for (int i = 0; i < 8; ++i) q[i] = *(const GAS v4u*)(WSP(bf16, WS_ZT) + row * ZT_LD + ZT_MQ + h * 64 + 8 * i);
        float acc[64];
#pragma unroll
        for (int i = 0; i < 64; ++i) acc[i] = 0.f;
        const f32x4 me = *(const GAS f32x4*)(WSP(float, WS_MLS) + (row * 4 + h) * 4); const float At = me.y, mt = me.z; float den = 0.f;
        const int nk = 32 * (w + 1);
        for (int s = 0; s < nk; ++s) { const size_t sr = (size_t)b * SEQ + s; float dot = 0.f;
#pragma unroll
            for (int i = 0; i < 8; ++i) { const v4u x = *(const GAS v4u*)(WSP(bf16, WS_ZT) + sr * ZT_LD + ZT_MK + h * 64 + 8 * i);
#pragma unroll
                for (int k = 0; k < 4; ++k) dot += blo(q[i][k]) * blo(x[k]) + bhi(q[i][k]) * bhi(x[k]); }
            const float ap = WSP(float, WS_MLS)[(sr * 4 + h) * 4]; const float p = s <= t ? dot * fexp2g((ap - At) * 1.4426950409f) : 0.f; den += p;
#pragma unroll
            for (int i = 0; i < 8; ++i) { const v4u x = *(const GAS v4u*)(WSP(bf16, WS_ZT) + sr * ZT_LD + ZT_MV + h * 128 + hf * 64 + 8 * i);
#pragma unroll
                for (int k = 0; k < 4; ++k) { acc[8 * i + 2 * k] += p * blo(x[k]); acc[8 * i + 2 * k + 1] += p * bhi(x[k]); } } }
        const float rd = 1.0f / fmaxf(fabsf(den), fexp2g(-mt * 1.4426950409f)); float ss = 0.f;
#pragma unroll
        for (int i = 0; i < 64; ++i) ss += acc[i] * acc[i];
        ss = sum_xor32(ss);
        const float rn = rd * __builtin_amdgcn_rsqf(rd * rd * ss * (1.f / 128.f) + RMS_EPS);
        const float* gm = ((const float*)A.in[12]) + l * 512 + h * 128 + hf * 64;
        GAS v4u* yp = (GAS v4u*)(WSP(bf16, WS_ZY) + row * ZY_LD + YB + h * 128 + hf * 64);
#pragma unroll
        for (int i = 0; i < 8; ++i) { const v4u g = yp[i]; v4u o;
#pragma unroll
            for (int k = 0; k < 4; ++k) o[k] = pk2(acc[8 * i + 2 * k] * rn * gm[8 * i + 2 * k] * blo(g[k]), acc[8 * i + 2 * k + 1] * rn * gm[8 * i + 2 * k + 1] * bhi(g[k]));
            yp[i] = o; }
    }
}
#endif
#if !MK_NAIVE_MLSTM
__device__ __forceinline__ void p3_mlstm(Frame& F, const Args& A, int l, bf16* Y) {
    const int bx = blockIdx.x, vcu = (F.G % 8 == 0) ? (bx % 8) * (F.G / 8) + bx / 8 : bx;
    for (int u = vcu; u < 512; u += F.G) { const int bh = u >> 4, qb = (u < 256) ? (u & 15) : 15 - (u & 15);
        mls::mlstm_unit(bh >> 2, bh & 3, qb, WSP(bf16, WS_ZT), WSP(float, WS_MLS), ((const float*)A.in[12]) + l * 512, WSP(bf16, WS_MSUM), WSP(float, WS_MSUM + 8 * MiB), WSP(float, WS_MSUM + 8 * MiB + 256 * 1024), Y, (char*)F.lds + RING_OFF); }
}
__device__ __forceinline__ void p2_msum(Frame& F, const Args& A, int l) {
    for (int u = blockIdx.x; u < 512; u += F.G) { const int bh = u >> 4, J = u & 15, h = bh & 3;
        mls::mlstm_summary(u, h, (size_t)(bh >> 2) * SEQ + J * 256, WSP(bf16, WS_ZT), WSP(float, WS_GIF), ((const float*)A.in[11])[l * 4 + h], WSP(bf16, WS_MSUM), WSP(float, WS_MSUM + 8 * MiB), WSP(float, WS_MSUM + 8 * MiB + 256 * 1024), (char*)F.lds + RING_OFF); }
}
#endif

#if MK_NAIVE_MLSTM
#define P2_MSUM(F, a, l) do {} while (0)
#else
#define P2_MSUM p2_msum
#endif
#if MK_NAIVE_SGU
#define P2_SGU p2_sgu_naive
#else
#define P2_SGU p2_sgu
#endif
#if MK_NAIVE_MLSTM
#define P3_MLSTM p3_mlstm_naive
#else
#define P3_MLSTM p3_mlstm
#endif
#if MK_NAIVE_ATTN
#define P3_ATTN p3_attn_naive
#else
#define P3_ATTN p3_attn
#endif
__global__ void __launch_bounds__(NTHREADS, 2) mk_fwd(Args args) {
    extern __shared__ __attribute__((aligned(16))) unsigned char lds[];
    Frame F;
    F.lds = (LAS unsigned char*)lds; F.MISC = (volatile LAS unsigned*)(F.lds + MISC_OFF);
    F.tid = threadIdx.x; F.lane = F.tid & 63; F.wave = __builtin_amdgcn_readfirstlane(F.tid >> 6); F.G = gridDim.x; F.gw = blockIdx.x * NWAVES + F.wave; F.NGW = F.G * NWAVES;
    F.ws = args.ws; F.ctl = (gu32*)(F.ws + WS_CTL);
    const Args& A = args;
    for (int u = F.tid; u < (LDS_BYTES - LDSCTL_OFF) / 4; u += NTHREADS) ((LAS unsigned*)(F.lds + LDSCTL_OFF))[u] = 0u;
    __syncthreads();
    const int lo = args.ph_lo, hi = args.ph_hi;
    XcdBarrier bar; bar.bar = (unsigned*)(F.ctl + CW_BAR); bar.x = 0; bar.st = nullptr;
    if (hi - lo > 1) bar = xcd_barrier_post((unsigned*)(F.ctl + CW_BAR), F.MISC + 8);
#define IN(k) (lo <= (k) && (k) < hi)
#define PROBE(b) ((MK_PROBE >> (b)) & 1)
#define NREP(b) (1 + PROBE(b))
#define FRESH() do { int z_ = 0; asm volatile("" : "+v"(z_)); F.ws = args.ws + __builtin_amdgcn_readfirstlane(z_); int t_ = threadIdx.x; asm volatile("" : "+v"(t_)); F.tid = t_; F.lane = t_ & 63; \
        F.wave = __builtin_amdgcn_readfirstlane(t_ >> 6); F.gw = blockIdx.x * NWAVES + F.wave; } while (0)
#define SEAM(k) do { if (IN(k) && IN((k) + 1)) xcd_barrier(bar); } while (0)
    typedef pg8::StaticOrder SO;
#define LAYER(l) do { \
        const int pb = 6 * l; \
        if (IN(pb + 0)) for (int rep_ = 0; rep_ < NREP(3); ++rep_) { FRESH(); if (l == 0) p0_rope(F, args); FRESH(); p0_all<ki8_of(l)>(F, args, l); } \
        SEAM(pb + 0); \
        if (IN(pb + 1)) for (int rep_ = 0; rep_ < NREP(0); ++rep_) { FRESH(); \
            pg8::Gemm g{WSP(bf16, WS_H), WSP(bf16, WS_WB + WB_IN), M, NV_IN, 1024, H_LD}; SO S; S.init(M, NV_IN, F.G, (int)blockIdx.x, 64 * (ki8_of(l) / 128 + (1024 - ki8_of(l)) / 64)  , 1024u - ki8_of(l)); \
            pg8::EpiIn<ki8_of(l)> E{WSP(bf16, WS_ZT), WSP(bf16, WS_ZY), WSP(bf16, WS_KR), WSP(float, WS_PQ), WSP(float, WS_PKV), WSP(float, WS_PVS), WSP(float, WS_GIF), WSP(float, WS_ROPE), WSP(float, WS_RDQ), WSP(float, WS_CDQI)}; \
            pg8::gemm_phase<pg8::EpiIn<ki8_of(l)>, SO, true, true>(F.lds + RING_OFF, g, S, E); \
        } \
        SEAM(pb + 1); \
        if (IN(pb + 2)) { for (int rep_ = 0; rep_ < NREP(6); ++rep_) { FRESH(); \
            { pg8::Gemm g{WSP(bf16, WS_ZT) + ZT_CQ, WSP(bf16, WS_WB + WB_UQ), M, 768, 256, ZT_LD}; SO S; S.init(M, 768, F.G, (int)blockIdx.x, 256); pg8::EpiUpQ E{WSP(bf16, WS_Q), WSP(float, WS_PQ), WSP(float, WS_ROPE)}; \
              pg8::gemm_phase<pg8::EpiUpQ, SO, true, true>(F.lds + RING_OFF, g, S, E); } \
            FRESH(); if (rep_ == 0) { p2_gateq<ki8_of(l)>(F, args, l); FRESH(); p2_wlate(F, args, l); FRESH(); } \
            { pg8::Gemm g{WSP(bf16, WS_ZT) + ZT_CKV, WSP(bf16, WS_WB + WB_UKV), M, 1024, 128, ZT_LD}; SO S; S.init(M, 1024, F.G, (int)blockIdx.x, 128); pg8::EpiUpKV E{WSP(bf16, WS_KN), WSP(bf16, WS_V), WSP(float, WS_PKV)}; \
              pg8::gemm_phase<pg8::EpiUpKV, SO, true, true>(F.lds + RING_OFF, g, S, E); } \
            __syncthreads(); } \
            for (int rep_ = 0; rep_ < NREP(7); ++rep_) { FRESH(); \
            p2_mscan(F, args, l); FRESH(); \
            P2_MSUM(F, args, l); } \
            FRESH(); \
            p2_conv(F, args, l); FRESH(); \
            P2_SGU(F, args, l); \
        } \
        SEAM(pb + 2); \
        if (IN(pb + 3)) { FRESH(); P3_ATTN(F, args, WSP(bf16, WS_ZY)); if (PROBE(4) && l == 0) { FRESH(); P3_ATTN(F, args, (bf16*)args.out); } FRESH(); P3_MLSTM(F, args, l, WSP(bf16, WS_ZY)); if (PROBE(5) && l == 0) { FRESH(); P3_MLSTM(F, args, l, (bf16*)args.out); } } \
        SEAM(pb + 3); \
        if (IN(pb + 4)) for (int rep_ = 0; rep_ < NREP(1); ++rep_) { FRESH(); \
            pg8::Gemm g{WSP(bf16, WS_H), WSP(bf16, WS_WB + WB_GATE), M, 1024, 1024, H_LD}; pg8::P4Order S; S.init(M, F.G, (int)blockIdx.x, (unsigned)(WB_P - WB_GATE)); \
            pg8::EpiP4 E{WSP(unsigned char, WS_S), WSP(bf16, WS_MG), ((const float*)A.in[6]) + l * 4096, WSP(float, WS_RDQ), WSP(float, WS_CDQ)}; \
            pg8::gemm_phase<pg8::EpiP4, pg8::P4Order, true, true>(F.lds + RING_OFF, g, S, E); \
        } \
        SEAM(pb + 4); \
        if (IN(pb + 5)) for (int rep_ = 0; rep_ < NREP(2); ++rep_) { FRESH(); \
            pg8::Gemm g{WSP(bf16, WS_MG), WSP(bf16, WS_WOUT), M, 1024, 1024, 1024}; SO S; S.init(M, 1024, F.G, (int)blockIdx.x, 1024); pg8::EpiOut E{WSP(bf16, WS_MO), WSP(float, WS_PO)}; \
            pg8::gemm_phase<pg8::EpiOut, SO, true, true>(F.lds + RING_OFF, g, S, E); \
        } \
        SEAM(pb + 5); \
    } while (0)
    LAYER(0);
    LAYER(1);
#undef LAYER
    if (IN(12)) { FRESH(); p0_rows<512>(F, args, 2); }
#undef IN
#undef SEAM
}

extern "C" void kernel_launch(void* const* d_in, const int* in_sizes, int n_in, void* d_out, int out_size, void* d_ws, size_t ws_size, hipStream_t stream) {
    static int grid = 0;
    if (grid == 0) {
        if (n_in != 23 || in_sizes[0] != M * D || out_size != M * D || ws_size < WS_END) { fprintf(stderr, "kernel_launch: unexpected shapes (n_in %d, in0 %d, out %d, ws %zu < %zu)\n", n_in, n_in > 0 ? in_sizes[0] : -1, out_size, ws_size, (size_t)WS_END); grid = -1; return; }
        int dev = 0, cus = 0, per_cu = 0;
        if (hipGetDevice(&dev) != hipSuccess || hipDeviceGetAttribute(&cus, hipDeviceAttributeMultiprocessorCount, dev) != hipSuccess) { grid = -1; return; }
        if (hipFuncSetAttribute((const void*)mk_fwd, hipFuncAttributeMaxDynamicSharedMemorySize, LDS_BYTES) != hipSuccess) { fprintf(stderr, "kernel_launch: hipFuncSetAttribute failed\n"); grid = -1; return; }
        if (hipOccupancyMaxActiveBlocksPerMultiprocessor(&per_cu, (const void*)mk_fwd, NTHREADS, LDS_BYTES) != hipSuccess || per_cu < 1) fprintf(stderr, "kernel_launch: occupancy query reports %d\n", per_cu);
        (void)hipGetLastError();
        grid = cus;
    }
    if (grid < 0) return;
    if (hipMemsetAsync((char*)d_ws + WS_CTL, 0, CTL_ZERO_BYTES, stream) != hipSuccess) return;
    Args a{};
    for (int i = 0; i < 23; ++i) a.in[i] = d_in[i];
    a.out = (float*)d_out; a.ws = (unsigned char*)d_ws;
#if MK_ONE_LAUNCH
    a.ph_lo = 0; a.ph_hi = N_PHASES;
    hipLaunchKernelGGL(mk_fwd, dim3(grid), dim3(NTHREADS), LDS_BYTES, stream, a);
#else
    for (int p = 0; p < N_PHASES; ++p) { a.ph_lo = p; a.ph_hi = p + 1; hipLaunchKernelGGL(mk_fwd, dim3(grid), dim3(NTHREADS), LDS_BYTES, stream, a); }
#endif
    const hipError_t le = hipPeekAtLastError();
    if (le != hipSuccess) fprintf(stderr, "kernel_launch: launch failed: %s\n", hipGetErrorName(le));
}
```

```cpp
#include <hip/hip_runtime.h>
#include <cstdio>
#include <cstdint>
#include <cmath>
constexpr int ZT_LD = 2432, ZT_CQ = 0, ZT_CKV = 256, ZT_MQ = 384, ZT_MK = 640, ZT_MV = 896, ZT_U = 1408, ZT_V = 1920;
constexpr int H_LD = 3072, ZY_LD = 3072, YA = 0, YB = 512, YC = 1024, YD = 1536;
constexpr float RMS_EPS = 1e-6f;
#ifndef MK_KI0
#define MK_KI0 512
#endif
#ifndef MK_KI1
#define MK_KI1 1024
#endif
constexpr int ki8_of(int l) { return l == 0 ? MK_KI0 : MK_KI1; }
namespace pg8 {
#define PG8_LAS __attribute__((address_space(3)))
typedef unsigned short bf16_t;
typedef short bf16x8 __attribute__((ext_vector_type(8)));
typedef float f32x4 __attribute__((ext_vector_type(4)));
typedef int i32x4 __attribute__((ext_vector_type(4)));
typedef unsigned u32x4 __attribute__((ext_vector_type(4)));
constexpr int BM = 256, BK = 64, HALF = 128, HTB = HALF * BK * 2  , STAGE_BYTES = 8 * HTB, NXCD = 8, WGM = 8;

__host__ __device__ __forceinline__ int lds_byte(int r, int c) { const int st = (r >> 4) * 2 + (c >> 5), rr = r & 15, cc = c & 31, ob = rr * 64 + cc * 2; return st * 1024 + (ob ^ (((ob >> 9) & 1) << 5)); }
__host__ __device__ __forceinline__ void stage_rc(int b, int& R, int& C) { const int st = b / 1024, sb = b % 1024, swz = sb ^ (((sb >> 9) & 1) << 5); R = (st >> 1) * 16 + swz / 64; C = (st & 1) * 32 + (swz % 64) / 2; }
__host__ __device__ __forceinline__ int perm32(int rho) { const int n = rho >> 4, i = rho & 15; return 8 * (i >> 2) + 4 * n + (i & 3); }

struct Unit { int pm, pn, nt, br, kind; unsigned aoff, boff; };
struct Gemm { const bf16_t* A; const bf16_t* Bt; int M, N, K, lda; };

struct StaticOrder {
    int nM, nN, nwg, G, c, nt; unsigned a0;
    __host__ __device__ __forceinline__ void init(int M, int N, int G_, int c_, int K_, unsigned a0_ = 0u) { nM = M / BM; nN = N / BM; nwg = nM * nN; G = G_; c = c_; nt = K_ / BK; a0 = a0_; }
    __host__ __device__ __forceinline__ bool next(int i, Unit& u) const {
        const long L = (long)i * G + c; if (L >= nwg) return false;
        int wgid = (int)L; { const int q = nwg / NXCD, r = nwg % NXCD, xcd = wgid % NXCD, off = wgid / NXCD; wgid = (xcd < r ? xcd * (q + 1) : r * (q + 1) + (xcd - r) * q) + off; }
        const int nig = WGM * nN, gid = wgid / nig, fm = gid * WGM, gsz = (nM - fm) < WGM ? (nM - fm) : WGM;
        u.pm = fm + ((wgid % nig) % gsz); u.pn = (wgid % nig) / gsz; u.nt = nt; u.br = 0; u.kind = 0; u.aoff = a0; u.boff = 0u; return true;
    }
    __device__ __forceinline__ void a_ready(const Unit&) const {}
    __device__ __forceinline__ void done(const Unit&) const {}
};

typedef __bf16 bf16x2_t __attribute__((ext_vector_type(2)));
__device__ __forceinline__ unsigned cvt_pk_bf16(float lo, float hi) { typedef float f32x2_t __attribute__((ext_vector_type(2))); f32x2_t v = {lo, hi}; bf16x2_t b = __builtin_convertvector(v, bf16x2_t); return __builtin_bit_cast(unsigned, b); }
typedef float f32x2 __attribute__((ext_vector_type(2)));
typedef unsigned u32x2 __attribute__((ext_vector_type(2)));
__device__ __forceinline__ float fexp2(float x) { return __builtin_amdgcn_exp2f(x); }
__device__ __forceinline__ float frcp(float x) { return __builtin_amdgcn_rcpf(x); }
__device__ __forceinline__ float sigm(float x) { return frcp(1.f + fexp2(-1.4426950409f * x)); }
__device__ __forceinline__ float silu(float x) { return x * sigm(x); }
__device__ __forceinline__ float gelu_t(float x) { const float u = x + 0.044715f * x * x * x; return x * frcp(1.f + fexp2(-2.302208198f * u)); }
__device__ __forceinline__ float bflo(unsigned w) { return __uint_as_float(w << 16); }
__device__ __forceinline__ float bfhi(unsigned w) { return __uint_as_float(w & 0xffff0000u); }
__device__ __forceinline__ u32x4 pack8(const float (&o)[8]) { u32x4 w; w.x = cvt_pk_bf16(o[0], o[1]); w.y = cvt_pk_bf16(o[2], o[3]); w.z = cvt_pk_bf16(o[4], o[5]); w.w = cvt_pk_bf16(o[6], o[7]); return w; }
__device__ __forceinline__ void st_nt(u32x4* p, u32x4 v) { __builtin_nontemporal_store(v, p); }
__device__ __forceinline__ float quad_sum(float s) {
    s += __int_as_float(__builtin_amdgcn_ds_swizzle(__float_as_int(s), (16 << 10) | 0x1f)); auto r = __builtin_amdgcn_permlane32_swap(__float_as_uint(s), __float_as_uint(s), false, false); return __uint_as_float(r[0]) + __uint_as_float(r[1]); }

template <int KI8> struct EpiIn {
    static constexpr bool PERM = true, AFTER_DRAIN = false, HAS_MID = false, HAS_I8 = true;
    static constexpr int SPLIT_T = KI8 / 128;
    bf16_t* ZT; bf16_t* ZY; bf16_t* KR; float* PQ; float* PKV; float* PVS; float* GIF; const float* ROPE; const float* rdq; const float* cdq;
    __device__ __forceinline__ void dequant(f32x4 (&acc)[2][2][4][2], const Unit& u, int wr, int wc, int fr_, int fq_) const {
        int fr = fr_, fq = fq_; asm volatile("" : "+v"(fr), "+v"(fq));
        const int row0 = u.pm * BM + wr * 64 + fr; const float* cp = cdq + u.pn * 256 + wc * 32 + 8 * fq;
        float rq[8];
#pragma unroll
        for (int g = 0; g < 8; ++g) rq[g] = rdq[row0 + (g >> 2) * HALF + (g & 3) * 16];
#pragma unroll
        for (int bj = 0; bj < 2; ++bj) { const f32x4 c0 = *(const f32x4*)(cp + bj * HALF), c1 = *(const f32x4*)(cp + bj * HALF + 4);
#pragma unroll
            for (int ai = 0; ai < 2; ++ai)
#pragma unroll
                for (int m = 0; m < 4; ++m)
#pragma unroll
                    for (int e = 0; e < 8; ++e) acc[ai][bj][m][e >> 2][e & 3] = (float)__float_as_int(acc[ai][bj][m][e >> 2][e & 3]) * rq[ai * 4 + m] * (e < 4 ? c0[e & 3] : c1[e & 3]); }
    }
    template <int KIND> __device__ __forceinline__ void pair_tile(const f32x4 (&acc)[2][2][4][2], bf16_t* dst, int ld, int row0, int c0) const {
#pragma unroll
        for (int ai = 0; ai < 2; ++ai)
#pragma unroll
            for (int m = 0; m < 4; ++m) { const size_t row = (size_t)(row0 + ai * HALF + m * 16); float o[8];
#pragma unroll
                for (int e = 0; e < 8; ++e) { const float a = acc[ai][0][m][e >> 2][e & 3], b = acc[ai][1][m][e >> 2][e & 3];
                    o[e] = KIND == 0 ? b * frcp((1.f + fexp2(-1.4426950409f * a)) * (1.f + fexp2(-1.4426950409f * b)))
                         : KIND == 1 ? a * b : KIND == 2 ? a * silu(b)
                         : a * b * frcp((1.f + fexp2(-2.302208198f * (a + 0.044715f * a * a * a))) * (1.f + fexp2(-1.4426950409f * b))); }
                st_nt((u32x4*)(dst + row * ld + c0), pack8(o)); }
    }
    template <int ACT, int ST> __device__ __forceinline__ void plain_tile(const f32x4 (&acc)[2][2][4][2], bf16_t* dst, int ld, int row0, int cw, int t, int wc, int fq) const {
#pragma unroll
        for (int ai = 0; ai < 2; ++ai)
#pragma unroll
            for (int m = 0; m < 4; ++m) { const size_t row = (size_t)(row0 + ai * HALF + m * 16); float s1 = 0.f, s2 = 0.f;
#pragma unroll
                for (int bj = 0; bj < 2; ++bj) { float o[8];
#pragma unroll
                    for (int e = 0; e < 8; ++e) { float v = acc[ai][bj][m][e >> 2][e & 3]; v = ACT == 1 ? silu(v) : ACT == 2 ? gelu_t(v) : v; o[e] = v; if (ST == 2) s1 += v; if (ST) s2 += v * v; }
                    st_nt((u32x4*)(dst + row * ld + bj * HALF + cw), pack8(o)); }
                if (ST == 1) { s2 = quad_sum(s2); if (fq == 0) PQ[row * 4 + wc] = s2; }
                if (ST == 2) { s1 = quad_sum(s1); s2 = quad_sum(s2); if (fq == 0) { f32x2 p; p.x = s1; p.y = s2; *(f32x2*)(PVS + (row * 8 + (t - 24) * 4 + wc) * 2) = p; } } }
    }
    __device__ __forceinline__ void operator()(const f32x4 (&acc)[2][2][4][2], const Unit& u, int wr, int wc, int fr_, int fq_) const {
        int fr = fr_, fq = fq_; asm volatile("" : "+v"(fr), "+v"(fq));
        const int t = u.pn, row0 = u.pm * BM + wr * 64 + fr, cw = wc * 32 + 8 * fq;
        if (t >= 8 && t < 24) {
            const int kind = (t - 8) >> 2, c0 = ((t - 8) & 3) * 128 + cw;
            if (kind == 0) pair_tile<0>(acc, ZY + YB, ZY_LD, row0, c0); else if (kind == 1) pair_tile<1>(acc, ZT + ZT_U, ZT_LD, row0, c0);
            else if (kind == 2) pair_tile<2>(acc, ZY + YC, ZY_LD, row0, c0); else pair_tile<3>(acc, ZY + YD, ZY_LD, row0, c0);
            return;
        }
        if (t == 1) {
#pragma unroll
            for (int ai = 0; ai < 2; ++ai)
#pragma unroll
                for (int m = 0; m < 4; ++m) { const size_t row = (size_t)(row0 + ai * HALF + m * 16); float o[8]; float ss = 0.f;
#pragma unroll
                    for (int e = 0; e < 8; ++e) { o[e] = acc[ai][0][m][e >> 2][e & 3]; ss += o[e] * o[e]; }
                    st_nt((u32x4*)(ZT + row * ZT_LD + ZT_CKV + cw), pack8(o));
                    ss = quad_sum(ss); if (fq == 0) PKV[row * 4 + wc] = ss;
                    if (wc == 0) { const f32x4 t1 = acc[ai][1][m][0], t2 = acc[ai][1][m][1];
                        const f32x4 cs0 = *(const f32x4*)(ROPE + row * 32 + 8 * fq), cs1 = *(const f32x4*)(ROPE + row * 32 + 8 * fq + 4);
                        const float c[4] = {cs0[0], cs0[2], cs1[0], cs1[2]}, s[4] = {cs0[1], cs0[3], cs1[1], cs1[3]};
                        u32x2 w1, w2; w1.x = cvt_pk_bf16(t1[0] * c[0] - t2[0] * s[0], t1[1] * c[1] - t2[1] * s[1]); w1.y = cvt_pk_bf16(t1[2] * c[2] - t2[2] * s[2], t1[3] * c[3] - t2[3] * s[3]);
                        w2.x = cvt_pk_bf16(t1[0] * s[0] + t2[0] * c[0], t1[1] * s[1] + t2[1] * c[1]); w2.y = cvt_pk_bf16(t1[2] * s[2] + t2[2] * c[2], t1[3] * s[3] + t2[3] * c[3]);
                        *(u32x2*)(KR + row * 32 + 4 * fq) = w1; *(u32x2*)(KR + row * 32 + 16 + 4 * fq) = w2; }
                    if (wc == 1 && fq == 0) { *(f32x4*)(GIF + row * 8) = acc[ai][1][m][0]; *(f32x4*)(GIF + row * 8 + 4) = acc[ai][1][m][1]; } }
            return;
        }
        if (t == 0) plain_tile<0, 1>(acc, ZT + ZT_CQ, ZT_LD, row0, cw, t, wc, fq);
        else if (t < 4) plain_tile<1, 0>(acc, ZY + YA + (t - 2) * 256, ZY_LD, row0, cw, t, wc, fq);
        else if (t < 8) plain_tile<0, 0>(acc, ZT + (t == 4 ? ZT_MQ : t == 5 ? ZT_MK : ZT_MV + (t - 6) * 256), ZT_LD, row0, cw, t, wc, fq);
        else plain_tile<2, 2>(acc, ZT + ZT_V + (t - 24) * 256, ZT_LD, row0, cw, t, wc, fq);
    }
};
struct EpiUpQ {
    static constexpr bool PERM = true, AFTER_DRAIN = false, HAS_MID = false, HAS_I8 = false; static constexpr int SPLIT_T = 0;
    bf16_t* Q; const float* PQ; const float* ROPE;
    __device__ __forceinline__ void operator()(const f32x4 (&acc)[2][2][4][2], const Unit& u, int wr, int wc, int fr_, int fq_) const {
        int fr = fr_, fq = fq_; asm volatile("" : "+v"(fr), "+v"(fq));
        const int t = u.pn, row0 = u.pm * BM + wr * 64 + fr;
        float rsv[8];
#pragma unroll
        for (int g = 0; g < 8; ++g) { const f32x4 pq = *(const f32x4*)(PQ + (size_t)(row0 + (g >> 2) * HALF + (g & 3) * 16) * 4); rsv[g] = __builtin_amdgcn_rsqf(((pq[0] + pq[1]) + (pq[2] + pq[3])) * (1.f / 256.f) + RMS_EPS); }
#pragma unroll
        for (int ai = 0; ai < 2; ++ai)
#pragma unroll
            for (int m = 0; m < 4; ++m) { const size_t row = (size_t)(row0 + ai * HALF + m * 16);
                const float rs = rsv[ai * 4 + m];
                if (t < 2) {
#pragma unroll
                    for (int bj = 0; bj < 2; ++bj) { float o[8];
#pragma unroll
                        for (int e = 0; e < 8; ++e) o[e] = acc[ai][bj][m][e >> 2][e & 3] * rs;
                        *(u32x4*)(Q + row * 768 + (4 * t + 2 * bj + (wc >> 1)) * 96 + (wc & 1) * 32 + 8 * fq) = pack8(o); }
                } else {
                    const int head = 2 * wc + (fq >> 1), j0 = 8 * (fq & 1);
#pragma unroll
                    for (int n = 0; n < 2; ++n) { const int j = j0 + 4 * n;
                        const f32x4 ca = *(const f32x4*)(ROPE + row * 32 + 2 * j), cb = *(const f32x4*)(ROPE + row * 32 + 2 * j + 4);
                        const f32x4 t1 = acc[ai][0][m][n] * rs, t2 = acc[ai][1][m][n] * rs;
                        u32x2 w1, w2; w1.x = cvt_pk_bf16(t1[0] * ca[0] - t2[0] * ca[1], t1[1] * ca[2] - t2[1] * ca[3]); w1.y = cvt_pk_bf16(t1[2] * cb[0] - t2[2] * cb[1], t1[3] * cb[2] - t2[3] * cb[3]);
                        w2.x = cvt_pk_bf16(t1[0] * ca[1] + t2[0] * ca[0], t1[1] * ca[3] + t2[1] * ca[2]); w2.y = cvt_pk_bf16(t1[2] * cb[1] + t2[2] * cb[0], t1[3] * cb[3] + t2[3] * cb[2]);
                        *(u32x2*)(Q + row * 768 + head * 96 + 64 + j) = w1; *(u32x2*)(Q + row * 768 + head * 96 + 80 + j) = w2; }
                } }
    }
};
struct EpiUpKV {
    static constexpr bool PERM = true, AFTER_DRAIN = false, HAS_MID = false, HAS_I8 = false; static constexpr int SPLIT_T = 0;
    bf16_t* KN; bf16_t* V; const float* PKV;
    __device__ __forceinline__ void operator()(const f32x4 (&acc)[2][2][4][2], const Unit& u, int wr, int wc, int fr_, int fq_) const {
        int fr = fr_, fq = fq_; asm volatile("" : "+v"(fr), "+v"(fq));
        const int t = u.pn, row0 = u.pm * BM + wr * 64 + fr, cw = wc * 32 + 8 * fq; bf16_t* dst = (t < 2 ? KN : V) + (t & 1) * 256;
        float rsv[8];
#pragma unroll
        for (int g = 0; g < 8; ++g) { const f32x4 pq = *(const f32x4*)(PKV + (size_t)(row0 + (g >> 2) * HALF + (g & 3) * 16) * 4); rsv[g] = __builtin_amdgcn_rsqf(((pq[0] + pq[1]) + (pq[2] + pq[3])) * (1.f / 128.f) + RMS_EPS); }
#pragma unroll
        for (int ai = 0; ai < 2; ++ai)
#pragma unroll
            for (int m = 0; m < 4; ++m) { const size_t row = (size_t)(row0 + ai * HALF + m * 16);
                const float rs = rsv[ai * 4 + m];
#pragma unroll
                for (int bj = 0; bj < 2; ++bj) { float o[8];
#pragma unroll
                    for (int e = 0; e < 8; ++e) o[e] = acc[ai][bj][m][e >> 2][e & 3] * rs;
                    st_nt((u32x4*)(dst + row * 512 + bj * HALF + cw), pack8(o)); } }
    }
};
struct P4Order {
    StaticOrder base; unsigned boff_p;
    __device__ __forceinline__ void init(int M, int G_, int c_, unsigned boff_p_) { base.init(M, 1024, G_, c_, 1024); boff_p = boff_p_; }
    __device__ __forceinline__ bool next(int j, Unit& u) const {
        const int tile = j / 6, sub = j - 6 * tile;
        if (!base.next(tile, u)) return false;
        const int pair = sub >= 3, q = sub - 3 * pair; u.nt = 16;
        if (q < 2) { u.kind = 0; u.nt = 8; u.br = 2 * pair + q; u.aoff = 0u; u.boff = (unsigned)u.br * (1024u * 1024u * 2u); }
        else { u.kind = 2; u.br = 2 * pair; u.aoff = (unsigned)(1024 + 1024 * pair) * 2u; u.boff = boff_p + (unsigned)pair * (1024u * 1024u * 2u); }
        return true;
    }
    __device__ __forceinline__ void a_ready(const Unit&) const {}
    __device__ __forceinline__ void done(const Unit&) const {}
};
struct EpiP4 {
    static constexpr bool PERM = true, AFTER_DRAIN = false, HAS_MID = true, HAS_I8 = true; static constexpr int SPLIT_T = 0;
    unsigned char* S; bf16_t* MG; const float* bias; const float* rdq; const float* cdq;
    static __device__ __forceinline__ float ub(unsigned w, int i) { return (float)((w >> (8 * i)) & 0xffu); }
    static __device__ __forceinline__ void swap16(unsigned& a, unsigned& b) { auto r = __builtin_amdgcn_permlane16_swap(a, b, false, false); a = r[0]; b = r[1]; }
    static __device__ __forceinline__ u32x4 join16(u32x2 w0, u32x2 w1) { unsigned a = w0.x, b = w0.y, c = w1.x, d = w1.y; swap16(a, c); swap16(b, d); return (u32x4){a, b, c, d}; }
    static __device__ __forceinline__ void split16(u32x4 v, u32x2& w0, u32x2& w1) { unsigned a = v.x, b = v.y, c = v.z, d = v.w; swap16(a, c); swap16(b, d); w0 = (u32x2){a, b}; w1 = (u32x2){c, d}; }
    __device__ __forceinline__ void mid(f32x4 (&acc)[2][2][4][2], const Unit& u, int wr, int wc, int fr_, int fq_) const {
        int fr = fr_, fq = fq_; asm volatile("" : "+v"(fr), "+v"(fq));
        const int row0 = u.pm * BM + wr * 64 + fr, col0 = u.pn * BM + wc * 32 + 8 * fq, soff = (fq & 1) ? HALF - 8 : 0;
        const unsigned char* Sa = S; const unsigned char* Sb = S + (size_t)32768 * 1024;
        u32x4 la[8], lb[8];
#pragma unroll
        for (int g = 0; g < 8; ++g) { const size_t off_ = (size_t)(row0 + (g >> 2) * HALF + (g & 3) * 16) * 1024 + col0 + soff; la[g] = *(const u32x4*)(Sa + off_); lb[g] = *(const u32x4*)(Sb + off_); }
#pragma unroll
        for (int g = 0; g < 8; ++g) { const int ai = g >> 2, mm = g & 3; u32x2 sa[2], sb[2]; split16(la[g], sa[0], sa[1]); split16(lb[g], sb[0], sb[1]);
#pragma unroll
            for (int bj = 0; bj < 2; ++bj)
#pragma unroll
                for (int e = 0; e < 8; ++e) { const unsigned wa = e < 4 ? sa[bj].x : sa[bj].y, wb = e < 4 ? sb[bj].x : sb[bj].y;
                    acc[ai][bj][mm][e >> 2][e & 3] *= ub(wa, e & 3) * frcp(ub(wb, e & 3)); } }
    }
    __device__ __forceinline__ void operator()(const f32x4 (&acc)[2][2][4][2], const Unit& u, int wr, int wc, int fr_, int fq_) const {
        int fr = fr_, fq = fq_; asm volatile("" : "+v"(fr), "+v"(fq));
        const int row0 = u.pm * BM + wr * 64 + fr, col0 = u.pn * BM + wc * 32 + 8 * fq, soff = (fq & 1) ? HALF - 8 : 0;
        if (u.kind == 0) {
            unsigned char* Sme = S + (size_t)(u.br & 1) * ((size_t)32768 * 1024);
            const float* bp = bias + u.br * 1024 + col0; const float* cp = cdq + u.br * 1024 + col0; float rq[8];
#pragma unroll
            for (int g = 0; g < 8; ++g) rq[g] = rdq[row0 + (g >> 2) * HALF + (g & 3) * 16];
            u32x2 w0[8];
#pragma unroll
            for (int bj = 0; bj < 2; ++bj) { f32x2 bv[4], cv[4];
#pragma unroll
                for (int n = 0; n < 2; ++n) { const f32x4 b4 = *(const f32x4*)(bp + bj * HALF + 4 * n), c4 = *(const f32x4*)(cp + bj * HALF + 4 * n);
                    bv[2 * n] = (f32x2){b4.x, b4.y} * -1.4426950409f; bv[2 * n + 1] = (f32x2){b4.z, b4.w} * -1.4426950409f; cv[2 * n] = (f32x2){c4.x, c4.y} * -1.4426950409f; cv[2 * n + 1] = (f32x2){c4.z, c4.w} * -1.4426950409f; }
#pragma unroll
                for (int g = 0; g < 8; ++g) { const int ai = g >> 2, m = g & 3; const float rs = rq[g]; u32x2 w = {0u, 0u};
#pragma unroll
                    for (int p = 0; p < 4; ++p) { const f32x4 a4 = acc[ai][bj][m][p >> 1];
                        f32x2 t = {(float)__float_as_int(a4[2 * (p & 1)]), (float)__float_as_int(a4[2 * (p & 1) + 1])};
                        t = (t * rs) * cv[p] + bv[p];
                        f32x2 d = {fexp2(t.x), fexp2(t.y)}; d = d * (1.f / 255.f) + (1.f / 255.f);
                        const float s0 = fmaxf(frcp(d.x), 1.f), s1 = fmaxf(frcp(d.y), 1.f);
                        if (p < 2) { w.x = __builtin_amdgcn_cvt_pk_u8_f32(s0, 2 * p, w.x); w.x = __builtin_amdgcn_cvt_pk_u8_f32(s1, 2 * p + 1, w.x); }
                        else { w.y = __builtin_amdgcn_cvt_pk_u8_f32(s0, 2 * p - 4, w.y); w.y = __builtin_amdgcn_cvt_pk_u8_f32(s1, 2 * p - 3, w.y); } }
                    if (bj == 0) w0[g] = w;
                    else *(u32x4*)(Sme + (size_t)(row0 + ai * HALF + m * 16) * 1024 + col0 + soff) = join16(w0[g], w); } }
            return;
        }
        const int first = u.br == 0; const unsigned char* Sb = S + (size_t)32768 * 1024;
#pragma unroll
        for (int h = 0; h < 2; ++h) { u32x4 ls[4]; u32x4 mv[4][2];
#pragma unroll
            for (int q = 0; q < 4; ++q) { const size_t off_ = (size_t)(row0 + h * HALF + q * 16) * 1024 + col0;
                ls[q] = *(const u32x4*)(Sb + off_ + soff);
                if (!first) { mv[q][0] = *(const u32x4*)(MG + off_); mv[q][1] = *(const u32x4*)(MG + off_ + HALF); } else { mv[q][0] = (u32x4){0u, 0u, 0u, 0u}; mv[q][1] = (u32x4){0u, 0u, 0u, 0u}; } }
#pragma unroll
            for (int q = 0; q < 4; ++q) { const size_t off = (size_t)(row0 + h * HALF + q * 16) * 1024 + col0; u32x2 sv[2]; split16(ls[q], sv[0], sv[1]);
#pragma unroll
                for (int bj = 0; bj < 2; ++bj) { float o[8];
#pragma unroll
                    for (int e = 0; e < 8; ++e) { const unsigned sw = e < 4 ? sv[bj].x : sv[bj].y; const float s = ub(sw, e & 3) * (1.f / 255.f);
                        const unsigned mw = mv[q][bj][e >> 1]; const float mprev = (e & 1) ? bfhi(mw) : bflo(mw);
                        o[e] = mprev + s * acc[h][bj][q][e >> 2][e & 3]; }
                    *(u32x4*)(MG + off + bj * HALF) = pack8(o); } } }
    }
};
struct EpiOut {
    static constexpr bool PERM = true, AFTER_DRAIN = false, HAS_MID = false, HAS_I8 = false; static constexpr int SPLIT_T = 0;
    bf16_t* MO; float* PO;
    __device__ __forceinline__ void operator()(const f32x4 (&acc)[2][2][4][2], const Unit& u, int wr, int wc, int fr_, int fq_) const {
        int fr = fr_, fq = fq_; asm volatile("" : "+v"(fr), "+v"(fq));
        const int row0 = u.pm * BM + wr * 64 + fr, col0 = u.pn * BM + wc * 32 + 8 * fq;
#pragma unroll
        for (int ai = 0; ai < 2; ++ai)
#pragma unroll
            for (int m = 0; m < 4; ++m) { const size_t row = (size_t)(row0 + ai * HALF + m * 16); float ss = 0.f;
#pragma unroll
                for (int bj = 0; bj < 2; ++bj) { float o[8];
#pragma unroll
                    for (int e = 0; e < 8; ++e) { o[e] = acc[ai][bj][m][e >> 2][e & 3]; ss += o[e] * o[e]; }
                    *(u32x4*)(MO + row * 1024 + col0 + bj * HALF) = pack8(o); }
                ss = quad_sum(ss); if (fq == 0) PO[row * 16 + u.pn * 4 + wc] = ss; }
    }
};
template <class Epi, class Sched, bool ALIGN_EPI = false, bool SP2 = false>
__device__ __forceinline__ void gemm_phase(PG8_LAS unsigned char* lds, const Gemm g, const Sched& S, const Epi& E) {
    int tid_ = threadIdx.x; asm volatile("" : "+v"(tid_));
    const int tid = tid_, wid = __builtin_amdgcn_readfirstlane(tid >> 6), lane = tid & 63, wr = wid >> 2, wc = wid & 3, fr = lane & 15, fq = lane >> 4;
    const int K = g.K;
    unsigned voffA[2], voffB[2];
#pragma unroll
    for (int i = 0; i < 2; ++i) { int R, C; stage_rc(tid * 16 + i * 8192, R, C); const int Rb = Epi::PERM ? ((R & ~31) + perm32(R & 31)) : R;
        voffA[i] = (unsigned)(R * g.lda + C) * 2u; voffB[i] = (unsigned)(Rb * K + C) * 2u; }
    const size_t kstep = (size_t)(BK * 2);
    const size_t hstepB = (size_t)HALF * K * 2, hstepA = (size_t)HALF * g.lda * 2;
    const size_t tstepA = 2 * hstepA, tstepB = 2 * hstepB;
    const unsigned ldsw = (unsigned)wid * 1024u;
    const int aoff = lds_byte(wr * 64 + fr, fq * 8), boff = lds_byte(wc * 32 + fr, fq * 8);
#define PG8_SA(b, h) (((b) * 2 + (h)) * HTB)
#define PG8_SB(b, h) ((4 + (b) * 2 + (h)) * HTB)
#define PG8_STAGE(bufoff, gbase, voff) do { _Pragma("unroll") for (int _i = 0; _i < 2; ++_i) { unsigned vo_ = (voff)[_i]; asm volatile("" : "+v"(vo_));     \
        __builtin_amdgcn_global_load_lds((const unsigned*)((const char*)(gbase) + vo_), (PG8_LAS unsigned*)(lds + (bufoff) + ldsw + _i * 8192), 16, 0, 0); } } while (0)
#define PG8_LDA(dst, b, h) do { _Pragma("unroll") for (int m = 0; m < 4; ++m) _Pragma("unroll") for (int k = 0; k < 2; ++k) dst[m][k] = *(const PG8_LAS bf16x8*)(lds + PG8_SA(b, h) + aoff + m * 2048 + k * 1024); } while (0)
#define PG8_LDB(dst, b, h) do { _Pragma("unroll") for (int n = 0; n < 2; ++n) _Pragma("unroll") for (int k = 0; k < 2; ++k) dst[n][k] = *(const PG8_LAS bf16x8*)(lds + PG8_SB(b, h) + boff + n * 2048 + k * 1024); } while (0)
#define PG8_MMA(ai, bj, At, Bt) do { __builtin_amdgcn_s_setprio(1); _Pragma("unroll") for (int m = 0; m < 4; ++m) _Pragma("unroll") for (int n = 0; n < 2; ++n) _Pragma("unroll") for (int k = 0; k < 2; ++k) \
        acc[ai][bj][m][n] = __builtin_amdgcn_mfma_f32_16x16x32_bf16(Bt[n][k], At[m][k], acc[ai][bj][m][n], 0, 0, 0); __builtin_amdgcn_s_setprio(0); } while (0)
#define PG8_MMA_I8(ai, bj, At, Bt) do { __builtin_amdgcn_s_setprio(1); _Pragma("unroll") for (int m = 0; m < 4; ++m) _Pragma("unroll") for (int n = 0; n < 2; ++n) _Pragma("unroll") for (int k = 0; k < 2; ++k) \
        acc[ai][bj][m][n] = __builtin_bit_cast(f32x4, __builtin_amdgcn_mfma_i32_16x16x64_i8(__builtin_bit_cast(i32x4, Bt[n][k]), __builtin_bit_cast(i32x4, At[m][k]), __builtin_bit_cast(i32x4, acc[ai][bj][m][n]), 0, 0, 0)); __builtin_amdgcn_s_setprio(0); } while (0)
#define PG8_WAIT_V(n) asm volatile("s_waitcnt vmcnt(" #n ")" ::: "memory")
#define PG8_WAIT_L(n) asm volatile("s_waitcnt lgkmcnt(" #n ")" ::: "memory")
#define PG8_BAR __builtin_amdgcn_s_barrier()
#define PG8_SCHED __builtin_amdgcn_sched_barrier(0)
#define PG8_KLOOP(MMAX, T0, T1) \
        for (int t = (T0); t < (T1); t += 2) { \
            const bool last = (t == nt - 2); \
            const char* a1 = cA + (size_t)(t + 1) * kstep; \
            const char* a2 = last ? nA : cA + (size_t)(t + 2) * kstep; const char* b2 = last ? nB : cB + (size_t)(t + 2) * kstep; \
            const char* a3 = a2 + kstep; const char* b3 = b2 + kstep; \
            if (last && has_next) S.a_ready(nxt); \
            if constexpr (Epi::HAS_MID) { if (t == 8 && cur.kind == 2) E.mid(acc, cur, wr, wc, fr, fq); } \
            PG8_LDB(B0, 0, 0); PG8_LDB(B1, 0, 1); PG8_SCHED; PG8_LDA(At, 0, 0); PG8_STAGE(PG8_SA(1, 1), a1 + hstepA, voffA); \
            PG8_WAIT_V(8); PG8_WAIT_L(0); PG8_BAR; MMAX(0, 0, At, B0); MMAX(0, 1, At, B1); PG8_BAR; PG8_SCHED; \
            PG8_LDA(At, 0, 1); PG8_STAGE(PG8_SB(0, 0), b2, voffB); PG8_STAGE(PG8_SB(0, 1), b2 + hstepB, voffB); PG8_STAGE(PG8_SA(0, 0), a2, voffA); \
            PG8_WAIT_V(8); PG8_WAIT_L(0); PG8_BAR; MMAX(1, 0, At, B0); MMAX(1, 1, At, B1); PG8_BAR; PG8_SCHED; \
            PG8_LDB(B0, 1, 0); PG8_LDB(B1, 1, 1); PG8_SCHED; PG8_LDA(At, 1, 0); PG8_STAGE(PG8_SA(0, 1), a2 + hstepA, voffA); \
            PG8_WAIT_V(8); PG8_WAIT_L(0); PG8_BAR; MMAX(0, 0, At, B0); MMAX(0, 1, At, B1); PG8_BAR; PG8_SCHED; \
            PG8_LDA(At, 1, 1); PG8_STAGE(PG8_SB(1, 0), b3, voffB); PG8_STAGE(PG8_SB(1, 1), b3 + hstepB, voffB); PG8_STAGE(PG8_SA(1, 0), a3, voffA); \
            PG8_WAIT_V(8); PG8_WAIT_L(0); PG8_BAR; MMAX(1, 0, At, B0); MMAX(1, 1, At, B1); PG8_BAR; PG8_SCHED; \
        }
    Unit cur, nxt; int ui = 0;
    if (!S.next(0, cur)) return;
    f32x4 acc[2][2][4][2];
#pragma unroll
    for (int a = 0; a < 2; ++a)
#pragma unroll
        for (int b = 0; b < 2; ++b)
#pragma unroll
            for (int m = 0; m < 4; ++m)
#pragma unroll
                for (int n = 0; n < 2; ++n) acc[a][b][m][n] = (f32x4){0.f, 0.f, 0.f, 0.f};
    bf16x8 At[4][2], B0[2][2], B1[2][2];
    const char* cA = (const char*)g.A + (size_t)cur.pm * tstepA + cur.aoff; const char* cB = (const char*)g.Bt + (size_t)cur.pn * tstepB + cur.boff;
    S.a_ready(cur);
    if constexpr (SP2) {
        PG8_STAGE(PG8_SB(0, 0), cB, voffB); PG8_STAGE(PG8_SB(0, 1), cB + hstepB, voffB); PG8_STAGE(PG8_SA(0, 0), cA, voffA); PG8_STAGE(PG8_SA(0, 1), cA + hstepA, voffA);
        if (wr == 1) PG8_BAR;
        PG8_WAIT_V(2); PG8_BAR;
        PG8_STAGE(PG8_SB(1, 0), cB + kstep, voffB); PG8_STAGE(PG8_SA(1, 0), cA + kstep, voffA); PG8_STAGE(PG8_SB(1, 1), cB + hstepB + kstep, voffB);
        PG8_WAIT_V(6); PG8_BAR;
    } else {
        PG8_STAGE(PG8_SB(0, 0), cB, voffB); PG8_STAGE(PG8_SA(0, 0), cA, voffA); PG8_STAGE(PG8_SB(0, 1), cB + hstepB, voffB); PG8_STAGE(PG8_SA(0, 1), cA + hstepA, voffA);
        if (wr == 1) PG8_BAR;
        PG8_WAIT_V(4); PG8_BAR;
        PG8_STAGE(PG8_SB(1, 0), cB + kstep, voffB); PG8_STAGE(PG8_SA(1, 0), cA + kstep, voffA); PG8_STAGE(PG8_SB(1, 1), cB + hstepB + kstep, voffB);
        PG8_WAIT_V(6); PG8_BAR;
    }
    for (;;) {
        const bool has_next = S.next(ui + 1, nxt);
        const char* nA = has_next ? (const char*)g.A + (size_t)nxt.pm * tstepA + nxt.aoff : cA; const char* nB = has_next ? (const char*)g.Bt + (size_t)nxt.pn * tstepB + nxt.boff : cB;
        const int nt = cur.nt; const bool i8u = Epi::HAS_I8 && cur.kind == 0;
        static_assert(SP2, "only the two-super-phase K-loop is kept");
        if (Epi::HAS_I8 && i8u) {
            if constexpr (Epi::SPLIT_T > 0) {
                PG8_KLOOP(PG8_MMA_I8, 0, Epi::SPLIT_T) E.dequant(acc, cur, wr, wc, fr, fq); PG8_KLOOP(PG8_MMA, Epi::SPLIT_T, nt)
            } else { PG8_KLOOP(PG8_MMA_I8, 0, nt) }
        } else { PG8_KLOOP(PG8_MMA, 0, nt) }
        if constexpr (ALIGN_EPI) { if (wr == 0) PG8_BAR; }
        if constexpr (!Epi::AFTER_DRAIN) { E(acc, cur, wr, wc, fr, fq); S.done(cur); }
        if (!has_next) break;
#pragma unroll
        for (int a = 0; a < 2; ++a)
#pragma unroll
            for (int b = 0; b < 2; ++b)
#pragma unroll
                for (int m = 0; m < 4; ++m)
#pragma unroll
                    for (int n = 0; n < 2; ++n) acc[a][b][m][n] = (f32x4){0.f, 0.f, 0.f, 0.f};
        cur = nxt; cA = nA; cB = nB; ++ui;
        if constexpr (ALIGN_EPI) { if (wr == 1) PG8_BAR; }
    }
    PG8_WAIT_V(0);
    if constexpr (!ALIGN_EPI) { if (wr == 0) PG8_BAR; }
    PG8_BAR;
    if constexpr (Epi::AFTER_DRAIN) { E.fused(acc, cur, wr, wc, fr, fq, lds, wid, lane); S.done(cur); }
#undef PG8_SA
#undef PG8_SB
#undef PG8_STAGE
#undef PG8_LDA
#undef PG8_LDB
#undef PG8_MMA
#undef PG8_MMA_I8
#undef PG8_KLOOP
#undef PG8_WAIT_V
#undef PG8_WAIT_L
#undef PG8_BAR
#undef PG8_SCHED
}
}

constexpr int NWAVES = 8, NTHREADS = 512;
constexpr int NB = 8, SEQ = 4096, D = 1024, M = NB * SEQ, DEPTH = 2;
constexpr int IN_DIM = 6568, NV_IN = 6656;
constexpr int O_CQ = 0, O_CKV = 256, O_KR = 384, O_GA = 416, O_MQ = 928, O_MK = 1184, O_MV = 1440, O_MI = 1952, O_MF = 1956, O_MO = 1960, O_GB = 2472,
              O_CX = 2984, O_CB = 3496, O_CC = 4008, O_GC = 4520, O_DU = 5032, O_DV = 5544, O_GD = 6056;
constexpr float QSCALE = 0.10206207261596577f * 1.4426950408889634f;
constexpr int N_PHASES = 13;
#ifndef MK_ONE_LAUNCH
#define MK_ONE_LAUNCH 1
#endif
#ifndef MK_PROBE
#define MK_PROBE 0
#endif
#ifndef MK_ATTN_V2
#define MK_ATTN_V2 1
#endif
#ifndef MK_NAIVE_ATTN
#define MK_NAIVE_ATTN 0
#endif
#ifndef MK_NAIVE_MLSTM
#define MK_NAIVE_MLSTM 0
#endif
#ifndef MK_NAIVE_SGU
#define MK_NAIVE_SGU 0
#endif

__host__ __device__ __forceinline__ int map_in(int vc, float& cs) {
    const int t = vc >> 8, j = vc & 255; cs = 1.f;
    if (t == 0) return O_CQ + j;
    if (t == 1) { if (j < 128) return O_CKV + j; const int jp = j - 128;
        if (jp < 32) { const int g = jp >> 3, w = jp & 7; return O_KR + (w < 4 ? 4 * g + w : 16 + 4 * g + (w - 4)); }
        if (jp < 36) return O_MI + (jp - 32); if (jp < 40) return O_MF + (jp - 36); return -1; }
    if (t < 4) return O_GA + 256 * (t - 2) + j;
    if (t == 4) { cs = 0.125f; return O_MQ + j; }
    if (t == 5) return O_MK + j;
    if (t < 8) return O_MV + 256 * (t - 6) + j;
    if (t < 24) { const int kind = (t - 8) >> 2, c0 = ((t - 8) & 3) * 128, jj = j & 127, hi = j >> 7;
        const int a = kind == 0 ? O_MO : kind == 1 ? O_CX : kind == 2 ? O_CB : O_DU, b = kind == 0 ? O_GB : kind == 1 ? O_CC : kind == 2 ? O_GC : O_GD;
        return (hi ? b : a) + c0 + jj; }
    return O_DV + 256 * (t - 24) + j;
}
__host__ __device__ __forceinline__ int map_q(int vc) { if (vc < 512) return (vc >> 6) * 96 + (vc & 63); const int j = vc - 512, hi = j >> 7, jj = j & 127; return (jj >> 4) * 96 + 64 + 16 * hi + (jj & 15); }
__host__ __device__ __forceinline__ int map_kv(int vc) { const int isv = vc >> 9, j = vc & 511; return (j >> 6) * 128 + 64 * isv + (j & 63); }

constexpr size_t MiB = 1u << 20;
constexpr size_t WS_CTL = 0, CTL_ZERO_BYTES = 64 * 1024;
constexpr size_t WS_WB = 1 * MiB;
constexpr size_t WB_IN = 0, WB_GATE = WB_IN + (size_t)NV_IN * 1024 * 2, WB_P = WB_GATE + (size_t)4096 * 1024 * 2  , WB_UQ = WB_P + (size_t)4 * 1024 * 1024 * 2,
                 WB_UKV = WB_UQ + (size_t)768 * 256 * 2, WB_S = WB_UKV + (size_t)1024 * 128 * 2, WB_END = WB_S + (size_t)4 * 128 * 128 * 2;
static_assert(WB_END <= 30 * MiB, "weights");
constexpr size_t WS_H = 31 * MiB  , WS_ZY = WS_H + 2048, WS_ZT = 223 * MiB, WS_Q = 375 * MiB, WS_KN = 423 * MiB, WS_V = 455 * MiB, WS_KR = 487 * MiB;
constexpr size_t WS_ROPE = 489 * MiB, WS_PQ = 493 * MiB, WS_PKV = WS_PQ + MiB / 2, WS_PVS = 494 * MiB, WS_GIF = 496 * MiB, WS_MLS = 497 * MiB, WS_PO = 499 * MiB, WS_MSUM = 501 * MiB, WS_WOUT = 509 * MiB + MiB / 2  , WS_END = 512 * MiB;
constexpr size_t WS_S = WS_ZT, WS_MG = WS_ZT + 64 * MiB, WS_MO = WS_S;
static_assert(WS_ZT + (size_t)M * ZT_LD * 2 <= WS_Q && WS_H + (size_t)M * H_LD * 2 <= WS_ZT && WS_MG + (size_t)M * D * 2 <= WS_Q && WS_WOUT + (size_t)1024 * 1024 * 2 <= WS_END, "ws map");
constexpr int CW_TMO = 0, CW_BAR = 4096;
constexpr size_t WS_RDQ = WS_CTL + 256 * 1024  , WS_CDQ = WS_CTL + 512 * 1024  , WS_CDQI = WS_CTL + 768 * 1024  ;

constexpr int RING_OFF = 0, RING_BYTES = 131072, LDSCTL_OFF = RING_BYTES, MISC_OFF = LDSCTL_OFF + 320, LDS_BYTES = 147456;

#define GAS __attribute__((address_space(1)))
#define LAS __attribute__((address_space(3)))
typedef unsigned short bf16;
typedef unsigned v4u __attribute__((ext_vector_type(4)));
typedef float f32x4 __attribute__((ext_vector_type(4)));
typedef short bf16x8 __attribute__((ext_vector_type(8)));
typedef GAS unsigned gu32;
typedef GAS unsigned long long gu64;
#define RLX_AGENT __ATOMIC_RELAXED, __HIP_MEMORY_SCOPE_AGENT
#define LDS_WAIT() asm volatile("s_waitcnt lgkmcnt(0)" ::: "memory")
#define VM_WAIT() asm volatile("s_waitcnt vmcnt(0)" ::: "memory")
__device__ __forceinline__ unsigned long long rt() { return __builtin_amdgcn_s_memrealtime(); }
__device__ __forceinline__ unsigned f2bf(float f) { unsigned u = __builtin_bit_cast(unsigned, f); return (u + 0x7fffu + ((u >> 16) & 1u)) >> 16; }
__device__ __forceinline__ unsigned pk2(float lo, float hi) { return f2bf(lo) | (f2bf(hi) << 16); }

#define XB_TMO      128
#define XB_XCNT(j)  (256  + 64 * (j))
#define XB_XSUB(j)  (1280 + 64 * (j))
#define XB_XGEN(j)  (2304 + 64 * (j))
#define XB_TOP      3328
#define XB_TOPGEN   3392
#define XCD_BAR_WORDS 3456
#define XB_SPIN_CAP (1u << 18)

__device__ __forceinline__ unsigned xb_ld(unsigned* p)              { return __hip_atomic_load(p, __ATOMIC_RELAXED, __HIP_MEMORY_SCOPE_AGENT); }
__device__ __forceinline__ unsigned xb_add(unsigned* p, unsigned v) { return __hip_atomic_fetch_add(p, v, __ATOMIC_RELAXED, __HIP_MEMORY_SCOPE_AGENT); }
__device__ __forceinline__ unsigned xb_xcc_id() { return (unsigned)__builtin_amdgcn_s_getreg((3 << 11) | 20) & 0xFu; }
#define XB_SPIN(cond, bar) do { unsigned _sp = 0; while (cond) { __builtin_amdgcn_s_sleep(1); \
    if ((++_sp & 255u) == 0u) { if (xb_ld(&(bar)[XB_TMO])) break; if (_sp > XB_SPIN_CAP) { atomicAdd(&(bar)[XB_TMO], 1u); break; } } } } while (0)

struct XcdBarrier {
    unsigned* bar; unsigned x;
    volatile LAS unsigned* st;
};

__device__ __forceinline__ XcdBarrier xcd_barrier_post(unsigned* bar, volatile LAS unsigned* st) {
    XcdBarrier b; b.bar = bar; b.x = xb_xcc_id(); b.st = st;
    if (threadIdx.x == 0) (void)xb_add(&bar[XB_XCNT(b.x)], 1u);
    return b;
}
__device__ __forceinline__ void xcd_barrier_complete(unsigned* bar, unsigned x, unsigned& nloc, unsigned& nx) {
    const unsigned G = gridDim.x * gridDim.y * gridDim.z;
    unsigned sum, cnt, mine, sp = 0u;
    for (;;) {
        sum = 0u; cnt = 0u; mine = 0u;
#pragma unroll
        for (unsigned j = 0; j < 16; ++j) { const unsigned c = xb_ld(&bar[XB_XCNT(j)]); sum += c; cnt += (c > 0u) ? 1u : 0u; mine = (j == x) ? c : mine; }
        if (sum == G) break;
        __builtin_amdgcn_s_sleep(1);
        if ((++sp & 255u) == 0u) { if (xb_ld(&bar[XB_TMO])) break; if (sp > XB_SPIN_CAP) { atomicAdd(&bar[XB_TMO], 1u); break; } }
    }
    nloc = mine > 0u ? mine : 1u; nx = cnt > 0u ? cnt : 1u;
}

__device__ __forceinline__ void xcd_barrier(const XcdBarrier& b) {
    asm volatile("s_waitcnt vmcnt(0)" ::: "memory");
    __syncthreads();
    if (threadIdx.x == 0) {
        unsigned* bar = b.bar;
        __builtin_amdgcn_s_waitcnt(0);
        unsigned nloc = b.st[0], nx = b.st[1];
        if (nloc == 0u) { xcd_barrier_complete(bar, b.x, nloc, nx); b.st[0] = nloc; b.st[1] = nx; }
        const unsigned old = xb_add(&bar[XB_XSUB(b.x)], 1u);
        const unsigned gen = old / nloc;
        if (old + 1u == (gen + 1u) * nloc) {
            __builtin_amdgcn_fence(__ATOMIC_RELEASE, "agent");
            asm volatile("s_waitcnt vmcnt(0)" ::: "memory");
            const unsigned og = xb_add(&bar[XB_TOP], 1u);
            const unsigned tg = og / nx;
            if (og + 1u == (tg + 1u) * nx) xb_add(&bar[XB_TOPGEN], 1u);
            else XB_SPIN(xb_ld(&bar[XB_TOPGEN]) == tg, bar);
            __builtin_amdgcn_fence(__ATOMIC_ACQUIRE, "agent");
            xb_add(&bar[XB_XGEN(b.x)], 1u);
            asm volatile("s_waitcnt vmcnt(0)" ::: "memory");
        } else {
            XB_SPIN(xb_ld(&bar[XB_XGEN(b.x)]) == gen, bar);
            __builtin_amdgcn_fence(__ATOMIC_ACQUIRE, "agent");
            asm volatile("s_waitcnt vmcnt(0)" ::: "memory");
        }
    }
    __syncthreads();
}
namespace att {
using bf16x8 = __attribute__((ext_vector_type(8))) short;
using s16x4  = __attribute__((ext_vector_type(4))) short;
using f32x16 = __attribute__((ext_vector_type(16))) float;
using u32x4  = __attribute__((ext_vector_type(4))) unsigned;
constexpr int NW = 8, QBLK = 32, KVBLK = 64;
constexpr float THR2 = 11.5f;
constexpr int SHM_V = 16384, SHM_K = 16384, SHM_ATTN = 2 * SHM_V + 2 * SHM_K + NW * 64 * 4;
#define KSWZ(row, colB) ((row) * 256 + ((colB) ^ (((row) & 7) << 4)))
#define SBAR() __builtin_amdgcn_sched_barrier(0)
__device__ __forceinline__ int crow(int r, int hi) { return (r & 3) + 8 * (r >> 2) + 4 * hi; }
__device__ __forceinline__ unsigned cvtpk(float lo, float hi) { typedef float f2 __attribute__((ext_vector_type(2))); typedef __bf16 b2 __attribute__((ext_vector_type(2))); f2 v = {lo, hi}; b2 b = __builtin_convertvector(v, b2); return __builtin_bit_cast(unsigned, b); }
__device__ __forceinline__ void partialSM(f32x16& p0, f32x16& p1, float& m_reg, float& mn, float& alpha) {
  float pmax = p0[0];
#pragma unroll
  for (int r = 1; r < 16; ++r) pmax = fmaxf(pmax, p0[r]);
#pragma unroll
  for (int r = 0; r < 16; ++r) pmax = fmaxf(pmax, p1[r]);
  { auto rr = __builtin_amdgcn_permlane32_swap(__float_as_uint(pmax), __float_as_uint(pmax), false, false); pmax = fmaxf(__uint_as_float(rr[0]), __uint_as_float(rr[1])); }
  if (__builtin_expect(__all(pmax - m_reg <= THR2), 1)) { mn = m_reg; alpha = 1.f; }
  else { mn = fmaxf(m_reg, pmax); alpha = __builtin_amdgcn_exp2f(m_reg - mn); m_reg = mn; }
#pragma unroll
  for (int r = 0; r < 16; ++r) p0[r] = p0[r] - mn;
#pragma unroll
  for (int r = 0; r < 16; ++r) p1[r] = p1[r] - mn;
#pragma unroll
  for (int r = 0; r < 16; ++r) p0[r] = __builtin_amdgcn_exp2f(p0[r]);
}
__device__ __forceinline__ void finishSM(f32x16& p0, f32x16& p1, float alpha, float& l_reg, bf16x8& pa0, bf16x8& pa1, bf16x8& pa2, bf16x8& pa3) {
#pragma unroll
  for (int r = 0; r < 16; ++r) p1[r] = __builtin_amdgcn_exp2f(p1[r]);
  float ps = 0;
#pragma unroll
  for (int r = 0; r < 16; ++r) ps += p0[r];
#pragma unroll
  for (int r = 0; r < 16; ++r) ps += p1[r];
  { auto rr = __builtin_amdgcn_permlane32_swap(__float_as_uint(ps), __float_as_uint(ps), false, false); ps = __uint_as_float(rr[0]) + __uint_as_float(rr[1]); }
  l_reg = l_reg * alpha + ps;
#define PK4(P, BASE, OUT) do { unsigned a0 = cvtpk(P[BASE + 0], P[BASE + 1]), a1 = cvtpk(P[BASE + 2], P[BASE + 3]);   \
    unsigned b0 = cvtpk(P[BASE + 4], P[BASE + 5]), b1 = cvtpk(P[BASE + 6], P[BASE + 7]);                              \
    auto r0 = __builtin_amdgcn_permlane32_swap(a0, b0, false, false); auto r1 = __builtin_amdgcn_permlane32_swap(a1, b1, false, false); \
    u32x4 w = {r0[0], r1[0], r0[1], r1[1]}; OUT = __builtin_bit_cast(bf16x8, w); } while (0)
  PK4(p0, 0, pa0); PK4(p0, 8, pa1); PK4(p1, 0, pa2); PK4(p1, 8, pa3);
#undef PK4
}
template <int ND0> __device__ __forceinline__ void qkt(f32x16& p0, f32x16& p1, const char* Ks, const bf16x8* qr, int r32, int hi) {
  bf16x8 kf[2 * ND0];
#pragma unroll
  for (int d0 = 0; d0 < ND0; ++d0) { const int cb = (d0 * 16 + hi * 8) * 2;
    kf[2 * d0] = *reinterpret_cast<const bf16x8*>(Ks + KSWZ(r32, cb)); kf[2 * d0 + 1] = *reinterpret_cast<const bf16x8*>(Ks + KSWZ(32 + r32, cb)); }
  SBAR();
  p0 = f32x16{}; p1 = f32x16{};
#pragma unroll
  for (int d0 = 0; d0 < ND0; ++d0) { p0 = __builtin_amdgcn_mfma_f32_32x32x16_bf16(kf[2 * d0], qr[d0], p0, 0, 0, 0); p1 = __builtin_amdgcn_mfma_f32_32x32x16_bf16(kf[2 * d0 + 1], qr[d0], p1, 0, 0, 0); }
}
__device__ __forceinline__ int v_st(int k, int c) { const int kk = (k & ~0xC) | ((k & 4) << 1) | ((k & 8) >> 1); return ((kk >> 3) * 4 + (c >> 5)) * 512 + ((kk & 7) * 32 + (c & 31)) * 2; }
__device__ __forceinline__ int v_rd_base(int lane) { return ((lane & 3) << 3) | (((lane >> 2) & 3) << 6) | (((lane >> 4) & 1) << 5) | (((lane >> 5) & 1) << 8); }
constexpr int v_rd_off(int d0, int ks, int half) { return d0 * 512 + ks * 4096 + half * 2048; }
template <int OFF> __device__ __forceinline__ s16x4 tr_read(int vb) { s16x4 r; asm volatile("ds_read_b64_tr_b16 %0, %1 offset:%2" : "=&v"(r) : "v"(vb), "i"(OFF) : "memory"); return r; }
template <int D0, bool SWAP> __device__ __forceinline__ void pv_one(f32x16& od, int vb, bf16x8 pa0, bf16x8 pa1, bf16x8 pa2, bf16x8 pa3) {
  const s16x4 l0 = tr_read<v_rd_off(D0, 0, 0)>(vb), h0 = tr_read<v_rd_off(D0, 0, 1)>(vb), l1 = tr_read<v_rd_off(D0, 1, 0)>(vb), h1 = tr_read<v_rd_off(D0, 1, 1)>(vb);
  const s16x4 l2 = tr_read<v_rd_off(D0, 2, 0)>(vb), h2 = tr_read<v_rd_off(D0, 2, 1)>(vb), l3 = tr_read<v_rd_off(D0, 3, 0)>(vb), h3 = tr_read<v_rd_off(D0, 3, 1)>(vb);
  asm volatile("s_waitcnt lgkmcnt(0)" ::: "memory"); SBAR();
#define PK(L, H) (bf16x8){L[0], L[1], L[2], L[3], H[0], H[1], H[2], H[3]}
  if (SWAP) {
    od = __builtin_amdgcn_mfma_f32_32x32x16_bf16(PK(l0, h0), pa0, od, 0, 0, 0); od = __builtin_amdgcn_mfma_f32_32x32x16_bf16(PK(l1, h1), pa1, od, 0, 0, 0);
    od = __builtin_amdgcn_mfma_f32_32x32x16_bf16(PK(l2, h2), pa2, od, 0, 0, 0); od = __builtin_amdgcn_mfma_f32_32x32x16_bf16(PK(l3, h3), pa3, od, 0, 0, 0);
  } else {
    od = __builtin_amdgcn_mfma_f32_32x32x16_bf16(pa0, PK(l0, h0), od, 0, 0, 0); od = __builtin_amdgcn_mfma_f32_32x32x16_bf16(pa1, PK(l1, h1), od, 0, 0, 0);
    od = __builtin_amdgcn_mfma_f32_32x32x16_bf16(pa2, PK(l2, h2), od, 0, 0, 0); od = __builtin_amdgcn_mfma_f32_32x32x16_bf16(pa3, PK(l3, h3), od, 0, 0, 0);
  }
#undef PK
}

__device__ __forceinline__ void pv2(f32x16& o0, f32x16& o1, int vb, bf16x8 pa0, bf16x8 pa1, bf16x8 pa2, bf16x8 pa3) {
  const s16x4 l0 = tr_read<v_rd_off(0, 0, 0)>(vb), h0 = tr_read<v_rd_off(0, 0, 1)>(vb), m0 = tr_read<v_rd_off(1, 0, 0)>(vb), n0 = tr_read<v_rd_off(1, 0, 1)>(vb);
  const s16x4 l1 = tr_read<v_rd_off(0, 1, 0)>(vb), h1 = tr_read<v_rd_off(0, 1, 1)>(vb), m1 = tr_read<v_rd_off(1, 1, 0)>(vb), n1 = tr_read<v_rd_off(1, 1, 1)>(vb);
  const s16x4 l2 = tr_read<v_rd_off(0, 2, 0)>(vb), h2 = tr_read<v_rd_off(0, 2, 1)>(vb), m2 = tr_read<v_rd_off(1, 2, 0)>(vb), n2 = tr_read<v_rd_off(1, 2, 1)>(vb);
  const s16x4 l3 = tr_read<v_rd_off(0, 3, 0)>(vb), h3 = tr_read<v_rd_off(0, 3, 1)>(vb), m3 = tr_read<v_rd_off(1, 3, 0)>(vb), n3 = tr_read<v_rd_off(1, 3, 1)>(vb);
  asm volatile("s_waitcnt lgkmcnt(0)" ::: "memory"); SBAR();
#define PK(L, H) (bf16x8){L[0], L[1], L[2], L[3], H[0], H[1], H[2], H[3]}
  o0 = __builtin_amdgcn_mfma_f32_32x32x16_bf16(pa0, PK(l0, h0), o0, 0, 0, 0); o1 = __builtin_amdgcn_mfma_f32_32x32x16_bf16(pa0, PK(m0, n0), o1, 0, 0, 0);
  o0 = __builtin_amdgcn_mfma_f32_32x32x16_bf16(pa1, PK(l1, h1), o0, 0, 0, 0); o1 = __builtin_amdgcn_mfma_f32_32x32x16_bf16(pa1, PK(m1, n1), o1, 0, 0, 0);
  o0 = __builtin_amdgcn_mfma_f32_32x32x16_bf16(pa2, PK(l2, h2), o0, 0, 0, 0); o1 = __builtin_amdgcn_mfma_f32_32x32x16_bf16(pa2, PK(m2, n2), o1, 0, 0, 0);
  o0 = __builtin_amdgcn_mfma_f32_32x32x16_bf16(pa3, PK(l3, h3), o0, 0, 0, 0); o1 = __builtin_amdgcn_mfma_f32_32x32x16_bf16(pa3, PK(m3, n3), o1, 0, 0, 0);
#undef PK
}
__device__ __forceinline__ void finishSM2(f32x16& p0, f32x16& p1, bf16x8& pa0, bf16x8& pa1, bf16x8& pa2, bf16x8& pa3) {
#pragma unroll
  for (int r = 0; r < 16; ++r) p1[r] = __builtin_amdgcn_exp2f(p1[r]);
#define PK4(P, BASE, OUT) do { unsigned a0 = cvtpk(P[BASE + 0], P[BASE + 1]), a1 = cvtpk(P[BASE + 2], P[BASE + 3]);   \
    unsigned b0 = cvtpk(P[BASE + 4], P[BASE + 5]), b1 = cvtpk(P[BASE + 6], P[BASE + 7]);                              \
    auto r0 = __builtin_amdgcn_permlane32_swap(a0, b0, false, false); auto r1 = __builtin_amdgcn_permlane32_swap(a1, b1, false, false); \
    u32x4 w = {r0[0], r1[0], r0[1], r1[1]}; OUT = __builtin_bit_cast(bf16x8, w); } while (0)
  PK4(p0, 0, pa0); PK4(p0, 8, pa1); PK4(p1, 0, pa2); PK4(p1, 8, pa3);
#undef PK4
}
__device__ __forceinline__ void pv2l(f32x16& o0, f32x16& o1, f32x16& ls, int vb, bf16x8 pa0, bf16x8 pa1, bf16x8 pa2, bf16x8 pa3) {
  const s16x4 l0 = tr_read<v_rd_off(0, 0, 0)>(vb), h0 = tr_read<v_rd_off(0, 0, 1)>(vb), m0 = tr_read<v_rd_off(1, 0, 0)>(vb), n0 = tr_read<v_rd_off(1, 0, 1)>(vb);
  const s16x4 l1 = tr_read<v_rd_off(0, 1, 0)>(vb), h1 = tr_read<v_rd_off(0, 1, 1)>(vb), m1 = tr_read<v_rd_off(1, 1, 0)>(vb), n1 = tr_read<v_rd_off(1, 1, 1)>(vb);
  const s16x4 l2 = tr_read<v_rd_off(0, 2, 0)>(vb), h2 = tr_read<v_rd_off(0, 2, 1)>(vb), m2 = tr_read<v_rd_off(1, 2, 0)>(vb), n2 = tr_read<v_rd_off(1, 2, 1)>(vb);
  const s16x4 l3 = tr_read<v_rd_off(0, 3, 0)>(vb), h3 = tr_read<v_rd_off(0, 3, 1)>(vb), m3 = tr_read<v_rd_off(1, 3, 0)>(vb), n3 = tr_read<v_rd_off(1, 3, 1)>(vb);
  const short one = 0x3f80; const bf16x8 ones = {one, one, one, one, one, one, one, one};
  asm volatile("s_waitcnt lgkmcnt(0)" ::: "memory"); SBAR();
#define PK(L, H) (bf16x8){L[0], L[1], L[2], L[3], H[0], H[1], H[2], H[3]}
  o0 = __builtin_amdgcn_mfma_f32_32x32x16_bf16(pa0, PK(l0, h0), o0, 0, 0, 0); o1 = __builtin_amdgcn_mfma_f32_32x32x16_bf16(pa0, PK(m0, n0), o1, 0, 0, 0); ls = __builtin_amdgcn_mfma_f32_32x32x16_bf16(pa0, ones, ls, 0, 0, 0);
  o0 = __builtin_amdgcn_mfma_f32_32x32x16_bf16(pa1, PK(l1, h1), o0, 0, 0, 0); o1 = __builtin_amdgcn_mfma_f32_32x32x16_bf16(pa1, PK(m1, n1), o1, 0, 0, 0); ls = __builtin_amdgcn_mfma_f32_32x32x16_bf16(pa1, ones, ls, 0, 0, 0);
  o0 = __builtin_amdgcn_mfma_f32_32x32x16_bf16(pa2, PK(l2, h2), o0, 0, 0, 0); o1 = __builtin_amdgcn_mfma_f32_32x32x16_bf16(pa2, PK(m2, n2), o1, 0, 0, 0); ls = __builtin_amdgcn_mfma_f32_32x32x16_bf16(pa2, ones, ls, 0, 0, 0);
  o0 = __builtin_amdgcn_mfma_f32_32x32x16_bf16(pa3, PK(l3, h3), o0, 0, 0, 0); o1 = __builtin_amdgcn_mfma_f32_32x32x16_bf16(pa3, PK(m3, n3), o1, 0, 0, 0); ls = __builtin_amdgcn_mfma_f32_32x32x16_bf16(pa3, ones, ls, 0, 0, 0);
#undef PK
}
__device__ __forceinline__ void pv_kv(f32x16& acc, int vbk, int vbv) {
  const s16x4 al0 = tr_read<v_rd_off(0, 0, 0)>(vbk), ah0 = tr_read<v_rd_off(0, 0, 1)>(vbk), al1 = tr_read<v_rd_off(0, 1, 0)>(vbk), ah1 = tr_read<v_rd_off(0, 1, 1)>(vbk);
  const s16x4 al2 = tr_read<v_rd_off(0, 2, 0)>(vbk), ah2 = tr_read<v_rd_off(0, 2, 1)>(vbk), al3 = tr_read<v_rd_off(0, 3, 0)>(vbk), ah3 = tr_read<v_rd_off(0, 3, 1)>(vbk);
  const s16x4 bl0 = tr_read<v_rd_off(0, 0, 0)>(vbv), bh0 = tr_read<v_rd_off(0, 0, 1)>(vbv), bl1 = tr_read<v_rd_off(0, 1, 0)>(vbv), bh1 = tr_read<v_rd_off(0, 1, 1)>(vbv);
  const s16x4 bl2 = tr_read<v_rd_off(0, 2, 0)>(vbv), bh2 = tr_read<v_rd_off(0, 2, 1)>(vbv), bl3 = tr_read<v_rd_off(0, 3, 0)>(vbv), bh3 = tr_read<v_rd_off(0, 3, 1)>(vbv);
  asm volatile("s_waitcnt lgkmcnt(0)" ::: "memory"); SBAR();
#define PK(L, H) (bf16x8){L[0], L[1], L[2], L[3], H[0], H[1], H[2], H[3]}
  acc = __builtin_amdgcn_mfma_f32_32x32x16_bf16(PK(al0, ah0), PK(bl0, bh0), acc, 0, 0, 0); acc = __builtin_amdgcn_mfma_f32_32x32x16_bf16(PK(al1, ah1), PK(bl1, bh1), acc, 0, 0, 0);
  acc = __builtin_amdgcn_mfma_f32_32x32x16_bf16(PK(al2, ah2), PK(bl2, bh2), acc, 0, 0, 0); acc = __builtin_amdgcn_mfma_f32_32x32x16_bf16(PK(al3, ah3), PK(bl3, bh3), acc, 0, 0, 0);
#undef PK
}
__device__ __forceinline__ void attn_unit(int b, int h, int qb, const bf16* Q, const bf16* __restrict__ KN, const bf16* __restrict__ KR, const bf16* __restrict__ V, bf16* Y, char* lds) {
  int tid = threadIdx.x; asm volatile("" : "+v"(tid));
  const int wid = __builtin_amdgcn_readfirstlane(tid >> 6), lane = tid & 63, r32 = lane & 31, hi = lane >> 5;
  char* V_lds = lds; char* K_lds = lds + 2 * SHM_V;
  float* ws = (float*)(lds + 2 * SHM_V + 2 * SHM_K) + wid * 64; float* li_l = ws; float* al_l = ws + 32;
  float m_reg = -1e30f, l_reg = 0; f32x16 o[2] = {}; bf16x8 qr[6];
  const size_t rowbase = (size_t)b * SEQ; const int q0 = qb * 256;
  const bf16* Qw = Q + (rowbase + q0 + wid * QBLK + r32) * 768 + h * 96 + hi * 8;
#pragma unroll
  for (int d0 = 0; d0 < 6; ++d0) qr[d0] = *reinterpret_cast<const bf16x8*>(Qw + d0 * 16);
  const int sr = tid >> 4, sc = (tid & 15) * 8, vst0 = v_st(sr, sc & 63), vst1 = v_st(32 + sr, sc & 63);
  const bool doK = sc < 96, doV = sc < 64;
  const bf16* ksrc = sc < 64 ? KN + rowbase * 512 + h * 64 + sc : KR + rowbase * 32 + (sc - 64); const int kld = sc < 64 ? 512 : 32;
  const bf16* vsrc = V + rowbase * 512 + h * 64 + (sc & 63);
  const int vb0 = (int)(uintptr_t)V_lds + v_rd_base(lane);
  struct { bf16x8 vs0, vs1, ks0, ks1; } sr_[2];
#define SLOAD(i, k0) do { if (doV) { sr_[i].vs0 = *(const bf16x8*)(vsrc + (size_t)((k0) + sr) * 512); sr_[i].vs1 = *(const bf16x8*)(vsrc + (size_t)((k0) + 32 + sr) * 512); } \
    if (doK) { sr_[i].ks0 = *(const bf16x8*)(ksrc + (size_t)((k0) + sr) * kld); sr_[i].ks1 = *(const bf16x8*)(ksrc + (size_t)((k0) + 32 + sr) * kld); } } while (0)
#define SWRITE(bb, i) do { if (doV) { *(bf16x8*)(V_lds + (bb) * SHM_V + vst0) = sr_[i].vs0; *(bf16x8*)(V_lds + (bb) * SHM_V + vst1) = sr_[i].vs1; } \
    if (doK) { const int kc = sc * 2; *(bf16x8*)(K_lds + (bb) * SHM_K + KSWZ(sr, kc)) = sr_[i].ks0; *(bf16x8*)(K_lds + (bb) * SHM_K + KSWZ(32 + sr, kc)) = sr_[i].ks1; } } while (0)
#define SWAIT() asm volatile("s_waitcnt vmcnt(4)" ::: "memory")
#define RESC(a) do { if (__any((a) < 1.f)) { if (hi == 0) al_l[r32] = (a); asm volatile("s_waitcnt lgkmcnt(0)" ::: "memory"); \
    _Pragma("unroll") for (int d = 0; d < 2; ++d) _Pragma("unroll") for (int r = 0; r < 16; ++r) o[d][r] *= al_l[crow(r, hi)]; } } while (0)
#define MASK(P0, P1, j) do { if ((j) >= NTw) { _Pragma("unroll") for (int r = 0; r < 16; ++r) { P0[r] = -INFINITY; P1[r] = -INFINITY; } } } while (0)
  f32x16 pA0, pA1, pB0, pB1; float mnA, mnB, alA, alB; bf16x8 pa0, pa1, pa2, pa3;
  const int NT = 4 * qb + 4, NTw = 4 * qb + (wid >> 1) + 1;
  constexpr int SE = 0, SO = 1;
  SLOAD(SE, 0); asm volatile("s_waitcnt vmcnt(0)" ::: "memory"); SWRITE(0, SE); __syncthreads();
  qkt<6>(pA0, pA1, K_lds, qr, r32, hi); partialSM(pA0, pA1, m_reg, mnA, alA);
  SLOAD(SO, KVBLK); if (2 < NT) SLOAD(SE, 2 * KVBLK);
  SWAIT(); SWRITE(1, SO); __syncthreads();
  for (int j = 1; j + 1 < NT; j += 2) {
    SBAR(); qkt<6>(pB0, pB1, K_lds + SHM_K, qr, r32, hi); MASK(pB0, pB1, j);
    finishSM(pA0, pA1, alA, l_reg, pa0, pa1, pa2, pa3); SBAR();
    SLOAD(SO, (j + 2) * KVBLK); SBAR();
    pv_one<0, false>(o[0], vb0, pa0, pa1, pa2, pa3); pv_one<1, false>(o[1], vb0, pa0, pa1, pa2, pa3); partialSM(pB0, pB1, m_reg, mnB, alB);
    __syncthreads(); SWAIT(); SWRITE(0, SE);
    RESC(alB); __syncthreads();
    SBAR(); qkt<6>(pA0, pA1, K_lds, qr, r32, hi); MASK(pA0, pA1, j + 1);
    finishSM(pB0, pB1, alB, l_reg, pa0, pa1, pa2, pa3); SBAR();
    if (j + 3 < NT) SLOAD(SE, (j + 3) * KVBLK); SBAR();
    pv_one<0, false>(o[0], vb0 + SHM_V, pa0, pa1, pa2, pa3); pv_one<1, false>(o[1], vb0 + SHM_V, pa0, pa1, pa2, pa3); partialSM(pA0, pA1, m_reg, mnA, alA);
    __syncthreads(); SWAIT(); SWRITE(1, SO);
    RESC(alA); __syncthreads();
  }
  SBAR(); qkt<6>(pB0, pB1, K_lds + SHM_K, qr, r32, hi); MASK(pB0, pB1, NT - 1);
  finishSM(pA0, pA1, alA, l_reg, pa0, pa1, pa2, pa3); SBAR();
  pv_one<0, false>(o[0], vb0, pa0, pa1, pa2, pa3); pv_one<1, false>(o[1], vb0, pa0, pa1, pa2, pa3); partialSM(pB0, pB1, m_reg, mnB, alB);
  __syncthreads(); RESC(alB);
  finishSM(pB0, pB1, alB, l_reg, pa0, pa1, pa2, pa3); SBAR();
  pv_one<0, false>(o[0], vb0 + SHM_V, pa0, pa1, pa2, pa3); pv_one<1, false>(o[1], vb0 + SHM_V, pa0, pa1, pa2, pa3);
  if (hi == 0) li_l[r32] = l_reg; asm volatile("s_waitcnt lgkmcnt(0)" ::: "memory");
  bf16* Yw = Y + (rowbase + q0 + wid * QBLK) * ZY_LD + YA + h * 64;
#pragma unroll
  for (int r = 0; r < 16; ++r) { const int orow = crow(r, hi); const float rl = __builtin_amdgcn_rcpf(li_l[orow]);
#pragma unroll
    for (int d0 = 0; d0 < 2; ++d0) { bf16* p = Yw + (size_t)orow * ZY_LD + d0 * 32 + r32; const float g = __uint_as_float((unsigned)*p << 16); *p = (bf16)f2bf(o[d0][r] * rl * g); } }
  __syncthreads();
#undef SLOAD
#undef SWRITE
#undef SWAIT
#undef RESC
#undef MASK
}

__device__ __forceinline__ void glds16(const void* gsrc, unsigned lds_dst) { unsigned keep;
  asm volatile("s_mov_b32 %0, m0\n\ts_mov_b32 m0, %2\n\ts_nop 0\n\tglobal_load_lds_dwordx4 %1, off\n\ts_mov_b32 m0, %0" : "=&s"(keep) : "v"(gsrc), "s"(lds_dst) : "memory"); }
#define WAIT_BAR(N) asm volatile("s_waitcnt vmcnt(" #N ") lgkmcnt(0)\n\ts_barrier" ::: "memory")
template <int ND0> __device__ __forceinline__ void qkt_c(f32x16& p0, f32x16& p1, const f32x16& c, const char* Ks, const bf16x8* qr, int r32, int hi) {
  bf16x8 kf[2 * ND0];
#pragma unroll
  for (int d0 = 0; d0 < ND0; ++d0) { const int cb = (d0 * 16 + hi * 8) * 2;
    kf[2 * d0] = *reinterpret_cast<const bf16x8*>(Ks + KSWZ(r32, cb)); kf[2 * d0 + 1] = *reinterpret_cast<const bf16x8*>(Ks + KSWZ(32 + r32, cb)); }
  SBAR();
#pragma unroll
  for (int d0 = 0; d0 < ND0; ++d0) {
    if (d0 == 0) { p0 = __builtin_amdgcn_mfma_f32_32x32x16_bf16(kf[0], qr[0], c, 0, 0, 0); p1 = __builtin_amdgcn_mfma_f32_32x32x16_bf16(kf[1], qr[0], c, 0, 0, 0); }
    else { p0 = __builtin_amdgcn_mfma_f32_32x32x16_bf16(kf[2 * d0], qr[d0], p0, 0, 0, 0); p1 = __builtin_amdgcn_mfma_f32_32x32x16_bf16(kf[2 * d0 + 1], qr[d0], p1, 0, 0, 0); } }
}
__device__ __forceinline__ void partialSM2(f32x16& p0, f32x16& p1, float& m_reg, f32x16& negm, float& alpha, bool first) {
  float pmax = p0[0];
#pragma unroll
  for (int r = 1; r < 16; ++r) pmax = fmaxf(pmax, p0[r]);
#pragma unroll
  for (int r = 0; r < 16; ++r) pmax = fmaxf(pmax, p1[r]);
  { auto rr = __builtin_amdgcn_permlane32_swap(__float_as_uint(pmax), __float_as_uint(pmax), false, false); pmax = fmaxf(__uint_as_float(rr[0]), __uint_as_float(rr[1])); }
  alpha = 1.f;
  if (__builtin_expect(first || __any(pmax > THR2), 0)) { const float dl = first ? pmax : fmaxf(pmax, 0.f); m_reg += dl; alpha = __builtin_amdgcn_exp2f(-dl);
#pragma unroll
    for (int r = 0; r < 16; ++r) { p0[r] -= dl; p1[r] -= dl; negm[r] = -m_reg; } }
#pragma unroll
  for (int r = 0; r < 16; ++r) p0[r] = __builtin_amdgcn_exp2f(p0[r]);
}

__device__ __forceinline__ void attn_unit2(int b, int h, int qb, const bf16* Q, const bf16* __restrict__ KN, const bf16* __restrict__ KR, const bf16* __restrict__ V, bf16* Y, char* lds) {
  int tid = threadIdx.x; asm volatile("" : "+v"(tid));
  const int wid = __builtin_amdgcn_readfirstlane(tid >> 6), lane = tid & 63, r32 = lane & 31, hi = lane >> 5;
  constexpr int OFF_K = 0, OFF_V = 3 * SHM_K, OFF_WS = 3 * SHM_K + 3 * SHM_V;
  const unsigned lds0 = (unsigned)(uintptr_t)lds;
  float* ws = (float*)(lds + OFF_WS) + wid * 64; float* li_l = ws; float* al_l = ws + 32;
  const size_t rowbase = (size_t)b * SEQ; const int q0 = qb * 256;
  bf16x8 qr[6];
  const bf16* ksrc[2]; bool kval[2];
#pragma unroll
  for (int i = 0; i < 2; ++i) { const int row = 8 * wid + 4 * i + (lane >> 4), gc = (lane & 15) ^ (row & 7); kval[i] = gc < 12;
    ksrc[i] = gc < 8 ? KN + (rowbase + row) * 512 + h * 64 + gc * 8 : KR + (rowbase + row) * 32 + ((gc - 8) & 3) * 8; }
  const int kstr0 = 512 * 64, kstr1 = 32 * 64;
  const bf16* vsrc; { const int kk = 8 * wid + ((lane & 31) >> 2), k = (kk & ~0xC) | ((kk & 4) << 1) | ((kk & 8) >> 1); vsrc = V + (rowbase + k) * 512 + h * 64 + (lane >> 5) * 32 + (lane & 3) * 8; }
  const unsigned kdst = lds0 + OFF_K + wid * 2048, vdst = lds0 + OFF_V + wid * 2048;
#define DMA_K(t, slot) do { _Pragma("unroll") for (int i_ = 0; i_ < 2; ++i_) { const bool isn = ((lane & 15) ^ ((4 * i_ + (lane >> 4)) & 7)) < 8; \
    if (kval[i_]) glds16(ksrc[i_] + (size_t)(t) * (isn ? kstr0 : kstr1), (unsigned)__builtin_amdgcn_readfirstlane(kdst + (slot) * SHM_K + i_ * 1024)); } } while (0)
#define DMA_V(t, slot) glds16(vsrc + (size_t)(t) * (512 * 64), (unsigned)__builtin_amdgcn_readfirstlane(vdst + (slot) * SHM_V))
  const int vb0 = (int)(lds0 + OFF_V) + v_rd_base(lane);
  float m_reg = 0.f; f32x16 o[2] = {}; f32x16 lacc = {}; f32x16 negm = {}; asm volatile("" : "+v"(negm));
  f32x16 pA0, pA1, pB0, pB1; float alA = 1.f, alB = 1.f; bf16x8 pa0, pa1, pa2, pa3;
  const int NT = 4 * qb + 4, NTw = 4 * qb + (wid >> 1) + 1;
#define RESC(a) do { if (__any((a) < 1.f)) { if (hi == 0) al_l[r32] = (a); asm volatile("s_waitcnt lgkmcnt(0)" ::: "memory"); \
    _Pragma("unroll") for (int r = 0; r < 16; ++r) { const float f_ = al_l[crow(r, hi)]; o[0][r] *= f_; o[1][r] *= f_; lacc[r] *= f_; } } } while (0)
  int sk = 0, sv = 2;
#define ROT3(s) ((s) == 2 ? 0 : (s) + 1)
#define STEP(C0, C1, ALC, P0, P1, ALP, t, FIRST) do { \
    const int nk_ = ((t) + 2 < NT) ? 2 : 0, nv_ = ((t) + 1 < NT) ? 1 : 0; \
    if (nk_) DMA_K((t) + 2, (sk == 0 ? 2 : sk - 1)); if (nv_) DMA_V((t) + 1, (sv == 0 ? 2 : sv - 1)); \
    const bool vc_ = (t) < NTw, vp_ = !(FIRST) && ((t) - 1) < NTw; \
    if (vc_) { SBAR(); qkt_c<6>(C0, C1, negm, lds + OFF_K + sk * SHM_K, qr, r32, hi); } \
    if (vp_) { finishSM2(P0, P1, pa0, pa1, pa2, pa3); SBAR(); pv2l(o[0], o[1], lacc, vb0 + sv * SHM_V, pa0, pa1, pa2, pa3); } \
    if (vc_) { partialSM2(C0, C1, m_reg, negm, ALC, (FIRST)); RESC(ALC); } \
    if (nk_ + nv_ == 3) WAIT_BAR(3); else if (nk_ + nv_ == 1) WAIT_BAR(1); else WAIT_BAR(0); \
    sk = ROT3(sk); sv = ROT3(sv); } while (0)
  DMA_K(0, 0); DMA_V(0, 0); DMA_K(1, 1);
  { const bf16* Qw = Q + (rowbase + q0 + wid * QBLK + r32) * 768 + h * 96 + hi * 8;
#pragma unroll
    for (int d0 = 0; d0 < 6; ++d0) qr[d0] = *reinterpret_cast<const bf16x8*>(Qw + d0 * 16);
#pragma unroll
    for (int d0 = 0; d0 < 6; ++d0) asm volatile("" : "+v"(qr[d0])); }
  WAIT_BAR(0);
  STEP(pA0, pA1, alA, pB0, pB1, alB, 0, true);
  for (int t = 1; t + 1 < NT; t += 2) {
    STEP(pB0, pB1, alB, pA0, pA1, alA, t, false);
    STEP(pA0, pA1, alA, pB0, pB1, alB, t + 1, false);
  }
  STEP(pB0, pB1, alB, pA0, pA1, alA, NT - 1, false);
  if (NT - 1 < NTw) { finishSM2(pB0, pB1, pa0, pa1, pa2, pa3); SBAR(); pv2l(o[0], o[1], lacc, vb0 + sv * SHM_V, pa0, pa1, pa2, pa3); }
  asm volatile("s_waitcnt vmcnt(0) lgkmcnt(0)\n\ts_barrier" ::: "memory");
  { char* T = lds + OFF_K + wid * 4608;
    bf16* Yw = Y + (rowbase + q0 + wid * QBLK) * ZY_LD + YA + h * 64;
    typedef unsigned u32x4a __attribute__((ext_vector_type(4)));
    u32x4a gv[4];
#pragma unroll
    for (int i = 0; i < 4; ++i) { const int c = lane + 64 * i; gv[i] = *(const u32x4a*)(Yw + (size_t)(c >> 3) * ZY_LD + (c & 7) * 8); }
#pragma unroll
    for (int r = 0; r < 16; ++r) { const int orow = crow(r, hi); const float rl = __builtin_amdgcn_rcpf(lacc[r]);
#pragma unroll
      for (int d0 = 0; d0 < 2; ++d0) *(bf16*)(T + orow * 144 + (d0 * 32 + r32) * 2) = (bf16)f2bf(o[d0][r] * rl); }
    asm volatile("s_waitcnt lgkmcnt(0)" ::: "memory");
#pragma unroll
    for (int i = 0; i < 4; ++i) { const int c = lane + 64 * i; const u32x4a tv = *(const u32x4a*)(T + (c >> 3) * 144 + (c & 7) * 16); u32x4a ov;
#pragma unroll
      for (int k = 0; k < 4; ++k) { const float lo = __uint_as_float(tv[k] << 16) * __uint_as_float(gv[i][k] << 16), hi2 = __uint_as_float(tv[k] & 0xffff0000u) * __uint_as_float(gv[i][k] & 0xffff0000u);
        ov[k] = (unsigned)f2bf(lo) | ((unsigned)f2bf(hi2) << 16); }
      *(u32x4a*)(Yw + (size_t)(c >> 3) * ZY_LD + (c & 7) * 8) = ov; } }
  asm volatile("s_waitcnt vmcnt(0) lgkmcnt(0)\n\ts_barrier" ::: "memory");
#undef DMA_K
#undef DMA_V
#undef RESC
#undef ROT3
#undef STEP
}
#undef WAIT_BAR
#undef KSWZ
#undef SBAR
}
namespace mls {
using att::bf16x8; using att::s16x4; using att::f32x16; using att::u32x4;
typedef unsigned u32x2g __attribute__((ext_vector_type(2)));
__device__ __forceinline__ float blo(unsigned w) { return __uint_as_float(w << 16); }
__device__ __forceinline__ float bhi(unsigned w) { return __uint_as_float(w & 0xffff0000u); }
constexpr int SHM_V = 16384, SHM_K = 16384, SHM_AP = 256, OFF_ST = 2 * SHM_V + 2 * SHM_K + 2 * SHM_AP + 512  , OFF_NS = OFF_ST + 16384, OFF_MX = OFF_NS + 256, SHM_TOT = OFF_MX + 64;
#define KSWZ(row, colB) ((row) * 256 + ((colB) ^ (((row) & 7) << 4)))
__device__ __forceinline__ void mlstm_unit(int b, int h, int qb, const bf16* __restrict__ ZT, const float* __restrict__ MLS, const float* __restrict__ gmh, const bf16* __restrict__ CK, const float* __restrict__ NK, const float* __restrict__ ML, bf16* Y, char* lds) {
  int tid = threadIdx.x; asm volatile("" : "+v"(tid));
  const int wid = __builtin_amdgcn_readfirstlane(tid >> 6), lane = tid & 63, r32 = lane & 31, hi = lane >> 5;
  char* V_lds = lds; char* K_lds = lds + 2 * SHM_V; float* AP = (float*)(lds + 2 * SHM_V + 2 * SHM_K);
  const size_t rowbase = (size_t)b * SEQ; const int q0 = qb * 256, tq = q0 + wid * 32 + r32; const size_t qrow = rowbase + tq;
  bf16x8 qr[4];
#pragma unroll
  for (int d0 = 0; d0 < 4; ++d0) qr[d0] = *reinterpret_cast<const bf16x8*>(ZT + qrow * ZT_LD + ZT_MQ + h * 64 + d0 * 16 + hi * 8);
  const f32x4 me = *(const f32x4*)(MLS + (qrow * 4 + h) * 4); const float At2 = me.y * 1.4426950409f, mt = me.z;
  const int sr = tid >> 4, sc = (tid & 15) * 8, vst0 = att::v_st(sr, sc), vst1 = att::v_st(32 + sr, sc); const bool doK = sc < 64;
  const bf16* ksrc = ZT + rowbase * ZT_LD + ZT_MK + h * 64 + (sc & 63); const bf16* vsrc = ZT + rowbase * ZT_LD + ZT_MV + h * 128 + sc;
  const int vb0 = (int)(uintptr_t)V_lds + att::v_rd_base(lane);
  bf16x8 vs0, vs1, ks0, ks1; float aps = 0.f;
#define SLOAD(k0) do { vs0 = *(const bf16x8*)(vsrc + (size_t)((k0) + sr) * ZT_LD); vs1 = *(const bf16x8*)(vsrc + (size_t)((k0) + 32 + sr) * ZT_LD); \
    if (doK) { ks0 = *(const bf16x8*)(ksrc + (size_t)((k0) + sr) * ZT_LD); ks1 = *(const bf16x8*)(ksrc + (size_t)((k0) + 32 + sr) * ZT_LD); } \
    if (tid < 64) aps = MLS[((rowbase + (k0) + tid) * 4 + h) * 4] * 1.4426950409f; } while (0)
#define SWRITE(bb) do { *(bf16x8*)(V_lds + (bb) * SHM_V + vst0) = vs0; *(bf16x8*)(V_lds + (bb) * SHM_V + vst1) = vs1; \
    if (doK) { const int kc = sc * 2; *(bf16x8*)(K_lds + (bb) * SHM_K + KSWZ(sr, kc)) = ks0; *(bf16x8*)(K_lds + (bb) * SHM_K + KSWZ(32 + sr, kc)) = ks1; } \
    if (tid < 64) AP[(bb) * 64 + tid] = aps; } while (0)
  f32x16 o[4] = {}; float den = 0.f;
  const int J0 = 4 * qb, NT = 4 * qb + 4, jd = 4 * qb + (wid >> 1);
  SLOAD(J0 * 64);
  if (qb > 0) {
    float* MX = (float*)(lds + OFF_MX); float* NS = (float*)(lds + OFF_NS); const int u0 = (b * 4 + h) * 16;
    if (tid < 16) { float Mj = -INFINITY; if (tid < qb) { float Bst = 0.f; if (tid > 0) { const f32x4 pr = *(const f32x4*)(MLS + ((rowbase + tid * 256 - 1) * 4 + h) * 4); Bst = pr.z - pr.y; } Mj = ML[u0 + tid] - Bst; } MX[tid] = Mj * 1.4426950409f; }
    __syncthreads();
    float Mp = MX[0];
    for (int j = 1; j < qb; ++j) Mp = fmaxf(Mp, MX[j]);
    float c0[8], c1[8]; float ns = 0.f;
#pragma unroll
    for (int e = 0; e < 8; ++e) { c0[e] = 0.f; c1[e] = 0.f; }
    for (int j0 = 0; j0 < qb; j0 += 4) {
      v4u x0[4], x1[4]; float fj[4], nk[4];
#pragma unroll
      for (int d = 0; d < 4; ++d) { const int j = j0 + d; const bool ok = j < qb; const int jj = ok ? j : j0; fj[d] = ok ? __builtin_amdgcn_exp2f(MX[jj] - Mp) : 0.f;
        const bf16* cj = CK + (size_t)(u0 + jj) * 8192 + sc; x0[d] = *(const v4u*)(cj + sr * 128); x1[d] = *(const v4u*)(cj + (32 + sr) * 128); nk[d] = tid < 64 ? NK[(u0 + jj) * 64 + tid] : 0.f; }
#pragma unroll
      for (int d = 0; d < 4; ++d) { const float f = fj[d];
#pragma unroll
        for (int k = 0; k < 4; ++k) { c0[2 * k] += f * blo(x0[d][k]); c0[2 * k + 1] += f * bhi(x0[d][k]); c1[2 * k] += f * blo(x1[d][k]); c1[2 * k + 1] += f * bhi(x1[d][k]); }
        ns += f * nk[d]; } }
    { v4u w0, w1;
#pragma unroll
      for (int k = 0; k < 4; ++k) { w0[k] = pk2(c0[2 * k], c0[2 * k + 1]); w1[k] = pk2(c1[2 * k], c1[2 * k + 1]); }
      *(v4u*)(lds + OFF_ST + vst0) = w0; *(v4u*)(lds + OFF_ST + vst1) = w1; if (tid < 64) NS[tid] = ns; }
    __syncthreads();
    const float ft = __builtin_amdgcn_exp2f(Mp - At2); bf16x8 qs[4]; float dn = 0.f;
#pragma unroll
    for (int d0 = 0; d0 < 4; ++d0) { const u32x4 qw = __builtin_bit_cast(u32x4, qr[d0]); u32x4 sw; const f32x4 n0 = *(const f32x4*)(NS + 16 * d0 + 8 * hi), n1 = *(const f32x4*)(NS + 16 * d0 + 8 * hi + 4);
      const float nn[8] = {n0[0], n0[1], n0[2], n0[3], n1[0], n1[1], n1[2], n1[3]};
#pragma unroll
      for (int k = 0; k < 4; ++k) { const float a = blo(qw[k]), c = bhi(qw[k]); dn += a * nn[2 * k] + c * nn[2 * k + 1]; sw[k] = pk2(ft * a, ft * c); }
      qs[d0] = __builtin_bit_cast(bf16x8, sw); }
    den += ft * dn;
    const int vbs = (int)(uintptr_t)(lds + OFF_ST) + att::v_rd_base(lane);
    att::pv_one<0, true>(o[0], vbs, qs[0], qs[1], qs[2], qs[3]); att::pv_one<1, true>(o[1], vbs, qs[0], qs[1], qs[2], qs[3]);
    att::pv_one<2, true>(o[2], vbs, qs[0], qs[1], qs[2], qs[3]); att::pv_one<3, true>(o[3], vbs, qs[0], qs[1], qs[2], qs[3]);
  }
  SWRITE(J0 & 1); __syncthreads();
  for (int j = J0; j < NT; ++j) { const int bb = j & 1;
    if (j + 1 < NT) SLOAD((j + 1) * 64);
    if (j <= jd) {
      f32x16 p0, p1; att::qkt<4>(p0, p1, K_lds + bb * SHM_K, qr, r32, hi);
      const float* ap = AP + bb * 64;
#pragma unroll
      for (int g = 0; g < 4; ++g) { const f32x4 a0 = *(const f32x4*)(ap + 8 * g + 4 * hi), a1 = *(const f32x4*)(ap + 32 + 8 * g + 4 * hi);
#pragma unroll
        for (int e = 0; e < 4; ++e) { p0[4 * g + e] *= __builtin_amdgcn_exp2f(a0[e] - At2); p1[4 * g + e] *= __builtin_amdgcn_exp2f(a1[e] - At2); } }
      if (j == jd) { const int kb = 64 * j + 4 * hi;
#pragma unroll
        for (int r = 0; r < 16; ++r) { const int kv = kb + (r & 3) + 8 * (r >> 2); if (kv > tq) p0[r] = 0.f; if (kv + 32 > tq) p1[r] = 0.f; } }
      float ps = 0.f;
#pragma unroll
      for (int r = 0; r < 16; ++r) ps += p0[r] + p1[r];
      den += ps;
      bf16x8 pa0, pa1, pa2, pa3;
#define PK4(P, BASE, OUT) do { unsigned a0_ = att::cvtpk(P[BASE + 0], P[BASE + 1]), a1_ = att::cvtpk(P[BASE + 2], P[BASE + 3]);   \
    unsigned b0_ = att::cvtpk(P[BASE + 4], P[BASE + 5]), b1_ = att::cvtpk(P[BASE + 6], P[BASE + 7]);                              \
    auto r0 = __builtin_amdgcn_permlane32_swap(a0_, b0_, false, false); auto r1 = __builtin_amdgcn_permlane32_swap(a1_, b1_, false, false); \
    u32x4 w = {r0[0], r1[0], r0[1], r1[1]}; OUT = __builtin_bit_cast(bf16x8, w); } while (0)
      PK4(p0, 0, pa0); PK4(p0, 8, pa1); PK4(p1, 0, pa2); PK4(p1, 8, pa3);
#undef PK4
      const int vb = vb0 + bb * SHM_V;
      att::pv_one<0, true>(o[0], vb, pa0, pa1, pa2, pa3); att::pv_one<1, true>(o[1], vb, pa0, pa1, pa2, pa3);
      att::pv_one<2, true>(o[2], vb, pa0, pa1, pa2, pa3); att::pv_one<3, true>(o[3], vb, pa0, pa1, pa2, pa3);
    }
    if (j + 1 < NT) SWRITE(bb ^ 1);
    __syncthreads();
  }
  { auto rr = __builtin_amdgcn_permlane32_swap(__float_as_uint(den), __float_as_uint(den), false, false); den = __uint_as_float(rr[0]) + __uint_as_float(rr[1]); }
  const float rd = __builtin_amdgcn_rcpf(fmaxf(fabsf(den), __builtin_amdgcn_exp2f(-mt * 1.4426950409f)));
  float ss = 0.f;
#pragma unroll
  for (int d = 0; d < 4; ++d)
#pragma unroll
    for (int r = 0; r < 16; ++r) ss += o[d][r] * o[d][r];
  { auto rr = __builtin_amdgcn_permlane32_swap(__float_as_uint(ss), __float_as_uint(ss), false, false); ss = __uint_as_float(rr[0]) + __uint_as_float(rr[1]); }
  const float rn = rd * __builtin_amdgcn_rsqf(rd * rd * ss * (1.f / 128.f) + RMS_EPS);
  { const float* gm = gmh + h * 128; char* T = lds + wid * 8704;
    bf16* yw = Y + (rowbase + q0 + wid * 32) * ZY_LD + YB + h * 128;
    typedef unsigned u32x4m __attribute__((ext_vector_type(4)));
    u32x4m og[8];
#pragma unroll
    for (int i = 0; i < 8; ++i) { const int c = lane + 64 * i; og[i] = *(const u32x4m*)(yw + (size_t)(c >> 4) * ZY_LD + (c & 15) * 8); }
#pragma unroll
    for (int d = 0; d < 4; ++d)
#pragma unroll
      for (int g = 0; g < 4; ++g) { const int c = 32 * d + 8 * g + 4 * hi; const f32x4 gv = *(const f32x4*)(gm + c); u32x2g w;
        w.x = pk2(o[d][4 * g] * rn * gv[0], o[d][4 * g + 1] * rn * gv[1]); w.y = pk2(o[d][4 * g + 2] * rn * gv[2], o[d][4 * g + 3] * rn * gv[3]);
        *(u32x2g*)(T + r32 * 272 + c * 2) = w; }
    asm volatile("s_waitcnt lgkmcnt(0)" ::: "memory");
#pragma unroll
    for (int i = 0; i < 8; ++i) { const int c = lane + 64 * i; const u32x4m tv = *(const u32x4m*)(T + (c >> 4) * 272 + (c & 15) * 16); u32x4m ov;
#pragma unroll
      for (int k = 0; k < 4; ++k) ov[k] = pk2(blo(tv[k]) * blo(og[i][k]), bhi(tv[k]) * bhi(og[i][k]));
      *(u32x4m*)(yw + (size_t)(c >> 4) * ZY_LD + (c & 15) * 8) = ov; } }
  __syncthreads();
#undef SLOAD
#undef SWRITE
}

__device__ __forceinline__ void mlstm_summary(int u, int h, size_t r0, const bf16* __restrict__ ZT, const float* __restrict__ GIF, float fb, bf16* CK, float* NK, float* ML, char* lds) {
  int tid = threadIdx.x; asm volatile("" : "+v"(tid));
  const int wid = __builtin_amdgcn_readfirstlane(tid >> 6), lane = tid & 63, r32 = lane & 31, hi = lane >> 5;
  char* Kt = lds; char* Vt = lds + 16384; float* WL = (float*)(lds + 32768); float* RED = (float*)(lds + 32768 + 1024); float* NKP = (float*)(lds + 32768 + 2048);
  float lf = 0.f, ai = 0.f; if (tid < 256) { const float f = GIF[(r0 + tid) * 8 + 4 + h] + fb; lf = fminf(f, 0.f) - 0.69314718056f * __builtin_amdgcn_logf(1.f + __builtin_amdgcn_exp2f(-1.4426950409f * fabsf(f))); ai = GIF[(r0 + tid) * 8 + h]; }
  float incl = lf;
#pragma unroll
  for (int o = 1; o < 64; o <<= 1) { const float t = __int_as_float(__builtin_amdgcn_ds_bpermute(((lane - o) & 63) << 2, __float_as_int(incl))); if (lane >= o) incl += t; }
  if (lane == 63) RED[wid] = incl;
  __syncthreads();
  float B = incl;
#pragma unroll
  for (int w = 0; w < 4; ++w) if (w < wid) B += RED[w];
  float a = tid < 256 ? ai - B : -INFINITY, mx = a;
  mx = fmaxf(mx, __int_as_float(__builtin_amdgcn_ds_swizzle(__float_as_int(mx), (1 << 10) | 0x1f))); mx = fmaxf(mx, __int_as_float(__builtin_amdgcn_ds_swizzle(__float_as_int(mx), (2 << 10) | 0x1f)));
  mx = fmaxf(mx, __int_as_float(__builtin_amdgcn_ds_swizzle(__float_as_int(mx), (4 << 10) | 0x1f))); mx = fmaxf(mx, __int_as_float(__builtin_amdgcn_ds_swizzle(__float_as_int(mx), (8 << 10) | 0x1f)));
  mx = fmaxf(mx, __int_as_float(__builtin_amdgcn_ds_swizzle(__float_as_int(mx), (16 << 10) | 0x1f)));
  { auto rr = __builtin_amdgcn_permlane32_swap(__float_as_uint(mx), __float_as_uint(mx), false, false); mx = fmaxf(__uint_as_float(rr[0]), __uint_as_float(rr[1])); }
  if (lane == 0) RED[8 + wid] = mx;
  __syncthreads();
  const float Mloc = fmaxf(fmaxf(RED[8], RED[9]), fmaxf(RED[10], RED[11]));
  if (tid < 256) WL[tid] = __builtin_amdgcn_exp2f((a - Mloc) * 1.4426950409f);
  __syncthreads();
  const int sr = tid >> 4, sc = (tid & 15) * 8, vst0 = att::v_st(sr, sc), vst1 = att::v_st(32 + sr, sc); const bool doK = sc < 64;
  const int ab = wid & 1, db = wid >> 1;
  const int vbk = (int)(uintptr_t)Kt + att::v_rd_base(lane) + ab * 512, vbv = (int)(uintptr_t)Vt + att::v_rd_base(lane) + db * 512;
  f32x16 acc = {}; float nk8[8];
#pragma unroll
  for (int e = 0; e < 8; ++e) nk8[e] = 0.f;
  v4u vs0, vs1, x0 = {0u, 0u, 0u, 0u}, x1 = {0u, 0u, 0u, 0u};
#define MS_LOAD(st_) do { const size_t ra_ = r0 + (st_) * 64 + sr, rb_ = ra_ + 32; vs0 = *(const v4u*)(ZT + ra_ * ZT_LD + ZT_MV + h * 128 + sc); vs1 = *(const v4u*)(ZT + rb_ * ZT_LD + ZT_MV + h * 128 + sc); \
    if (doK) { x0 = *(const v4u*)(ZT + ra_ * ZT_LD + ZT_MK + h * 64 + sc); x1 = *(const v4u*)(ZT + rb_ * ZT_LD + ZT_MK + h * 64 + sc); } } while (0)
  MS_LOAD(0);
  for (int st = 0; st < 4; ++st) { v4u k0 = {0u, 0u, 0u, 0u}, k1 = {0u, 0u, 0u, 0u}; const v4u w0v = vs0, w1v = vs1;
    if (doK) { const float w0 = WL[st * 64 + sr], w1 = WL[st * 64 + 32 + sr];
#pragma unroll
      for (int k = 0; k < 4; ++k) { const float a0 = w0 * blo(x0[k]), b0 = w0 * bhi(x0[k]), a1 = w1 * blo(x1[k]), b1 = w1 * bhi(x1[k]); nk8[2 * k] += a0 + a1; nk8[2 * k + 1] += b0 + b1; k0[k] = pk2(a0, b0); k1[k] = pk2(a1, b1); } }
    if (st > 0) __syncthreads();
    *(v4u*)(Vt + vst0) = w0v; *(v4u*)(Vt + vst1) = w1v; if (doK) { *(v4u*)(Kt + vst0) = k0; *(v4u*)(Kt + vst1) = k1; }
    if (st + 1 < 4) MS_LOAD(st + 1);
    __syncthreads();
    att::pv_kv(acc, vbk, vbv); }
#undef MS_LOAD
  if (doK) { *(f32x4*)(NKP + sr * 64 + sc) = (f32x4){nk8[0], nk8[1], nk8[2], nk8[3]}; *(f32x4*)(NKP + sr * 64 + sc + 4) = (f32x4){nk8[4], nk8[5], nk8[6], nk8[7]}; }
  __syncthreads();
  bf16* ck = CK + (size_t)u * 8192 + (ab * 32) * 128 + db * 32 + r32;
#pragma unroll
  for (int r = 0; r < 16; ++r) ck[att::crow(r, hi) * 128] = (bf16)f2bf(acc[r]);
  if (tid < 64) { float s = 0.f;
#pragma unroll 8
    for (int q = 0; q < 32; ++q) s += NKP[q * 64 + tid];
    NK[u * 64 + tid] = s; }
  if (tid == 0) ML[u] = Mloc;
  __syncthreads();
}
#undef KSWZ
}
namespace sgu {
using att::bf16x8; using att::f32x16;
typedef float f32x2s __attribute__((ext_vector_type(2)));
typedef unsigned u32x2s __attribute__((ext_vector_type(2)));
__device__ __forceinline__ float blo(unsigned w) { return __uint_as_float(w << 16); }
__device__ __forceinline__ float bhi(unsigned w) { return __uint_as_float(w & 0xffff0000u); }
__device__ __forceinline__ void sgu_unit(int bn, int g, const bf16* __restrict__ ZT, const float* __restrict__ PVS, const bf16* __restrict__ WS, const float* __restrict__ gsv, const float* __restrict__ bs, bf16* Y, char* lds) {
  int tid = threadIdx.x; asm volatile("" : "+v"(tid));
  const int wid = __builtin_amdgcn_readfirstlane(tid >> 6), lane = tid & 63, r32 = lane & 31, hi = lane >> 5;
  char* V_lds = lds; f32x2s* st = (f32x2s*)(lds + 32768);
  const size_t base = (size_t)bn * 128;
  const int sr = tid >> 4, sc = (tid & 15) * 8;
  const int tb = wid & 3, ch = wid >> 2, t = 32 * tb + r32;
  v4u xv[4];
#pragma unroll
  for (int q = 0; q < 4; ++q) xv[q] = __builtin_nontemporal_load((const v4u*)(ZT + (base + 32 * q + sr) * ZT_LD + ZT_V + g * 128 + sc));
  f32x2s pp[8];
  if (tid < 128) {
#pragma unroll
    for (int k = 0; k < 8; ++k) pp[k] = *(const f32x2s*)(PVS + ((base + tid) * 8 + k) * 2); }
  bf16* yw = Y + (base + 32 * tb) * ZY_LD + YD + g * 128 + 64 * ch;
  v4u ugv[4];
#pragma unroll
  for (int i = 0; i < 4; ++i) { const int c = lane + 64 * i; ugv[i] = *(const v4u*)(yw + (size_t)(c >> 3) * ZY_LD + (c & 7) * 8); }
  if (tid < 128) { float s1 = 0.f, s2 = 0.f;
#pragma unroll
    for (int k = 0; k < 8; ++k) { s1 += pp[k].x; s2 += pp[k].y; }
    const float mean = s1 * (1.f / 512.f), var = fmaxf(s2 * (1.f / 512.f) - mean * mean, 0.f); f32x2s o; o.x = mean; o.y = __builtin_amdgcn_rsqf(var + RMS_EPS); st[tid] = o; }
  __syncthreads();
#pragma unroll
  for (int q = 0; q < 4; ++q) { const int s = 32 * q + sr; const f32x2s ms = st[s]; const v4u x = xv[q]; v4u w;
#pragma unroll
    for (int k = 0; k < 4; ++k) w[k] = pk2((blo(x[k]) - ms.x) * ms.y, (bhi(x[k]) - ms.x) * ms.y);
    *(v4u*)(V_lds + (q >> 1) * 16384 + att::v_st(32 * (q & 1) + sr, sc)) = w; }
  __syncthreads();
  f32x16 o[2] = {};
  const bf16* wrow = WS + ((size_t)g * 128 + t) * 128 + hi * 8;
  const int vb = (int)(uintptr_t)V_lds + att::v_rd_base(lane);
#pragma unroll
  for (int st_ = 0; st_ < 2; ++st_) { if (st_ == 1 && tb < 2) break;
    const bf16x8 pa0 = *(const bf16x8*)(wrow + 64 * st_), pa1 = *(const bf16x8*)(wrow + 64 * st_ + 16), pa2 = *(const bf16x8*)(wrow + 64 * st_ + 32), pa3 = *(const bf16x8*)(wrow + 64 * st_ + 48);
    if (ch == 0) { att::pv_one<0, true>(o[0], vb + st_ * 16384, pa0, pa1, pa2, pa3); att::pv_one<1, true>(o[1], vb + st_ * 16384, pa0, pa1, pa2, pa3); }
    else         { att::pv_one<2, true>(o[0], vb + st_ * 16384, pa0, pa1, pa2, pa3); att::pv_one<3, true>(o[1], vb + st_ * 16384, pa0, pa1, pa2, pa3); } }
  const float bt = bs[g * 128 + t]; const float* gp = gsv + g * 128 + 64 * ch;
  char* T = lds + 34816 + wid * 4608;
#pragma unroll
  for (int d = 0; d < 2; ++d)
#pragma unroll
    for (int q = 0; q < 4; ++q) { const int c = 32 * d + 8 * q + 4 * hi; const f32x4 gv = *(const f32x4*)(gp + c); u32x2s w;
      w.x = pk2(o[d][4 * q] * gv[0] + bt, o[d][4 * q + 1] * gv[1] + bt); w.y = pk2(o[d][4 * q + 2] * gv[2] + bt, o[d][4 * q + 3] * gv[3] + bt);
      *(u32x2s*)(T + r32 * 144 + c * 2) = w; }
  asm volatile("s_waitcnt lgkmcnt(0)" ::: "memory");
#pragma unroll
  for (int i = 0; i < 4; ++i) { const int c = lane + 64 * i; const v4u tv = *(const v4u*)(T + (c >> 3) * 144 + (c & 7) * 16); v4u ov;
#pragma unroll
    for (int k = 0; k < 4; ++k) ov[k] = pk2(blo(tv[k]) * blo(ugv[i][k]), bhi(tv[k]) * bhi(ugv[i][k]));
    *(v4u*)(yw + (size_t)(c >> 3) * ZY_LD + (c & 7) * 8) = ov; }
  __syncthreads();
}
}

typedef float f32x2g __attribute__((ext_vector_type(2)));
typedef unsigned u32x2g __attribute__((ext_vector_type(2)));
__device__ __forceinline__ float fexp2g(float x) { return __builtin_amdgcn_exp2f(x); }
struct Args { const void* in[23]; float* out; unsigned char* ws; int ph_lo, ph_hi; };
struct Frame {
    LAS unsigned char* lds; volatile LAS unsigned* MISC; gu32* ctl; unsigned char* ws;
    int tid, lane, wave, G, gw, NGW;
};
#define WSP(T, off) ((T*)(F.ws + (off)))

template <int X> __device__ __forceinline__ float swz_xor(float v) { return __int_as_float(__builtin_amdgcn_ds_swizzle(__float_as_int(v), (X << 10) | 0x1f)); }
__device__ __forceinline__ float sum_xor32(float v) { auto r = __builtin_amdgcn_permlane32_swap(__float_as_uint(v), __float_as_uint(v), false, false); return __uint_as_float(r[0]) + __uint_as_float(r[1]); }
__device__ __forceinline__ float wave_sum(float v) { v += swz_xor<1>(v); v += swz_xor<2>(v); v += swz_xor<4>(v); v += swz_xor<8>(v); v += swz_xor<16>(v); return sum_xor32(v); }
__device__ __forceinline__ float lane_up(float v, int lane, int o) { return __int_as_float(__builtin_amdgcn_ds_bpermute(((lane - o) & 63) << 2, __float_as_int(v))); }
__device__ __forceinline__ float bf2f(bf16 h) { return __uint_as_float((unsigned)h << 16); }
__device__ __forceinline__ float blo(unsigned w) { return __uint_as_float(w << 16); }
__device__ __forceinline__ float bhi(unsigned w) { return __uint_as_float(w & 0xffff0000u); }

template <int MAP> __device__ __forceinline__ void cvt_item(const float* W, int K, int Nsrc, const float* kscale, bf16* WT, LAS float* scr, int item, int nblk, int lane, int ldk = 0) {
    if (ldk == 0) ldk = K;
    const int kb = item / nblk, nb = item % nblk, k0 = 64 * kb, n0 = 32 * nb;
    float cs = 1.f; int sc; const int vc = n0 + 4 * (lane & 7);
    if (MAP == 0) sc = vc; else if (MAP == 1) sc = map_in(vc, cs); else if (MAP == 2) { sc = map_q(vc); cs = QSCALE; } else sc = map_kv(vc);
#pragma unroll
    for (int i = 0; i < 8; ++i) { const int kk = 8 * i + (lane >> 3); f32x4 v = {0.f, 0.f, 0.f, 0.f};
        if (sc >= 0) { v = __builtin_nontemporal_load((const GAS f32x4*)(W + (size_t)(k0 + kk) * Nsrc + sc)); float s = cs; if (kscale) s *= kscale[k0 + kk]; v = v * s; }
        LAS float* d = scr + kk * 33 + 4 * (lane & 7); d[0] = v.x; d[1] = v.y; d[2] = v.z; d[3] = v.w; }
    LDS_WAIT(); asm volatile("" ::: "memory");
    const int c = lane & 7;
#pragma unroll
    for (int j = 0; j < 4; ++j) { const int n = (lane >> 3) + 8 * j; const LAS float* s = scr + (8 * c) * 33 + n;
        v4u o; o.x = pk2(s[0 * 33], s[1 * 33]); o.y = pk2(s[2 * 33], s[3 * 33]); o.z = pk2(s[4 * 33], s[5 * 33]); o.w = pk2(s[6 * 33], s[7 * 33]);
        *(GAS v4u*)(WT + (size_t)(n0 + n) * ldk + k0 + 8 * c) = o; }
    LDS_WAIT(); asm volatile("" ::: "memory");
}
__device__ __forceinline__ void p0_weights_part(Frame& F, const Args& A, int l, int part, int w0, int nw) {
    LAS float* scr = (LAS float*)(F.lds + RING_OFF + F.wave * 16384);
    constexpr int I_UQ = 4 * 24, I_UKV = 2 * 32, I_P = 8 * 32, I_O = 16 * 32;
    if (part == 0) {
        for (int it = w0; it < I_UQ + I_UKV; it += nw) { int r = it;
            if (r < I_UQ) { cvt_item<2>(((const float*)A.in[9]) + (size_t)l * 256 * 768, 256, 768, ((const float*)A.in[7]) + l * 256, WSP(bf16, WS_WB + WB_UQ), scr, r, 24, F.lane); continue; } r -= I_UQ;
            cvt_item<3>(((const float*)A.in[10]) + (size_t)l * 128 * 1024, 128, 1024, ((const float*)A.in[8]) + l * 128, WSP(bf16, WS_WB + WB_UKV), scr, r, 32, F.lane); }
        const float* wsrc = ((const float*)A.in[16]) + (size_t)l * 65536; bf16* wd = WSP(bf16, WS_WB + WB_S);
        for (int i = w0 * 64 + F.lane; i < 65536; i += nw * 64) { const int t = (i >> 7) & 127, s = i & 127; wd[i] = (bf16)f2bf(s <= t ? wsrc[i] : 0.f); }
    } else {
        for (int it = w0; it < 4 * I_P + I_O; it += nw) { int r = it;
            if (r < 4 * I_P) { const int i = r / I_P; const float* wp = (const float*)A.in[18 + i]; cvt_item<0>(wp + (size_t)l * 512 * 1024, 512, 1024, nullptr, WSP(bf16, WS_WB + WB_P) + (size_t)(i >> 1) * 1024 * 1024 + (i & 1) * 512, scr, r % I_P, 32, F.lane, 1024); continue; } r -= 4 * I_P;
            cvt_item<0>(((const float*)A.in[22]) + (size_t)l * 1024 * 1024, 1024, 1024, nullptr, WSP(bf16, WS_WOUT), scr, r, 32, F.lane); }
    }
}
__device__ __forceinline__ void p0_weights(Frame& F, const Args& A, int l) {
    p0_weights_part(F, A, l, 0, F.gw, F.NGW);
    if (F.G != 256) p0_weights_part(F, A, l, 1, F.gw, F.NGW);
}
__device__ __forceinline__ void p2_wlate(Frame& F, const Args& A, int l) {
    if (F.G != 256 || blockIdx.x < 128) return;
    p0_weights_part(F, A, l, 1, ((int)blockIdx.x - 128) * NWAVES + F.wave, 128 * NWAVES);
    __syncthreads();
}
__device__ __forceinline__ float max_xor32(float v) { auto r = __builtin_amdgcn_permlane32_swap(__float_as_uint(v), __float_as_uint(v), false, false); return fmaxf(__uint_as_float(r[0]), __uint_as_float(r[1])); }
__device__ __forceinline__ float wave_max(float v) { v = fmaxf(v, swz_xor<1>(v)); v = fmaxf(v, swz_xor<2>(v)); v = fmaxf(v, swz_xor<4>(v)); v = fmaxf(v, swz_xor<8>(v)); v = fmaxf(v, swz_xor<16>(v)); return max_xor32(v); }
__device__ __forceinline__ unsigned pk4_i8(float a, float b, float c, float d) {
    const int ia = (int)__builtin_rintf(a), ib = (int)__builtin_rintf(b), ic = (int)__builtin_rintf(c), id = (int)__builtin_rintf(d);
    return ((unsigned)ia & 0xffu) | (((unsigned)ib & 0xffu) << 8) | (((unsigned)ic & 0xffu) << 16) | ((unsigned)id << 24); }
template <int MAP, int KI, int ROT> __device__ __forceinline__ void quant_cols(Frame& F, const float* W, int Nsrc, int nitems, unsigned char* dst, float* cdq) {
    LAS float* red = (LAS float*)(F.lds + RING_OFF);
    for (int it = blockIdx.x; it < nitems; it += F.G) {
        const int cg = F.tid & 7, n0 = it * 32 + 4 * cg, kg = F.tid >> 3, k0 = kg * 16; float cs = 1.f; const int sc = MAP == 1 ? map_in(n0, cs) : n0;
        const bool q8 = k0 < KI;
        f32x4 v[16]; f32x4 mx = {0.f, 0.f, 0.f, 0.f};
#pragma unroll
        for (int i = 0; i < 16; ++i) { v[i] = sc >= 0 ? __builtin_nontemporal_load((const GAS f32x4*)(W + (size_t)(k0 + i) * Nsrc + sc)) : (f32x4){0.f, 0.f, 0.f, 0.f};
            if (q8) { mx.x = fmaxf(mx.x, fabsf(v[i].x)); mx.y = fmaxf(mx.y, fabsf(v[i].y)); mx.z = fmaxf(mx.z, fabsf(v[i].z)); mx.w = fmaxf(mx.w, fabsf(v[i].w)); } }
#pragma unroll
        for (int c = 0; c < 4; ++c) { float t = mx[c]; t = fmaxf(t, swz_xor<8>(t)); t = fmaxf(t, swz_xor<16>(t)); mx[c] = max_xor32(t); }
        __syncthreads();
        if (F.lane < 8) { LAS float* d = red + F.wave * 32 + 4 * F.lane; d[0] = mx.x; d[1] = mx.y; d[2] = mx.z; d[3] = mx.w; }
        __syncthreads();
        f32x4 cm = {0.f, 0.f, 0.f, 0.f};
#pragma unroll
        for (int w = 0; w < 8; ++w) { const LAS float* s = red + w * 32 + 4 * cg; cm.x = fmaxf(cm.x, s[0]); cm.y = fmaxf(cm.y, s[1]); cm.z = fmaxf(cm.z, s[2]); cm.w = fmaxf(cm.w, s[3]); }
#pragma unroll
        for (int c = 0; c < 4; ++c) { unsigned char* drow = dst + (size_t)(n0 + c) * 2048;
            if (q8) { const float s = cm[c] > 0.f ? 127.f / cm[c] : 0.f; v4u o;
                o.x = pk4_i8(v[0][c] * s, v[1][c] * s, v[2][c] * s, v[3][c] * s); o.y = pk4_i8(v[4][c] * s, v[5][c] * s, v[6][c] * s, v[7][c] * s);
                o.z = pk4_i8(v[8][c] * s, v[9][c] * s, v[10][c] * s, v[11][c] * s); o.w = pk4_i8(v[12][c] * s, v[13][c] * s, v[14][c] * s, v[15][c] * s);
                *(GAS v4u*)(drow + ((k0 + ROT) & 1023)) = o;
                if (kg == 0) cdq[n0 + c] = cs * cm[c] * (1.f / 127.f); }
            else { v4u o0, o1; o0.x = pk2(v[0][c] * cs, v[1][c] * cs); o0.y = pk2(v[2][c] * cs, v[3][c] * cs); o0.z = pk2(v[4][c] * cs, v[5][c] * cs); o0.w = pk2(v[6][c] * cs, v[7][c] * cs);
                o1.x = pk2(v[8][c] * cs, v[9][c] * cs); o1.y = pk2(v[10][c] * cs, v[11][c] * cs); o1.z = pk2(v[12][c] * cs, v[13][c] * cs); o1.w = pk2(v[14][c] * cs, v[15][c] * cs);
                GAS v4u* d2 = (GAS v4u*)(drow + KI + 2 * (k0 - KI)); d2[0] = o0; d2[1] = o1; } }
    }
    __syncthreads();
}
struct QItem { const float* W; int Nsrc, n0, sc, KI, ROT; float cs; unsigned char* dst; float* cdq; };
constexpr int Q_NITEMS = NV_IN / 32 + 4096 / 32;
template <int KI8> __device__ __forceinline__ QItem q_item(Frame& F, const Args& A, int l, int it) {
    QItem q; const int cg = F.tid & 7; q.cs = 1.f;
    if (it < NV_IN / 32) { q.W = ((const float*)A.in[4]) + (size_t)l * 1024 * IN_DIM; q.Nsrc = IN_DIM; q.n0 = it * 32 + 4 * cg; q.sc = map_in(q.n0, q.cs); q.KI = KI8; q.ROT = 0; q.dst = WSP(unsigned char, WS_WB + WB_IN); q.cdq = WSP(float, WS_CDQI); }
    else { q.W = ((const float*)A.in[5]) + (size_t)l * 1024 * 4096; q.Nsrc = 4096; q.n0 = (it - NV_IN / 32) * 32 + 4 * cg; q.sc = q.n0; q.KI = 1024; q.ROT = 1024 - KI8; q.dst = WSP(unsigned char, WS_WB + WB_GATE); q.cdq = WSP(float, WS_CDQ); }
    return q;
}
__device__ __forceinline__ void q_load(Frame& F, const QItem& q, f32x4 (&v)[16]) {
    const int k0 = (F.tid >> 3) * 16;
#pragma unroll
    for (int i = 0; i < 16; ++i) v[i] = q.sc >= 0 ? __builtin_nontemporal_load((const GAS f32x4*)(q.W + (size_t)(k0 + i) * q.Nsrc + q.sc)) : (f32x4){0.f, 0.f, 0.f, 0.f};
}
__device__ __forceinline__ void q_finish(Frame& F, const QItem& q, f32x4 (&v)[16]) {
    LAS float* red = (LAS float*)(F.lds + RING_OFF);
    const int cg = F.tid & 7, kg = F.tid >> 3, k0 = kg * 16; const bool q8 = k0 < q.KI;
    f32x4 mx = {0.f, 0.f, 0.f, 0.f};
    if (q8) {
#pragma unroll
        for (int i = 0; i < 16; ++i) { mx.x = fmaxf(mx.x, fabsf(v[i].x)); mx.y = fmaxf(mx.y, fabsf(v[i].y)); mx.z = fmaxf(mx.z, fabsf(v[i].z)); mx.w = fmaxf(mx.w, fabsf(v[i].w)); } }
#pragma unroll
    for (int c = 0; c < 4; ++c) { float t = mx[c]; t = fmaxf(t, swz_xor<8>(t)); t = fmaxf(t, swz_xor<16>(t)); mx[c] = max_xor32(t); }
    __syncthreads();
    if (F.lane < 8) { LAS float* d = red + F.wave * 32 + 4 * F.lane; d[0] = mx.x; d[1] = mx.y; d[2] = mx.z; d[3] = mx.w; }
    __syncthreads();
    f32x4 cm = {0.f, 0.f, 0.f, 0.f};
#pragma unroll
    for (int w = 0; w < 8; ++w) { const LAS float* s = red + w * 32 + 4 * cg; cm.x = fmaxf(cm.x, s[0]); cm.y = fmaxf(cm.y, s[1]); cm.z = fmaxf(cm.z, s[2]); cm.w = fmaxf(cm.w, s[3]); }
#pragma unroll
    for (int c = 0; c < 4; ++c) { unsigned char* drow = q.dst + (size_t)(q.n0 + c) * 2048; const float cs = q.cs;
        if (q8) { const float s = cm[c] > 0.f ? 127.f / cm[c] : 0.f; v4u o;
            o.x = pk4_i8(v[0][c] * s, v[1][c] * s, v[2][c] * s, v[3][c] * s); o.y = pk4_i8(v[4][c] * s, v[5][c] * s, v[6][c] * s, v[7][c] * s);
            o.z = pk4_i8(v[8][c] * s, v[9][c] * s, v[10][c] * s, v[11][c] * s); o.w = pk4_i8(v[12][c] * s, v[13][c] * s, v[14][c] * s, v[15][c] * s);
            *(GAS v4u*)(drow + ((k0 + q.ROT) & 1023)) = o;
            if (kg == 0) q.cdq[q.n0 + c] = cs * cm[c] * (1.f / 127.f); }
        else { v4u o0, o1; o0.x = pk2(v[0][c] * cs, v[1][c] * cs); o0.y = pk2(v[2][c] * cs, v[3][c] * cs); o0.z = pk2(v[4][c] * cs, v[5][c] * cs); o0.w = pk2(v[6][c] * cs, v[7][c] * cs);
            o1.x = pk2(v[8][c] * cs, v[9][c] * cs); o1.y = pk2(v[10][c] * cs, v[11][c] * cs); o1.z = pk2(v[12][c] * cs, v[13][c] * cs); o1.w = pk2(v[14][c] * cs, v[15][c] * cs);
            GAS v4u* d2 = (GAS v4u*)(drow + q.KI + 2 * (k0 - q.KI)); d2[0] = o0; d2[1] = o1; } }
}
template <int KI8> __device__ __forceinline__ void p0_rows(Frame& F, const Args& A, int stage) {
    const float* xsrc = stage == 2 ? A.out : ((const float*)A.in[0]);
    f32x4 gpo[4], gpr[4];
#pragma unroll
    for (int j = 0; j < 4; ++j) { gpo[j] = stage >= 1 ? *((const GAS f32x4*)(((const float*)A.in[3]) + (stage - 1) * D) + F.lane + 64 * j) : (f32x4){0.f, 0.f, 0.f, 0.f};
        gpr[j] = stage < 2 ? *((const GAS f32x4*)(((const float*)A.in[2]) + stage * D) + F.lane + 64 * j) : (f32x4){0.f, 0.f, 0.f, 0.f}; }
    f32x4 v[4], vn[4]; u32x2g mo[4], mon[4]; float po = 0.f, pon = 0.f;
#define ROW_LOAD(V, MO, PO, m_) do { if (stage == 2) { _Pragma("unroll") for (int j = 0; j < 4; ++j) { const u32x2g xb_ = __builtin_nontemporal_load((const GAS u32x2g*)((const char*)A.out + (size_t)(m_) * 4096) + F.lane + 64 * j); V[j].x = __uint_as_float(xb_.x); V[j].y = __uint_as_float(xb_.y); } } \
        else { _Pragma("unroll") for (int j = 0; j < 4; ++j) V[j] = __builtin_nontemporal_load((const GAS f32x4*)(xsrc + (size_t)(m_) * D) + F.lane + 64 * j); } \
        if (stage >= 1) { _Pragma("unroll") for (int j = 0; j < 4; ++j) MO[j] = __builtin_nontemporal_load((const GAS u32x2g*)(WSP(bf16, WS_MO) + (size_t)(m_) * D) + F.lane + 64 * j); PO = F.lane < 16 ? WSP(float, WS_PO)[(size_t)(m_) * 16 + F.lane] : 0.f; } } while (0)
    int m = F.gw; if (m < M) ROW_LOAD(v, mo, po, m);
    for (; m < M; m += F.NGW) {
        const int mn = m + F.NGW; if (mn < M) ROW_LOAD(vn, mon, pon, mn);
        if (stage == 2) {
#pragma unroll
            for (int j = 0; j < 4; ++j) { const unsigned w0 = __float_as_uint(v[j].x), w1 = __float_as_uint(v[j].y); v[j].x = blo(w0); v[j].y = bhi(w0); v[j].z = blo(w1); v[j].w = bhi(w1); } }
        if (stage >= 1) {
            const float rs = __builtin_amdgcn_rsqf(wave_sum(po) * (1.f / 1024.f) + RMS_EPS);
#pragma unroll
            for (int j = 0; j < 4; ++j) { v[j].x += blo(mo[j].x) * rs * gpo[j].x; v[j].y += bhi(mo[j].x) * rs * gpo[j].y; v[j].z += blo(mo[j].y) * rs * gpo[j].z; v[j].w += bhi(mo[j].y) * rs * gpo[j].w;
                if (stage == 1) { u32x2g o; o.x = pk2(v[j].x, v[j].y); o.y = pk2(v[j].z, v[j].w); __builtin_nontemporal_store(o, (GAS u32x2g*)((char*)A.out + (size_t)m * 4096) + F.lane + 64 * j); }
                else __builtin_nontemporal_store(v[j], (GAS f32x4*)(A.out + (size_t)m * D) + F.lane + 64 * j); }
        }
        if (stage < 2) {
            float s2 = 0.f;
#pragma unroll
            for (int j = 0; j < 4; ++j) s2 += (v[j].x * v[j].x + v[j].y * v[j].y) + (v[j].z * v[j].z + v[j].w * v[j].w);
            const float rs = __builtin_amdgcn_rsqf(wave_sum(s2) * (1.f / D) + RMS_EPS);
#pragma unroll
            for (int j = 0; j < 4; ++j) { v[j].x *= rs * gpr[j].x; v[j].y *= rs * gpr[j].y; v[j].z *= rs * gpr[j].z; v[j].w *= rs * gpr[j].w; }
            float mx = 0.f;
#pragma unroll
            for (int j = 0; j < 4; ++j) mx = fmaxf(fmaxf(mx, fmaxf(fabsf(v[j].x), fabsf(v[j].y))), fmaxf(fabsf(v[j].z), fabsf(v[j].w)));
            mx = wave_max(mx); const float qs = mx > 0.f ? 127.f / mx : 0.f;
#pragma unroll
            for (int j = 0; j < 4; ++j) { unsigned char* hrow = WSP(unsigned char, WS_H) + (size_t)m * (H_LD * 2); const int k = 256 * j + 4 * F.lane;
                *(GAS unsigned*)(hrow + ((k + 1024 - KI8) & 1023)) = pk4_i8(v[j].x * qs, v[j].y * qs, v[j].z * qs, v[j].w * qs);
                if (256 * j >= KI8) { u32x2g o; o.x = pk2(v[j].x, v[j].y); o.y = pk2(v[j].z, v[j].w); *(GAS u32x2g*)(hrow + 1024 + 2 * (k - KI8)) = o; } }
            if (F.lane == 0) WSP(float, WS_RDQ)[m] = mx * (1.f / 127.f);
        }
#pragma unroll
        for (int j = 0; j < 4; ++j) { v[j] = vn[j]; mo[j] = mon[j]; } po = pon;
    }
#undef ROW_LOAD
}
template <int KI8> __device__ __forceinline__ void p0_all(Frame& F, const Args& A, int l) {
    const int nit = F.G == 256 ? NV_IN / 32 : Q_NITEMS;
    const int it0 = blockIdx.x; f32x4 qv[16]; QItem q0 = q_item<KI8>(F, A, l, it0 < nit ? it0 : 0);
    if (it0 < nit) q_load(F, q0, qv);
    p0_rows<KI8>(F, A, l);
    p0_weights(F, A, l);
    if (it0 < nit) q_finish(F, q0, qv);
    for (int it = it0 + F.G; it < nit; it += F.G) { QItem q = q_item<KI8>(F, A, l, it); q_load(F, q, qv); q_finish(F, q, qv); }
    __syncthreads();
}
template <int KI8> __device__ __forceinline__ void p2_gateq(Frame& F, const Args& A, int l) {
    if (F.G != 256 || blockIdx.x < 128) return;
    f32x4 qv[16]; QItem q = q_item<KI8>(F, A, l, NV_IN / 32 + ((int)blockIdx.x - 128)); q_load(F, q, qv); q_finish(F, q, qv);
    __syncthreads();
}
__device__ __forceinline__ void p0_rope(Frame& F, const Args& A) {
    const int gt = F.gw * 64 + F.lane, NT = F.NGW * 64;
    for (int i = gt; i < M * 16; i += NT) { const int row = i >> 4, j = i & 15;
        const float inv = exp2f(-(float)j * 0.83048202372184058f);     const float ang = (float)((const int*)A.in[1])[row] * inv; const double rv = (double)ang * 0.15915494309189535; const float fr = (float)(rv - rint(rv)); const float s = __builtin_amdgcn_sinf(fr), c = __builtin_amdgcn_cosf(fr);
        f32x2g o; o.x = c; o.y = s; *(GAS f32x2g*)(WSP(float, WS_ROPE) + (size_t)i * 2) = o; }
}
__device__ __forceinline__ void p2_conv(Frame& F, const Args& A, int l) {
    const float* wc = ((const float*)A.in[13]) + l * 3 * 512; const float* bc = ((const float*)A.in[14]) + l * 512; const int c0 = F.lane * 8;
    float w0[8], w1[8], w2[8], bb[8];
    { const f32x4 a0 = *(const GAS f32x4*)(wc + c0), a1 = *(const GAS f32x4*)(wc + c0 + 4), b0 = *(const GAS f32x4*)(wc + 512 + c0), b1 = *(const GAS f32x4*)(wc + 512 + c0 + 4),
                  d0 = *(const GAS f32x4*)(wc + 1024 + c0), d1 = *(const GAS f32x4*)(wc + 1024 + c0 + 4), e0 = *(const GAS f32x4*)(bc + c0), e1 = *(const GAS f32x4*)(bc + c0 + 4);
#pragma unroll
      for (int q = 0; q < 4; ++q) { w0[q] = a0[q]; w0[4 + q] = a1[q]; w1[q] = b0[q]; w1[4 + q] = b1[q]; w2[q] = d0[q]; w2[4 + q] = d1[q]; bb[q] = e0[q]; bb[4 + q] = e1[q]; } }
    for (int r0 = F.gw * 16; r0 < M; r0 += F.NGW * 16) {
        const int t0 = r0 & (SEQ - 1);
        const bf16* up = WSP(bf16, WS_ZT) + (size_t)r0 * ZT_LD + ZT_U + c0; bf16* gp = WSP(bf16, WS_ZY) + (size_t)r0 * ZY_LD + YC + c0;
        v4u um2 = {0u, 0u, 0u, 0u}, um1 = {0u, 0u, 0u, 0u};
        if (t0 > 0) { um2 = *(const GAS v4u*)(up - 2 * ZT_LD); um1 = *(const GAS v4u*)(up - ZT_LD); }
#pragma unroll
        for (int hb = 0; hb < 2; ++hb) { v4u uu[8], gg[8];
#pragma unroll
            for (int i = 0; i < 8; ++i) { uu[i] = __builtin_nontemporal_load((const GAS v4u*)(up + (size_t)(8 * hb + i) * ZT_LD)); gg[i] = __builtin_nontemporal_load((const GAS v4u*)(gp + (size_t)(8 * hb + i) * ZY_LD)); }
#pragma unroll
            for (int i = 0; i < 8; ++i) { v4u o;
#pragma unroll
                for (int q = 0; q < 4; ++q) {
                    const float ylo = w0[2 * q] * blo(um2[q]) + w1[2 * q] * blo(um1[q]) + w2[2 * q] * blo(uu[i][q]) + bb[2 * q];
                    const float yhi = w0[2 * q + 1] * bhi(um2[q]) + w1[2 * q + 1] * bhi(um1[q]) + w2[2 * q + 1] * bhi(uu[i][q]) + bb[2 * q + 1];
                    o[q] = pk2(blo(gg[i][q]) * ylo, bhi(gg[i][q]) * yhi); }
                *(GAS v4u*)(gp + (size_t)(8 * hb + i) * ZY_LD) = o; um2 = um1; um1 = uu[i]; } }
    }
}
__device__ __forceinline__ float logsig(float x) { return fminf(x, 0.f) - 0.69314718056f * __builtin_amdgcn_logf(1.f + __builtin_amdgcn_exp2f(-1.4426950409f * fabsf(x))); }
__device__ __forceinline__ void p2_mscan(Frame& F, const Args& A, int l) {
    if (blockIdx.x >= 32) return;
    const int b = blockIdx.x >> 2, h = blockIdx.x & 3, lane = F.lane, wave = F.wave; const float fb = ((const float*)A.in[11])[l * 4 + h];
    const size_t r0 = (size_t)b * SEQ + F.tid * 8; const float* G = WSP(float, WS_GIF); LAS float* X = (LAS float*)(F.lds + RING_OFF);
    float lf[8], ai[8];
#pragma unroll
    for (int i = 0; i < 8; ++i) { lf[i] = G[(r0 + i) * 8 + 4 + h]; ai[i] = G[(r0 + i) * 8 + h]; }
    float ls = 0.f;
#pragma unroll
    for (int i = 0; i < 8; ++i) { lf[i] = logsig(lf[i] + fb); ls += lf[i]; }
    float incl = ls;
#pragma unroll
    for (int o = 1; o < 64; o <<= 1) { const float t = lane_up(incl, lane, o); if (lane >= o) incl += t; }
    if (lane == 63) X[wave] = incl;
    __syncthreads();
    float B = incl - ls;
#pragma unroll
    for (int w = 0; w < 8; ++w) if (w < wave) B += X[w];
    float lm = -INFINITY;
#pragma unroll
    for (int i = 0; i < 8; ++i) { B += lf[i]; ai[i] -= B; lf[i] = B; lm = fmaxf(lm, ai[i]); }
    float im = lm;
#pragma unroll
    for (int o = 1; o < 64; o <<= 1) { const float t = lane_up(im, lane, o); if (lane >= o) im = fmaxf(im, t); }
    if (lane == 63) X[8 + wave] = im;
    __syncthreads();
    float run = lane_up(im, lane, 1); if (lane == 0) run = -INFINITY; run = fmaxf(run, 0.f);
#pragma unroll
    for (int w = 0; w < 8; ++w) if (w < wave) run = fmaxf(run, X[8 + w]);
    float* O = WSP(float, WS_MLS);
#pragma unroll
    for (int i = 0; i < 8; ++i) { run = fmaxf(run, ai[i]); f32x4 o; o.x = ai[i]; o.y = run; o.z = lf[i] + run; o.w = 0.f; *(GAS f32x4*)(O + ((r0 + i) * 4 + h) * 4) = o; }
    __syncthreads();
}
#if MK_NAIVE_SGU
__device__ __forceinline__ void p2_sgu_naive(Frame& F, const Args& A, int l) {
    LAS f32x2g* st = (LAS f32x2g*)(F.lds + RING_OFF);
    const int c = F.tid & 127, tq = F.tid >> 7;
    for (int u = blockIdx.x; u < 1024; u += F.G) { const int g = u & 3, bn = u >> 2; const size_t base = (size_t)bn * 128;
        if (F.tid < 128) { float s1 = 0.f, s2 = 0.f;
            for (int k = 0; k < 8; ++k) { const f32x2g p = *(const GAS f32x2g*)(WSP(float, WS_PVS) + ((base + F.tid) * 8 + k) * 2); s1 += p.x; s2 += p.y; }
            const float mean = s1 * (1.f / 512.f), var = fmaxf(s2 * (1.f / 512.f) - mean * mean, 0.f); f32x2g o; o.x = mean; o.y = 1.0f / sqrtf(var + RMS_EPS); st[F.tid] = o; }
        __syncthreads();
        const float* W = ((const float*)A.in[16]) + ((size_t)l * 4 + g) * 128 * 128;
        float acc[32];
#pragma unroll
        for (int i = 0; i < 32; ++i) acc[i] = 0.f;
        for (int s = 0; s < 128; ++s) { const f32x2g ms = st[s]; const float vn = (bf2f(WSP(bf16, WS_ZT)[(base + s) * ZT_LD + ZT_V + g * 128 + c]) - ms.x) * ms.y;
#pragma unroll
            for (int i = 0; i < 32; ++i) { const int tt = tq + 4 * i; if (tt >= s) acc[i] += W[tt * 128 + s] * vn; } }
        const float gs = ((const float*)A.in[15])[l * 512 + g * 128 + c];
#pragma unroll
        for (int i = 0; i < 32; ++i) { const int tt = tq + 4 * i; GAS bf16* p = (GAS bf16*)(WSP(bf16, WS_ZY) + (base + tt) * ZY_LD + YD + g * 128 + c);
            const float mixed = acc[i] * gs + ((const float*)A.in[17])[(l * 4 + g) * 128 + tt]; *p = (bf16)f2bf(bf2f(*p) * mixed); }
        __syncthreads();
    }
}
#endif
#if !MK_NAIVE_SGU
__device__ __forceinline__ void p2_sgu(Frame& F, const Args& A, int l) {
    for (int u = blockIdx.x; u < 1024; u += F.G)
        sgu::sgu_unit(u >> 2, u & 3, WSP(bf16, WS_ZT), WSP(float, WS_PVS), WSP(bf16, WS_WB + WB_S), ((const float*)A.in[15]) + l * 512, ((const float*)A.in[17]) + l * 512, WSP(bf16, WS_ZY), (char*)F.lds + RING_OFF);
}
#endif
#if MK_NAIVE_ATTN
__device__ __forceinline__ void p3_attn_naive(Frame& F, const Args& A, bf16* Yunused) {
    const int lane = F.lane;
    for (int pass = 0; pass < 2; ++pass) { const int u = pass == 0 ? F.gw : 4095 - F.gw; if (F.gw >= 2048) break;
        const int c = u & 63, h = (u >> 6) & 7, b = u >> 9; const size_t row = (size_t)b * SEQ + c * 64 + lane;
        v4u q[12];
#pragma unroll
        for (int i = 0; i < 12; ++i) q[i] = *(const GAS v4u*)(WSP(bf16, WS_Q) + row * 768 + h * 96 + 8 * i);
        float o[64];
#pragma unroll
        for (int i = 0; i < 64; ++i) o[i] = 0.f;
        float mx = -1e30f, lsum = 0.f; const int nk = 64 * (c + 1);
        for (int k0 = 0; k0 < nk; ++k0) { const size_t kr = (size_t)b * SEQ + k0; float a = 0.f;
#pragma unroll
            for (int i = 0; i < 8; ++i) { const v4u w = *(const GAS v4u*)(WSP(bf16, WS_KN) + kr * 512 + h * 64 + 8 * i);
#pragma unroll
                for (int k = 0; k < 4; ++k) a += blo(q[i][k]) * blo(w[k]) + bhi(q[i][k]) * bhi(w[k]); }
#pragma unroll
            for (int i = 0; i < 4; ++i) { const v4u w = *(const GAS v4u*)(WSP(bf16, WS_KR) + kr * 32 + 8 * i);
#pragma unroll
                for (int k = 0; k < 4; ++k) a += blo(q[8 + i][k]) * blo(w[k]) + bhi(q[8 + i][k]) * bhi(w[k]); }
            if (__any(a > mx)) { const float mn = fmaxf(a, mx), al = fexp2g(mx - mn); mx = mn; lsum *= al;
#pragma unroll
                for (int i = 0; i < 64; ++i) o[i] *= al; }
            const float p = fexp2g(a - mx); lsum += p;
#pragma unroll
            for (int i = 0; i < 8; ++i) { const v4u w = *(const GAS v4u*)(WSP(bf16, WS_V) + kr * 512 + h * 64 + 8 * i);
#pragma unroll
                for (int k = 0; k < 4; ++k) { o[8 * i + 2 * k] += p * blo(w[k]); o[8 * i + 2 * k + 1] += p * bhi(w[k]); } }
        }
        const float rl = 1.0f / lsum; GAS v4u* yp = (GAS v4u*)(WSP(bf16, WS_ZY) + row * ZY_LD + YA + h * 64);
#pragma unroll
        for (int i = 0; i < 8; ++i) { const v4u g = yp[i]; v4u w;
#pragma unroll
            for (int k = 0; k < 4; ++k) w[k] = pk2(o[8 * i + 2 * k] * rl * blo(g[k]), o[8 * i + 2 * k + 1] * rl * bhi(g[k]));
            yp[i] = w; }
    }
}
#endif
#if !MK_NAIVE_ATTN
#if MK_ATTN_V2 == 2
#define ATTN_UNIT attn_unit3
#elif MK_ATTN_V2
#define ATTN_UNIT attn_unit2
#else
#define ATTN_UNIT attn_unit
#endif
__device__ __forceinline__ void p3_attn(Frame& F, const Args& A, bf16* Y) {
    const int bx = blockIdx.x, vcu = (F.G % 8 == 0) ? (bx % 8) * (F.G / 8) + bx / 8 : bx;
    for (int u = vcu; u < 1024; u += F.G) { const int v = u & 255, i = u >> 8, bh = v >> 2, s = v & 3, qb = i == 0 ? s : i == 1 ? 7 - s : i == 2 ? 8 + s : 15 - s;
        att::ATTN_UNIT(bh >> 3, bh & 7, qb, WSP(bf16, WS_Q), WSP(bf16, WS_KN), WSP(bf16, WS_KR), WSP(bf16, WS_V), Y, (char*)F.lds + RING_OFF); }
}
#endif
#if MK_NAIVE_MLSTM
__device__ __forceinline__ void p3_mlstm_naive(Frame& F, const Args& A, int l, bf16* Yunused) {
    const int lane = F.lane, hf = lane >> 5;
    for (int pass = 0; pass < 2; ++pass) { const int u = pass == 0 ? F.gw : 4095 - F.gw; if (F.gw >= 2048) break;
        const int w = u & 127, h = (u >> 7) & 3, b = u >> 9; const int t = w * 32 + (lane & 31); const size_t row = (size_t)b * SEQ + t;
        v4u q[8];
#pragma unroll
        for (int i = 0; i < 8; ++i) q[i] = *(const GAS v4u*)(WSP(bf16, WS_ZT) + row * ZT_LD + ZT_MQ + h * 64 + 8 * i);
        float acc[64];
#pragma unroll
        for (int i = 0; i < 64; ++i) acc[i] = 0.f;
        const f32x4 me = *(const GAS f32x4*)(WSP(float, WS_MLS) + (row * 4 + h) * 4); const float At = me.y, mt = me.z; float den = 0.f;
        const int nk = 32 * (w + 1);
        for (int s = 0; s < nk; ++s) { const size_t sr = (size_t)b * SEQ + s; float dot = 0.f;
#pragma unroll
            for (int i = 0; i < 8; ++i) { const v4u x = *(const GAS v4u*)(WSP(bf16, WS_ZT) + sr * ZT_LD + ZT_MK + h * 64 + 8 * i);
#pragma unroll
                for (int k = 0; k < 4; ++k) dot += blo(q[i][k]) * blo(x[k]) + bhi(q[i][k]) * bhi(x[k]); }
            const float ap = WSP(float, WS_MLS)[(sr * 4 + h) * 4]; const float p = s <= t ? dot * fexp2g((ap - At) * 1.4426950409f) : 0.f; den += p;
#pragma unroll
            for (int i = 0; i < 8; ++i) { const v4u x = *(const GAS v4u*)(WSP(bf16, WS_ZT) + sr * ZT_LD + ZT_MV + h * 128 + hf * 64 + 8 * i);
#pragma unroll
                for (int k = 0; k < 4; ++k) { acc[8 * i + 2 * k] += p * blo(x[k]); acc[8 * i + 2 * k + 1] += p * bhi(x[k]); } } }
        const float rd = 1.0f / fmaxf(fabsf(den), fexp2g(-mt * 1.4426950409f)); float ss = 0.f;
#pragma unroll
        for (int i = 0; i < 64; ++i) ss += acc[i] * acc[i];
        ss = sum_xor32(ss);
        const float rn = rd * __builtin_amdgcn_rsqf(rd * rd * ss * (1.f / 128.f) + RMS_EPS);
        const float* gm = ((const float*)A.in[12]) + l * 512 + h * 128 + hf * 64;
        GAS v4u* yp = (GAS v4u*)(WSP(bf16, WS_ZY) + row * ZY_LD + YB + h * 128 + hf * 64);
#pragma unroll
        for (int i = 0; i < 8; ++i) { const v4u g = yp[i]; v4u o;
#pragma unroll
            for (int k = 0; k < 4; ++k) o[k] = pk2(acc[8 * i + 2 * k] * rn * gm[8 * i + 2 * k] * blo(g[k]), acc[8 * i + 2 * k + 1] * rn * gm[8 * i + 2 * k + 1] * bhi(g[k]));
            yp[i] = o; }
    }
}
#endif
#if !MK_NAIVE_MLSTM
__device__ __forceinline__ void p3_mlstm(Frame& F, const Args& A, int l, bf16* Y) {
    const int bx = blockIdx.x, vcu = (F.G % 8 == 0) ? (bx % 8) * (F.G / 8) + bx / 8 : bx;
    for (int u = vcu; u < 512; u += F.G) { const int bh = u >> 4, qb = (u < 256) ? (u & 15) : 15 - (u & 15);
        mls::mlstm_unit(bh >> 2, bh & 3, qb, WSP(bf16, WS_ZT), WSP(float, WS_MLS), ((const float*)A.in[12]) + l * 512, WSP(bf16, WS_MSUM), WSP(float, WS_MSUM + 8 * MiB), WSP(float, WS_MSUM + 8 * MiB + 256 * 1024), Y, (char*)F.lds + RING_OFF); }
}
__device__ __forceinline__ void p2_msum(Frame& F, const Args& A, int l) {
    for (int u = blockIdx.x; u < 512; u += F.G) { const int bh = u >> 4, J = u & 15, h = bh & 3;
        mls::mlstm_summary(u, h, (size_t)(bh >> 2) * SEQ + J * 256, WSP(bf16, WS_ZT), WSP(float, WS_GIF), ((const float*)A.in[11])[l * 4 + h], WSP(bf16, WS_MSUM), WSP(float, WS_MSUM + 8 * MiB), WSP(float, WS_MSUM + 8 * MiB + 256 * 1024), (char*)F.lds + RING_OFF); }
}
#endif

#if MK_NAIVE_MLSTM
#define P2_MSUM(F, a, l) do {} while (0)
#else
#define P2_MSUM p2_msum
#endif
#if MK_NAIVE_SGU
#define P2_SGU p2_sgu_naive
#else
#define P2_SGU p2_sgu
#endif
#if MK_NAIVE_MLSTM
#define P3_MLSTM p3_mlstm_naive
#else
#define P3_MLSTM p3_mlstm
#endif
#if MK_NAIVE_ATTN
#define P3_ATTN p3_attn_naive
#else
#define P3_ATTN p3_attn
#endif
__global__ void __launch_bounds__(NTHREADS, 2) mk_fwd(Args args) {
    extern __shared__ __attribute__((aligned(16))) unsigned char lds[];
    Frame F;
    F.lds = (LAS unsigned char*)lds; F.MISC = (volatile LAS unsigned*)(F.lds + MISC_OFF);
    F.tid = threadIdx.x; F.lane = F.tid & 63; F.wave = __builtin_amdgcn_readfirstlane(F.tid >> 6); F.G = gridDim.x; F.gw = blockIdx.x * NWAVES + F.wave; F.NGW = F.G * NWAVES;
    F.ws = args.ws; F.ctl = (gu32*)(F.ws + WS_CTL);
    const Args& A = args;
    for (int u = F.tid; u < (LDS_BYTES - LDSCTL_OFF) / 4; u += NTHREADS) ((LAS unsigned*)(F.lds + LDSCTL_OFF))[u] = 0u;
    __syncthreads();
    const int lo = args.ph_lo, hi = args.ph_hi;
    XcdBarrier bar; bar.bar = (unsigned*)(F.ctl + CW_BAR); bar.x = 0; bar.st = nullptr;
    if (hi - lo > 1) bar = xcd_barrier_post((unsigned*)(F.ctl + CW_BAR), F.MISC + 8);
#define IN(k) (lo <= (k) && (k) < hi)
#define PROBE(b) ((MK_PROBE >> (b)) & 1)
#define NREP(b) (1 + PROBE(b))
#define FRESH() do { int z_ = 0; asm volatile("" : "+v"(z_)); F.ws = args.ws + __builtin_amdgcn_readfirstlane(z_); int t_ = threadIdx.x; asm volatile("" : "+v"(t_)); F.tid = t_; F.lane = t_ & 63; \
        F.wave = __builtin_amdgcn_readfirstlane(t_ >> 6); F.gw = blockIdx.x * NWAVES + F.wave; } while (0)
#define SEAM(k) do { if (IN(k) && IN((k) + 1)) xcd_barrier(bar); } while (0)
    typedef pg8::StaticOrder SO;
#define LAYER(l) do { \
        const int pb = 6 * l; \
        if (IN(pb + 0)) for (int rep_ = 0; rep_ < NREP(3); ++rep_) { FRESH(); if (l == 0) p0_rope(F, args); FRESH(); p0_all<ki8_of(l)>(F, args, l); } \
        SEAM(pb + 0); \
        if (IN(pb + 1)) for (int rep_ = 0; rep_ < NREP(0); ++rep_) { FRESH(); \
            pg8::Gemm g{WSP(bf16, WS_H), WSP(bf16, WS_WB + WB_IN), M, NV_IN, 1024, H_LD}; SO S; S.init(M, NV_IN, F.G, (int)blockIdx.x, 64 * (ki8_of(l) / 128 + (1024 - ki8_of(l)) / 64)  , 1024u - ki8_of(l)); \
            pg8::EpiIn<ki8_of(l)> E{WSP(bf16, WS_ZT), WSP(bf16, WS_ZY), WSP(bf16, WS_KR), WSP(float, WS_PQ), WSP(float, WS_PKV), WSP(float, WS_PVS), WSP(float, WS_GIF), WSP(float, WS_ROPE), WSP(float, WS_RDQ), WSP(float, WS_CDQI)}; \
            pg8::gemm_phase<pg8::EpiIn<ki8_of(l)>, SO, true, true>(F.lds + RING_OFF, g, S, E); \
        } \
        SEAM(pb + 1); \
        if (IN(pb + 2)) { for (int rep_ = 0; rep_ < NREP(6); ++rep_) { FRESH(); \
            { pg8::Gemm g{WSP(bf16, WS_ZT) + ZT_CQ, WSP(bf16, WS_WB + WB_UQ), M, 768, 256, ZT_LD}; SO S; S.init(M, 768, F.G, (int)blockIdx.x, 256); pg8::EpiUpQ E{WSP(bf16, WS_Q), WSP(float, WS_PQ), WSP(float, WS_ROPE)}; \
              pg8::gemm_phase<pg8::EpiUpQ, SO, true, true>(F.lds + RING_OFF, g, S, E); } \
            FRESH(); if (rep_ == 0) { p2_gateq<ki8_of(l)>(F, args, l); FRESH(); p2_wlate(F, args, l); FRESH(); } \
            { pg8::Gemm g{WSP(bf16, WS_ZT) + ZT_CKV, WSP(bf16, WS_WB + WB_UKV), M, 1024, 128, ZT_LD}; SO S; S.init(M, 1024, F.G, (int)blockIdx.x, 128); pg8::EpiUpKV E{WSP(bf16, WS_KN), WSP(bf16, WS_V), WSP(float, WS_PKV)}; \
              pg8::gemm_phase<pg8::EpiUpKV, SO, true, true>(F.lds + RING_OFF, g, S, E); } \
            __syncthreads(); } \
            for (int rep_ = 0; rep_ < NREP(7); ++rep_) { FRESH(); \
            p2_mscan(F, args, l); FRESH(); \
            P2_MSUM(F, args, l); } \
            FRESH(); \
            p2_conv(F, args, l); FRESH(); \
            P2_SGU(F, args, l); \
        } \
        SEAM(pb + 2); \
        if (IN(pb + 3)) { FRESH(); P3_ATTN(F, args, WSP(bf16, WS_ZY)); if (PROBE(4) && l == 0) { FRESH(); P3_ATTN(F, args, (bf16*)args.out); } FRESH(); P3_MLSTM(F, args, l, WSP(bf16, WS_ZY)); if (PROBE(5) && l == 0) { FRESH(); P3_MLSTM(F, args, l, (bf16*)args.out); } } \
        SEAM(pb + 3); \
        if (IN(pb + 4)) for (int rep_ = 0; rep_ < NREP(1); ++rep_) { FRESH(); \
            pg8::Gemm g{WSP(bf16, WS_H), WSP(bf16, WS_WB + WB_GATE), M, 1024, 1024, H_LD}; pg8::P4Order S; S.init(M, F.G, (int)blockIdx.x, (unsigned)(WB_P - WB_GATE)); \
            pg8::EpiP4 E{WSP(unsigned char, WS_S), WSP(bf16, WS_MG), ((const float*)A.in[6]) + l * 4096, WSP(float, WS_RDQ), WSP(float, WS_CDQ)}; \
            pg8::gemm_phase<pg8::EpiP4, pg8::P4Order, true, true>(F.lds + RING_OFF, g, S, E); \
        } \
        SEAM(pb + 4); \
        if (IN(pb + 5)) for (int rep_ = 0; rep_ < NREP(2); ++rep_) { FRESH(); \
            pg8::Gemm g{WSP(bf16, WS_MG), WSP(bf16, WS_WOUT), M, 1024, 1024, 1024}; SO S; S.init(M, 1024, F.G, (int)blockIdx.x, 1024); pg8::EpiOut E{WSP(bf16, WS_MO), WSP(float, WS_PO)}; \
            pg8::gemm_phase<pg8::EpiOut, SO, true, true>(F.lds + RING_OFF, g, S, E); \
        } \
        SEAM(pb + 5); \
    } while (0)
    LAYER(0);
    LAYER(1);
#undef LAYER
    if (IN(12)) { FRESH(); p0_rows<512>(F, args, 2); }
#undef IN
#undef SEAM
}

extern "C" void kernel_launch(void* const* d_in, const int* in_sizes, int n_in, void* d_out, int out_size, void* d_ws, size_t ws_size, hipStream_t stream) {
    static int grid = 0;
    if (grid == 0) {
        if (n_in != 23 || in_sizes[0] != M * D || out_size != M * D || ws_size < WS_END) { fprintf(stderr, "kernel_launch: unexpected shapes (n_in %d, in0 %d, out %d, ws %zu < %zu)\n", n_in, n_in > 0 ? in_sizes[0] : -1, out_size, ws_size, (size_t)WS_END); grid = -1; return; }
        int dev = 0, cus = 0, per_cu = 0;
        if (hipGetDevice(&dev) != hipSuccess || hipDeviceGetAttribute(&cus, hipDeviceAttributeMultiprocessorCount, dev) != hipSuccess) { grid = -1; return; }
        if (hipFuncSetAttribute((const void*)mk_fwd, hipFuncAttributeMaxDynamicSharedMemorySize, LDS_BYTES) != hipSuccess) { fprintf(stderr, "kernel_launch: hipFuncSetAttribute failed\n"); grid = -1; return; }
        if (hipOccupancyMaxActiveBlocksPerMultiprocessor(&per_cu, (const void*)mk_fwd, NTHREADS, LDS_BYTES) != hipSuccess || per_cu < 1) fprintf(stderr, "kernel_launch: occupancy query reports %d\n", per_cu);
        (void)hipGetLastError();
        grid = cus;
    }
    if (grid < 0) return;
    if (hipMemsetAsync((char*)d_ws + WS_CTL, 0, CTL_ZERO_BYTES, stream) != hipSuccess) return;
    Args a{};
    for (int i = 0; i < 23; ++i) a.in[i] = d_in[i];
    a.out = (float*)d_out; a.ws = (unsigned char*)d_ws;
#if MK_ONE_LAUNCH
    a.ph_lo = 0; a.ph_hi = N_PHASES;
    hipLaunchKernelGGL(mk_fwd, dim3(grid), dim3(NTHREADS), LDS_BYTES, stream, a);
#else
    for (int p = 0; p < N_PHASES; ++p) { a.ph_lo = p; a.ph_hi = p + 1; hipLaunchKernelGGL(mk_fwd, dim3(grid), dim3(NTHREADS), LDS_BYTES, stream, a); }
#endif
    const hipError_t le = hipPeekAtLastError();
    if (le != hipSuccess) fprintf(stderr, "kernel_launch: launch failed: %s\n", hipGetErrorName(le));
}
```

```cpp
#include <hip/hip_runtime.h>
#include <cstdio>
#include <cstdint>
#include <cmath>
constexpr int ZT_LD = 2432, ZT_CQ = 0, ZT_CKV = 256, ZT_MQ = 384, ZT_MK = 640, ZT_MV = 896, ZT_U = 1408, ZT_V = 1920;
constexpr int H_LD = 3072, ZY_LD = 3072, YA = 0, YB = 512, YC = 1024, YD = 1536;
constexpr float RMS_EPS = 1e-6f;
#ifndef MK_KI0
#define MK_KI0 512
#endif
#ifndef MK_KI1
#define MK_KI1 1024
#endif
constexpr int ki8_of(int l) { return l == 0 ? MK_KI0 : MK_KI1; }
namespace pg8 {
#define PG8_LAS __attribute__((address_space(3)))
typedef unsigned short bf16_t;
typedef short bf16x8 __attribute__((ext_vector_type(8)));
typedef float f32x4 __attribute__((ext_vector_type(4)));
typedef int i32x4 __attribute__((ext_vector_type(4)));
typedef unsigned u32x4 __attribute__((ext_vector_type(4)));
constexpr int BM = 256, BK = 64, HALF = 128, HTB = HALF * BK * 2  , STAGE_BYTES = 8 * HTB, NXCD = 8, WGM = 8;

__host__ __device__ __forceinline__ int lds_byte(int r, int c) { const int st = (r >> 4) * 2 + (c >> 5), rr = r & 15, cc = c & 31, ob = rr * 64 + cc * 2; return st * 1024 + (ob ^ (((ob >> 9) & 1) << 5)); }
__host__ __device__ __forceinline__ void stage_rc(int b, int& R, int& C) { const int st = b / 1024, sb = b % 1024, swz = sb ^ (((sb >> 9) & 1) << 5); R = (st >> 1) * 16 + swz / 64; C = (st & 1) * 32 + (swz % 64) / 2; }
__host__ __device__ __forceinline__ int perm32(int rho) { const int n = rho >> 4, i = rho & 15; return 8 * (i >> 2) + 4 * n + (i & 3); }

struct Unit { int pm, pn, nt, br, kind; unsigned aoff, boff; };
struct Gemm { const bf16_t* A; const bf16_t* Bt; int M, N, K, lda; };

struct StaticOrder {
    int nM, nN, nwg, G, c, nt; unsigned a0;
    __host__ __device__ __forceinline__ void init(int M, int N, int G_, int c_, int K_, unsigned a0_ = 0u) { nM = M / BM; nN = N / BM; nwg = nM * nN; G = G_; c = c_; nt = K_ / BK; a0 = a0_; }
    __host__ __device__ __forceinline__ bool next(int i, Unit& u) const {
        const long L = (long)i * G + c; if (L >= nwg) return false;
        int wgid = (int)L; { const int q = nwg / NXCD, r = nwg % NXCD, xcd = wgid % NXCD, off = wgid / NXCD; wgid = (xcd < r ? xcd * (q + 1) : r * (q + 1) + (xcd - r) * q) + off; }
        const int nig = WGM * nN, gid = wgid / nig, fm = gid * WGM, gsz = (nM - fm) < WGM ? (nM - fm) : WGM;
        u.pm = fm + ((wgid % nig) % gsz); u.pn = (wgid % nig) / gsz; u.nt = nt; u.br = 0; u.kind = 0; u.aoff = a0; u.boff = 0u; return true;
    }
    __device__ __forceinline__ void a_ready(const Unit&) const {}
    __device__ __forceinline__ void done(const Unit&) const {}
};

typedef __bf16 bf16x2_t __attribute__((ext_vector_type(2)));
__device__ __forceinline__ unsigned cvt_pk_bf16(float lo, float hi) { typedef float f32x2_t __attribute__((ext_vector_type(2))); f32x2_t v = {lo, hi}; bf16x2_t b = __builtin_convertvector(v, bf16x2_t); return __builtin_bit_cast(unsigned, b); }
typedef float f32x2 __attribute__((ext_vector_type(2)));
typedef unsigned u32x2 __attribute__((ext_vector_type(2)));
__device__ __forceinline__ float fexp2(float x) { return __builtin_amdgcn_exp2f(x); }
__device__ __forceinline__ float frcp(float x) { return __builtin_amdgcn_rcpf(x); }
__device__ __forceinline__ float sigm(float x) { return frcp(1.f + fexp2(-1.4426950409f * x)); }
__device__ __forceinline__ float silu(float x) { return x * sigm(x); }
__device__ __forceinline__ float gelu_t(float x) { const float u = x + 0.044715f * x * x * x; return x * frcp(1.f + fexp2(-2.302208198f * u)); }
__device__ __forceinline__ float bflo(unsigned w) { return __uint_as_float(w << 16); }
__device__ __forceinline__ float bfhi(unsigned w) { return __uint_as_float(w & 0xffff0000u); }
__device__ __forceinline__ u32x4 pack8(const float (&o)[8]) { u32x4 w; w.x = cvt_pk_bf16(o[0], o[1]); w.y = cvt_pk_bf16(o[2], o[3]); w.z = cvt_pk_bf16(o[4], o[5]); w.w = cvt_pk_bf16(o[6], o[7]); return w; }
__device__ __forceinline__ void st_nt(u32x4* p, u32x4 v) { __builtin_nontemporal_store(v, p); }
__device__ __forceinline__ float quad_sum(float s) {
    s += __int_as_float(__builtin_amdgcn_ds_swizzle(__float_as_int(s), (16 << 10) | 0x1f)); auto r = __builtin_amdgcn_permlane32_swap(__float_as_uint(s), __float_as_uint(s), false, false); return __uint_as_float(r[0]) + __uint_as_float(r[1]); }

template <int KI8> struct EpiIn {
    static constexpr bool PERM = true, AFTER_DRAIN = false, HAS_MID = false, HAS_I8 = true;
    static constexpr int SPLIT_T = KI8 / 128;
    bf16_t* ZT; bf16_t* ZY; bf16_t* KR; float* PQ; float* PKV; float* PVS; float* GIF; const float* ROPE; const float* rdq; const float* cdq;
    __device__ __forceinline__ void dequant(f32x4 (&acc)[2][2][4][2], const Unit& u, int wr, int wc, int fr_, int fq_) const {
        int fr = fr_, fq = fq_; asm volatile("" : "+v"(fr), "+v"(fq));
        const int row0 = u.pm * BM + wr * 64 + fr; const float* cp = cdq + u.pn * 256 + wc * 32 + 8 * fq;
        float rq[8];
#pragma unroll
        for (int g = 0; g < 8; ++g) rq[g] = rdq[row0 + (g >> 2) * HALF + (g & 3) * 16];
#pragma unroll
        for (int bj = 0; bj < 2; ++bj) { const f32x4 c0 = *(const f32x4*)(cp + bj * HALF), c1 = *(const f32x4*)(cp + bj * HALF + 4);
#pragma unroll
            for (int ai = 0; ai < 2; ++ai)
#pragma unroll
                for (int m = 0; m < 4; ++m)
#pragma unroll
                    for (int e = 0; e < 8; ++e) acc[ai][bj][m][e >> 2][e & 3] = (float)__float_as_int(acc[ai][bj][m][e >> 2][e & 3]) * rq[ai * 4 + m] * (e < 4 ? c0[e & 3] : c1[e & 3]); }
    }
    template <int KIND> __device__ __forceinline__ void pair_tile(const f32x4 (&acc)[2][2][4][2], bf16_t* dst, int ld, int row0, int c0) const {
#pragma unroll
        for (int ai = 0; ai < 2; ++ai)
#pragma unroll
            for (int m = 0; m < 4; ++m) { const size_t row = (size_t)(row0 + ai * HALF + m * 16); float o[8];
#pragma unroll
                for (int e = 0; e < 8; ++e) { const float a = acc[ai][0][m][e >> 2][e & 3], b = acc[ai][1][m][e >> 2][e & 3];
                    o[e] = KIND == 0 ? b * frcp((1.f + fexp2(-1.4426950409f * a)) * (1.f + fexp2(-1.4426950409f * b)))
                         : KIND == 1 ? a * b : KIND == 2 ? a * silu(b)
                         : a * b * frcp((1.f + fexp2(-2.302208198f * (a + 0.044715f * a * a * a))) * (1.f + fexp2(-1.4426950409f * b))); }
                st_nt((u32x4*)(dst + row * ld + c0), pack8(o)); }
    }
    template <int ACT, int ST> __device__ __forceinline__ void plain_tile(const f32x4 (&acc)[2][2][4][2], bf16_t* dst, int ld, int row0, int cw, int t, int wc, int fq) const {
#pragma unroll
        for (int ai = 0; ai < 2; ++ai)
#pragma unroll
            for (int m = 0; m < 4; ++m) { const size_t row = (size_t)(row0 + ai * HALF + m * 16); float s1 = 0.f, s2 = 0.f;
#pragma unroll
                for (int bj = 0; bj < 2; ++bj) { float o[8];
#pragma unroll
                    for (int e = 0; e < 8; ++e) { float v = acc[ai][bj][m][e >> 2][e & 3]; v = ACT == 1 ? silu(v) : ACT == 2 ? gelu_t(v) : v; o[e] = v; if (ST == 2) s1 += v; if (ST) s2 += v * v; }
                    if (ST == 1) *(u32x4*)(dst + row * ld + bj * HALF + cw) = pack8(o);
                    else st_nt((u32x4*)(dst + row * ld + bj * HALF + cw), pack8(o)); }
                if (ST == 1) { s2 = quad_sum(s2); if (fq == 0) PQ[row * 4 + wc] = s2; }
                if (ST == 2) { s1 = quad_sum(s1); s2 = quad_sum(s2); if (fq == 0) { f32x2 p; p.x = s1; p.y = s2; *(f32x2*)(PVS + (row * 8 + (t - 24) * 4 + wc) * 2) = p; } } }
    }
    __device__ __forceinline__ void operator()(const f32x4 (&acc)[2][2][4][2], const Unit& u, int wr, int wc, int fr_, int fq_) const {
        int fr = fr_, fq = fq_; asm volatile("" : "+v"(fr), "+v"(fq));
        const int t = u.pn, row0 = u.pm * BM + wr * 64 + fr, cw = wc * 32 + 8 * fq;
        if (t >= 8 && t < 24) {
            const int kind = (t - 8) >> 2, c0 = ((t - 8) & 3) * 128 + cw;
            if (kind == 0) pair_tile<0>(acc, ZY + YB, ZY_LD, row0, c0); else if (kind == 1) pair_tile<1>(acc, ZT + ZT_U, ZT_LD, row0, c0);
            else if (kind == 2) pair_tile<2>(acc, ZY + YC, ZY_LD, row0, c0); else pair_tile<3>(acc, ZY + YD, ZY_LD, row0, c0);
            return;
        }
        if (t == 1) {
#pragma unroll
            for (int ai = 0; ai < 2; ++ai)
#pragma unroll
                for (int m = 0; m < 4; ++m) { const size_t row = (size_t)(row0 + ai * HALF + m * 16); float o[8]; float ss = 0.f;
#pragma unroll
                    for (int e = 0; e < 8; ++e) { o[e] = acc[ai][0][m][e >> 2][e & 3]; ss += o[e] * o[e]; }
                    *(u32x4*)(ZT + row * ZT_LD + ZT_CKV + cw) = pack8(o);
                    ss = quad_sum(ss); if (fq == 0) PKV[row * 4 + wc] = ss;
                    if (wc == 0) { const f32x4 t1 = acc[ai][1][m][0], t2 = acc[ai][1][m][1];
                        const f32x4 cs0 = *(const f32x4*)(ROPE + row * 32 + 8 * fq), cs1 = *(const f32x4*)(ROPE + row * 32 + 8 * fq + 4);
                        const float c[4] = {cs0[0], cs0[2], cs1[0], cs1[2]}, s[4] = {cs0[1], cs0[3], cs1[1], cs1[3]};
                        u32x2 w1, w2; w1.x = cvt_pk_bf16(t1[0] * c[0] - t2[0] * s[0], t1[1] * c[1] - t2[1] * s[1]); w1.y = cvt_pk_bf16(t1[2] * c[2] - t2[2] * s[2], t1[3] * c[3] - t2[3] * s[3]);
                        w2.x = cvt_pk_bf16(t1[0] * s[0] + t2[0] * c[0], t1[1] * s[1] + t2[1] * c[1]); w2.y = cvt_pk_bf16(t1[2] * s[2] + t2[2] * c[2], t1[3] * s[3] + t2[3] * c[3]);
                        *(u32x2*)(KR + row * 32 + 4 * fq) = w1; *(u32x2*)(KR + row * 32 + 16 + 4 * fq) = w2; }
                    if (wc == 1 && fq == 0) { *(f32x4*)(GIF + row * 8) = acc[ai][1][m][0]; *(f32x4*)(GIF + row * 8 + 4) = acc[ai][1][m][1]; } }
            return;
        }
        if (t == 0) plain_tile<0, 1>(acc, ZT + ZT_CQ, ZT_LD, row0, cw, t, wc, fq);
        else if (t < 4) plain_tile<1, 0>(acc, ZY + YA + (t - 2) * 256, ZY_LD, row0, cw, t, wc, fq);
        else if (t < 8) plain_tile<0, 0>(acc, ZT + (t == 4 ? ZT_MQ : t == 5 ? ZT_MK : ZT_MV + (t - 6) * 256), ZT_LD, row0, cw, t, wc, fq);
        else plain_tile<2, 2>(acc, ZT + ZT_V + (t - 24) * 256, ZT_LD, row0, cw, t, wc, fq);
    }
};
struct EpiUpQ {
    static constexpr bool PERM = true, AFTER_DRAIN = false, HAS_MID = false, HAS_I8 = false; static constexpr int SPLIT_T = 0;
    bf16_t* Q; const float* PQ; const float* ROPE;
    __device__ __forceinline__ void operator()(const f32x4 (&acc)[2][2][4][2], const Unit& u, int wr, int wc, int fr_, int fq_) const {
        int fr = fr_, fq = fq_; asm volatile("" : "+v"(fr), "+v"(fq));
        const int t = u.pn, row0 = u.pm * BM + wr * 64 + fr;
        float rsv[8];
#pragma unroll
        for (int g = 0; g < 8; ++g) { const f32x4 pq = *(const f32x4*)(PQ + (size_t)(row0 + (g >> 2) * HALF + (g & 3) * 16) * 4); rsv[g] = __builtin_amdgcn_rsqf(((pq[0] + pq[1]) + (pq[2] + pq[3])) * (1.f / 256.f) + RMS_EPS); }
#pragma unroll
        for (int ai = 0; ai < 2; ++ai)
#pragma unroll
            for (int m = 0; m < 4; ++m) { const size_t row = (size_t)(row0 + ai * HALF + m * 16);
                const float rs = rsv[ai * 4 + m];
                if (t < 2) {
#pragma unroll
                    for (int bj = 0; bj < 2; ++bj) { float o[8];
#pragma unroll
                        for (int e = 0; e < 8; ++e) o[e] = acc[ai][bj][m][e >> 2][e & 3] * rs;
                        *(u32x4*)(Q + row * 768 + (4 * t + 2 * bj + (wc >> 1)) * 96 + (wc & 1) * 32 + 8 * fq) = pack8(o); }
                } else {
                    const int head = 2 * wc + (fq >> 1), j0 = 8 * (fq & 1);
#pragma unroll
                    for (int n = 0; n < 2; ++n) { const int j = j0 + 4 * n;
                        const f32x4 ca = *(const f32x4*)(ROPE + row * 32 + 2 * j), cb = *(const f32x4*)(ROPE + row * 32 + 2 * j + 4);
                        const f32x4 t1 = acc[ai][0][m][n] * rs, t2 = acc[ai][1][m][n] * rs;
                        u32x2 w1, w2; w1.x = cvt_pk_bf16(t1[0] * ca[0] - t2[0] * ca[1], t1[1] * ca[2] - t2[1] * ca[3]); w1.y = cvt_pk_bf16(t1[2] * cb[0] - t2[2] * cb[1], t1[3] * cb[2] - t2[3] * cb[3]);
                        w2.x = cvt_pk_bf16(t1[0] * ca[1] + t2[0] * ca[0], t1[1] * ca[3] + t2[1] * ca[2]); w2.y = cvt_pk_bf16(t1[2] * cb[1] + t2[2] * cb[0], t1[3] * cb[3] + t2[3] * cb[2]);
                        *(u32x2*)(Q + row * 768 + head * 96 + 64 + j) = w1; *(u32x2*)(Q + row * 768 + head * 96 + 80 + j) = w2; }
                } }
    }
};
struct EpiUpKV {
    static constexpr bool PERM = true, AFTER_DRAIN = false, HAS_MID = false, HAS_I8 = false; static constexpr int SPLIT_T = 0;
    bf16_t* KN; bf16_t* V; const float* PKV;
    __device__ __forceinline__ void operator()(const f32x4 (&acc)[2][2][4][2], const Unit& u, int wr, int wc, int fr_, int fq_) const {
        int fr = fr_, fq = fq_; asm volatile("" : "+v"(fr), "+v"(fq));
        const int t = u.pn, row0 = u.pm * BM + wr * 64 + fr, cw = wc * 32 + 8 * fq; bf16_t* dst = (t < 2 ? KN : V) + (t & 1) * 256;
        float rsv[8];
#pragma unroll
        for (int g = 0; g < 8; ++g) { const f32x4 pq = *(const f32x4*)(PKV + (size_t)(row0 + (g >> 2) * HALF + (g & 3) * 16) * 4); rsv[g] = __builtin_amdgcn_rsqf(((pq[0] + pq[1]) + (pq[2] + pq[3])) * (1.f / 128.f) + RMS_EPS); }
#pragma unroll
        for (int ai = 0; ai < 2; ++ai)
#pragma unroll
            for (int m = 0; m < 4; ++m) { const size_t row = (size_t)(row0 + ai * HALF + m * 16);
                const float rs = rsv[ai * 4 + m];
#pragma unroll
                for (int bj = 0; bj < 2; ++bj) { float o[8];
#pragma unroll
                    for (int e = 0; e < 8; ++e) o[e] = acc[ai][bj][m][e >> 2][e & 3] * rs;
                    st_nt((u32x4*)(dst + row * 512 + bj * HALF + cw), pack8(o)); } }
    }
};
struct P4Order {
    StaticOrder base; unsigned boff_p;
    __device__ __forceinline__ void init(int M, int G_, int c_, unsigned boff_p_) { base.init(M, 1024, G_, c_, 1024); boff_p = boff_p_; }
    __device__ __forceinline__ bool next(int j, Unit& u) const {
        const int tile = j / 6, sub = j - 6 * tile;
        if (!base.next(tile, u)) return false;
        const int pair = sub >= 3, q = sub - 3 * pair; u.nt = 16;
        if (q < 2) { u.kind = 0; u.nt = 8; u.br = 2 * pair + q; u.aoff = 0u; u.boff = (unsigned)u.br * (1024u * 1024u * 2u); }
        else { u.kind = 2; u.br = 2 * pair; u.aoff = (unsigned)(1024 + 1024 * pair) * 2u; u.boff = boff_p + (unsigned)pair * (1024u * 1024u * 2u); }
        return true;
    }
    __device__ __forceinline__ void a_ready(const Unit&) const {}
    __device__ __forceinline__ void done(const Unit&) const {}
};
struct EpiP4 {
    static constexpr bool PERM = true, AFTER_DRAIN = false, HAS_MID = true, HAS_I8 = true; static constexpr int SPLIT_T = 0;
    unsigned char* S; bf16_t* MG; const float* bias; const float* rdq; const float* cdq;
    static __device__ __forceinline__ float ub(unsigned w, int i) { return (float)((w >> (8 * i)) & 0xffu); }
    static __device__ __forceinline__ void swap16(unsigned& a, unsigned& b) { auto r = __builtin_amdgcn_permlane16_swap(a, b, false, false); a = r[0]; b = r[1]; }
    static __device__ __forceinline__ u32x4 join16(u32x2 w0, u32x2 w1) { unsigned a = w0.x, b = w0.y, c = w1.x, d = w1.y; swap16(a, c); swap16(b, d); return (u32x4){a, b, c, d}; }
    static __device__ __forceinline__ void split16(u32x4 v, u32x2& w0, u32x2& w1) { unsigned a = v.x, b = v.y, c = v.z, d = v.w; swap16(a, c); swap16(b, d); w0 = (u32x2){a, b}; w1 = (u32x2){c, d}; }
    __device__ __forceinline__ void mid(f32x4 (&acc)[2][2][4][2], const Unit& u, int wr, int wc, int fr_, int fq_) const {
        int fr = fr_, fq = fq_; asm volatile("" : "+v"(fr), "+v"(fq));
        const int row0 = u.pm * BM + wr * 64 + fr, col0 = u.pn * BM + wc * 32 + 8 * fq, soff = (fq & 1) ? HALF - 8 : 0;
        const unsigned char* Sa = S; const unsigned char* Sb = S + (size_t)32768 * 1024;
        u32x4 la[8], lb[8];
#pragma unroll
        for (int g = 0; g < 8; ++g) { const size_t off_ = (size_t)(row0 + (g >> 2) * HALF + (g & 3) * 16) * 1024 + col0 + soff; la[g] = *(const u32x4*)(Sa + off_); lb[g] = *(const u32x4*)(Sb + off_); }
#pragma unroll
        for (int g = 0; g < 8; ++g) { const int ai = g >> 2, mm = g & 3; u32x2 sa[2], sb[2]; split16(la[g], sa[0], sa[1]); split16(lb[g], sb[0], sb[1]);
#pragma unroll
            for (int bj = 0; bj < 2; ++bj)
#pragma unroll
                for (int e = 0; e < 8; ++e) { const unsigned wa = e < 4 ? sa[bj].x : sa[bj].y, wb = e < 4 ? sb[bj].x : sb[bj].y;
                    acc[ai][bj][mm][e >> 2][e & 3] *= ub(wa, e & 3) * frcp(ub(wb, e & 3)); } }
    }
    __device__ __forceinline__ void operator()(const f32x4 (&acc)[2][2][4][2], const Unit& u, int wr, int wc, int fr_, int fq_) const {
        int fr = fr_, fq = fq_; asm volatile("" : "+v"(fr), "+v"(fq));
        const int row0 = u.pm * BM + wr * 64 + fr, col0 = u.pn * BM + wc * 32 + 8 * fq, soff = (fq & 1) ? HALF - 8 : 0;
        if (u.kind == 0) {
            unsigned char* Sme = S + (size_t)(u.br & 1) * ((size_t)32768 * 1024);
            const float* bp = bias + u.br * 1024 + col0; const float* cp = cdq + u.br * 1024 + col0; float rq[8];
#pragma unroll
            for (int g = 0; g < 8; ++g) rq[g] = rdq[row0 + (g >> 2) * HALF + (g & 3) * 16];
            u32x2 w0[8];
#pragma unroll
            for (int bj = 0; bj < 2; ++bj) { f32x2 bv[4], cv[4];
#pragma unroll
                for (int n = 0; n < 2; ++n) { const f32x4 b4 = *(const f32x4*)(bp + bj * HALF + 4 * n), c4 = *(const f32x4*)(cp + bj * HALF + 4 * n);
                    bv[2 * n] = (f32x2){b4.x, b4.y} * -1.4426950409f; bv[2 * n + 1] = (f32x2){b4.z, b4.w} * -1.4426950409f; cv[2 * n] = (f32x2){c4.x, c4.y} * -1.4426950409f; cv[2 * n + 1] = (f32x2){c4.z, c4.w} * -1.4426950409f; }
#pragma unroll
                for (int g = 0; g < 8; ++g) { const int ai = g >> 2, m = g & 3; const float rs = rq[g]; u32x2 w = {0u, 0u};
#pragma unroll
                    for (int p = 0; p < 4; ++p) { const f32x4 a4 = acc[ai][bj][m][p >> 1];
                        f32x2 t = {(float)__float_as_int(a4[2 * (p & 1)]), (float)__float_as_int(a4[2 * (p & 1) + 1])};
                        t = (t * rs) * cv[p] + bv[p];
                        f32x2 d = {fexp2(t.x), fexp2(t.y)}; d = d * (1.f / 255.f) + (1.f / 255.f);
                        const float s0 = fmaxf(frcp(d.x), 1.f), s1 = fmaxf(frcp(d.y), 1.f);
                        if (p < 2) { w.x = __builtin_amdgcn_cvt_pk_u8_f32(s0, 2 * p, w.x); w.x = __builtin_amdgcn_cvt_pk_u8_f32(s1, 2 * p + 1, w.x); }
                        else { w.y = __builtin_amdgcn_cvt_pk_u8_f32(s0, 2 * p - 4, w.y); w.y = __builtin_amdgcn_cvt_pk_u8_f32(s1, 2 * p - 3, w.y); } }
                    if (bj == 0) w0[g] = w;
                    else *(u32x4*)(Sme + (size_t)(row0 + ai * HALF + m * 16) * 1024 + col0 + soff) = join16(w0[g], w); } }
            return;
        }
        const int first = u.br == 0; const unsigned char* Sb = S + (size_t)32768 * 1024;
#pragma unroll
        for (int h = 0; h < 2; ++h) { u32x4 ls[4]; u32x4 mv[4][2];
#pragma unroll
            for (int q = 0; q < 4; ++q) { const size_t off_ = (size_t)(row0 + h * HALF + q * 16) * 1024 + col0;
                ls[q] = *(const u32x4*)(Sb + off_ + soff);
                if (!first) { mv[q][0] = *(const u32x4*)(MG + off_); mv[q][1] = *(const u32x4*)(MG + off_ + HALF); } else { mv[q][0] = (u32x4){0u, 0u, 0u, 0u}; mv[q][1] = (u32x4){0u, 0u, 0u, 0u}; } }
#pragma unroll
            for (int q = 0; q < 4; ++q) { const size_t off = (size_t)(row0 + h * HALF + q * 16) * 1024 + col0; u32x2 sv[2]; split16(ls[q], sv[0], sv[1]);
#pragma unroll
                for (int bj = 0; bj < 2; ++bj) { float o[8];
#pragma unroll
                    for (int e = 0; e < 8; ++e) { const unsigned sw = e < 4 ? sv[bj].x : sv[bj].y; const float s = ub(sw, e & 3) * (1.f / 255.f);
                        const unsigned mw = mv[q][bj][e >> 1]; const float mprev = (e & 1) ? bfhi(mw) : bflo(mw);
                        o[e] = mprev + s * acc[h][bj][q][e >> 2][e & 3]; }
                    *(u32x4*)(MG + off + bj * HALF) = pack8(o); } } }
    }
};
struct EpiOut {
    static constexpr bool PERM = true, AFTER_DRAIN = false, HAS_MID = false, HAS_I8 = false; static constexpr int SPLIT_T = 0;
    bf16_t* MO; float* PO;
    __device__ __forceinline__ void operator()(const f32x4 (&acc)[2][2][4][2], const Unit& u, int wr, int wc, int fr_, int fq_) const {
        int fr = fr_, fq = fq_; asm volatile("" : "+v"(fr), "+v"(fq));
        const int row0 = u.pm * BM + wr * 64 + fr, col0 = u.pn * BM + wc * 32 + 8 * fq;
#pragma unroll
        for (int ai = 0; ai < 2; ++ai)
#pragma unroll
            for (int m = 0; m < 4; ++m) { const size_t row = (size_t)(row0 + ai * HALF + m * 16); float ss = 0.f;
#pragma unroll
                for (int bj = 0; bj < 2; ++bj) { float o[8];
#pragma unroll
                    for (int e = 0; e < 8; ++e) { o[e] = acc[ai][bj][m][e >> 2][e & 3]; ss += o[e] * o[e]; }
                    *(u32x4*)(MO + row * 1024 + col0 + bj * HALF) = pack8(o); }
                ss = quad_sum(ss); if (fq == 0) PO[row * 16 + u.pn * 4 + wc] = ss; }
    }
};
template <class Epi, class Sched, bool ALIGN_EPI = false, bool SP2 = false>
__device__ __forceinline__ void gemm_phase(PG8_LAS unsigned char* lds, const Gemm g, const Sched& S, const Epi& E) {
    int tid_ = threadIdx.x; asm volatile("" : "+v"(tid_));
    const int tid = tid_, wid = __builtin_amdgcn_readfirstlane(tid >> 6), lane = tid & 63, wr = wid >> 2, wc = wid & 3, fr = lane & 15, fq = lane >> 4;
    const int K = g.K;
    unsigned voffA[2], voffB[2];
#pragma unroll
    for (int i = 0; i < 2; ++i) { int R, C; stage_rc(tid * 16 + i * 8192, R, C); const int Rb = Epi::PERM ? ((R & ~31) + perm32(R & 31)) : R;
        voffA[i] = (unsigned)(R * g.lda + C) * 2u; voffB[i] = (unsigned)(Rb * K + C) * 2u; }
    const size_t kstep = (size_t)(BK * 2);
    const size_t hstepB = (size_t)HALF * K * 2, hstepA = (size_t)HALF * g.lda * 2;
    const size_t tstepA = 2 * hstepA, tstepB = 2 * hstepB;
    const unsigned ldsw = (unsigned)wid * 1024u;
    const int aoff = lds_byte(wr * 64 + fr, fq * 8), boff = lds_byte(wc * 32 + fr, fq * 8);
#define PG8_SA(b, h) (((b) * 2 + (h)) * HTB)
#define PG8_SB(b, h) ((4 + (b) * 2 + (h)) * HTB)
#define PG8_STAGE(bufoff, gbase, voff) do { _Pragma("unroll") for (int _i = 0; _i < 2; ++_i) { unsigned vo_ = (voff)[_i]; asm volatile("" : "+v"(vo_));     \
        __builtin_amdgcn_global_load_lds((const unsigned*)((const char*)(gbase) + vo_), (PG8_LAS unsigned*)(lds + (bufoff) + ldsw + _i * 8192), 16, 0, 0); } } while (0)
#define PG8_LDA(dst, b, h) do { _Pragma("unroll") for (int m = 0; m < 4; ++m) _Pragma("unroll") for (int k = 0; k < 2; ++k) dst[m][k] = *(const PG8_LAS bf16x8*)(lds + PG8_SA(b, h) + aoff + m * 2048 + k * 1024); } while (0)
#define PG8_LDB(dst, b, h) do { _Pragma("unroll") for (int n = 0; n < 2; ++n) _Pragma("unroll") for (int k = 0; k < 2; ++k) dst[n][k] = *(const PG8_LAS bf16x8*)(lds + PG8_SB(b, h) + boff + n * 2048 + k * 1024); } while (0)
#define PG8_MMA(ai, bj, At, Bt) do { __builtin_amdgcn_s_setprio(1); _Pragma("unroll") for (int m = 0; m < 4; ++m) _Pragma("unroll") for (int n = 0; n < 2; ++n) _Pragma("unroll") for (int k = 0; k < 2; ++k) \
        acc[ai][bj][m][n] = __builtin_amdgcn_mfma_f32_16x16x32_bf16(Bt[n][k], At[m][k], acc[ai][bj][m][n], 0, 0, 0); __builtin_amdgcn_s_setprio(0); } while (0)
#define PG8_MMA_I8(ai, bj, At, Bt) do { __builtin_amdgcn_s_setprio(1); _Pragma("unroll") for (int m = 0; m < 4; ++m) _Pragma("unroll") for (int n = 0; n < 2; ++n) _Pragma("unroll") for (int k = 0; k < 2; ++k) \
        acc[ai][bj][m][n] = __builtin_bit_cast(f32x4, __builtin_amdgcn_mfma_i32_16x16x64_i8(__builtin_bit_cast(i32x4, Bt[n][k]), __builtin_bit_cast(i32x4, At[m][k]), __builtin_bit_cast(i32x4, acc[ai][bj][m][n]), 0, 0, 0)); __builtin_amdgcn_s_setprio(0); } while (0)
#define PG8_WAIT_V(n) asm volatile("s_waitcnt vmcnt(" #n ")" ::: "memory")
#define PG8_WAIT_L(n) asm volatile("s_waitcnt lgkmcnt(" #n ")" ::: "memory")
#define PG8_BAR __builtin_amdgcn_s_barrier()
#define PG8_SCHED __builtin_amdgcn_sched_barrier(0)
#define PG8_KLOOP(MMAX, T0, T1) \
        for (int t = (T0); t < (T1); t += 2) { \
            const bool last = (t == nt - 2); \
            const char* a1 = cA + (size_t)(t + 1) * kstep; \
            const char* a2 = last ? nA : cA + (size_t)(t + 2) * kstep; const char* b2 = last ? nB : cB + (size_t)(t + 2) * kstep; \
            const char* a3 = a2 + kstep; const char* b3 = b2 + kstep; \
            if (last && has_next) S.a_ready(nxt); \
            if constexpr (Epi::HAS_MID) { if (t == 8 && cur.kind == 2) E.mid(acc, cur, wr, wc, fr, fq); } \
            PG8_LDB(B0, 0, 0); PG8_LDB(B1, 0, 1); PG8_SCHED; PG8_LDA(At, 0, 0); PG8_STAGE(PG8_SA(1, 1), a1 + hstepA, voffA); \
            PG8_WAIT_V(8); PG8_WAIT_L(0); PG8_BAR; MMAX(0, 0, At, B0); MMAX(0, 1, At, B1); PG8_BAR; PG8_SCHED; \
            PG8_LDA(At, 0, 1); PG8_STAGE(PG8_SB(0, 0), b2, voffB); PG8_STAGE(PG8_SB(0, 1), b2 + hstepB, voffB); PG8_STAGE(PG8_SA(0, 0), a2, voffA); \
            PG8_WAIT_V(8); PG8_WAIT_L(0); PG8_BAR; MMAX(1, 0, At, B0); MMAX(1, 1, At, B1); PG8_BAR; PG8_SCHED; \
            PG8_LDB(B0, 1, 0); PG8_LDB(B1, 1, 1); PG8_SCHED; PG8_LDA(At, 1, 0); PG8_STAGE(PG8_SA(0, 1), a2 + hstepA, voffA); \
            PG8_WAIT_V(8); PG8_WAIT_L(0); PG8_BAR; MMAX(0, 0, At, B0); MMAX(0, 1, At, B1); PG8_BAR; PG8_SCHED; \
            PG8_LDA(At, 1, 1); PG8_STAGE(PG8_SB(1, 0), b3, voffB); PG8_STAGE(PG8_SB(1, 1), b3 + hstepB, voffB); PG8_STAGE(PG8_SA(1, 0), a3, voffA); \
            PG8_WAIT_V(8); PG8_WAIT_L(0); PG8_BAR; MMAX(1, 0, At, B0); MMAX(1, 1, At, B1); PG8_BAR; PG8_SCHED; \
        }
    Unit cur, nxt; int ui = 0;
    if (!S.next(0, cur)) return;
    f32x4 acc[2][2][4][2];
#pragma unroll
    for (int a = 0; a < 2; ++a)
#pragma unroll
        for (int b = 0; b < 2; ++b)
#pragma unroll
            for (int m = 0; m < 4; ++m)
#pragma unroll
                for (int n = 0; n < 2; ++n) acc[a][b][m][n] = (f32x4){0.f, 0.f, 0.f, 0.f};
    bf16x8 At[4][2], B0[2][2], B1[2][2];
    const char* cA = (const char*)g.A + (size_t)cur.pm * tstepA + cur.aoff; const char* cB = (const char*)g.Bt + (size_t)cur.pn * tstepB + cur.boff;
    S.a_ready(cur);
    if constexpr (SP2) {
        PG8_STAGE(PG8_SB(0, 0), cB, voffB); PG8_STAGE(PG8_SB(0, 1), cB + hstepB, voffB); PG8_STAGE(PG8_SA(0, 0), cA, voffA); PG8_STAGE(PG8_SA(0, 1), cA + hstepA, voffA);
        if (wr == 1) PG8_BAR;
        PG8_WAIT_V(2); PG8_BAR;
        PG8_STAGE(PG8_SB(1, 0), cB + kstep, voffB); PG8_STAGE(PG8_SA(1, 0), cA + kstep, voffA); PG8_STAGE(PG8_SB(1, 1), cB + hstepB + kstep, voffB);
        PG8_WAIT_V(6); PG8_BAR;
    } else {
        PG8_STAGE(PG8_SB(0, 0), cB, voffB); PG8_STAGE(PG8_SA(0, 0), cA, voffA); PG8_STAGE(PG8_SB(0, 1), cB + hstepB, voffB); PG8_STAGE(PG8_SA(0, 1), cA + hstepA, voffA);
        if (wr == 1) PG8_BAR;
        PG8_WAIT_V(4); PG8_BAR;
        PG8_STAGE(PG8_SB(1, 0), cB + kstep, voffB); PG8_STAGE(PG8_SA(1, 0), cA + kstep, voffA); PG8_STAGE(PG8_SB(1, 1), cB + hstepB + kstep, voffB);
        PG8_WAIT_V(6); PG8_BAR;
    }
    for (;;) {
        const bool has_next = S.next(ui + 1, nxt);
        const char* nA = has_next ? (const char*)g.A + (size_t)nxt.pm * tstepA + nxt.aoff : cA; const char* nB = has_next ? (const char*)g.Bt + (size_t)nxt.pn * tstepB + nxt.boff : cB;
        const int nt = cur.nt; const bool i8u = Epi::HAS_I8 && cur.kind == 0;
        static_assert(SP2, "only the two-super-phase K-loop is kept");
        if (Epi::HAS_I8 && i8u) {
            if constexpr (Epi::SPLIT_T > 0) {
                PG8_KLOOP(PG8_MMA_I8, 0, Epi::SPLIT_T) E.dequant(acc, cur, wr, wc, fr, fq); PG8_KLOOP(PG8_MMA, Epi::SPLIT_T, nt)
            } else { PG8_KLOOP(PG8_MMA_I8, 0, nt) }
        } else { PG8_KLOOP(PG8_MMA, 0, nt) }
        if constexpr (ALIGN_EPI) { if (wr == 0) PG8_BAR; }
        if constexpr (!Epi::AFTER_DRAIN) { E(acc, cur, wr, wc, fr, fq); S.done(cur); }
        if (!has_next) break;
#pragma unroll
        for (int a = 0; a < 2; ++a)
#pragma unroll
            for (int b = 0; b < 2; ++b)
#pragma unroll
                for (int m = 0; m < 4; ++m)
#pragma unroll
                    for (int n = 0; n < 2; ++n) acc[a][b][m][n] = (f32x4){0.f, 0.f, 0.f, 0.f};
        cur = nxt; cA = nA; cB = nB; ++ui;
        if constexpr (ALIGN_EPI) { if (wr == 1) PG8_BAR; }
    }
    PG8_WAIT_V(0);
    if constexpr (!ALIGN_EPI) { if (wr == 0) PG8_BAR; }
    PG8_BAR;
    if constexpr (Epi::AFTER_DRAIN) { E.fused(acc, cur, wr, wc, fr, fq, lds, wid, lane); S.done(cur); }
#undef PG8_SA
#undef PG8_SB
#undef PG8_STAGE
#undef PG8_LDA
#undef PG8_LDB
#undef PG8_MMA
#undef PG8_MMA_I8
#undef PG8_KLOOP
#undef PG8_WAIT_V
#undef PG8_WAIT_L
#undef PG8_BAR
#undef PG8_SCHED
}
}

constexpr int NWAVES = 8, NTHREADS = 512;
constexpr int NB = 8, SEQ = 4096, D = 1024, M = NB * SEQ, DEPTH = 2;
constexpr int IN_DIM = 6568, NV_IN = 6656;
constexpr int O_CQ = 0, O_CKV = 256, O_KR = 384, O_GA = 416, O_MQ = 928, O_MK = 1184, O_MV = 1440, O_MI = 1952, O_MF = 1956, O_MO = 1960, O_GB = 2472,
              O_CX = 2984, O_CB = 3496, O_CC = 4008, O_GC = 4520, O_DU = 5032, O_DV = 5544, O_GD = 6056;
constexpr float QSCALE = 0.10206207261596577f * 1.4426950408889634f;
constexpr int N_PHASES = 13;
#ifndef MK_ONE_LAUNCH
#define MK_ONE_LAUNCH 1
#endif
#ifndef MK_PROBE
#define MK_PROBE 0
#endif
#ifndef MK_ATTN_V2
#define MK_ATTN_V2 1
#endif
#ifndef MK_NAIVE_ATTN
#define MK_NAIVE_ATTN 0
#endif
#ifndef MK_NAIVE_MLSTM
#define MK_NAIVE_MLSTM 0
#endif
#ifndef MK_NAIVE_SGU
#define MK_NAIVE_SGU 0
#endif

__host__ __device__ __forceinline__ int map_in(int vc, float& cs) {
    const int t = vc >> 8, j = vc & 255; cs = 1.f;
    if (t == 0) return O_CQ + j;
    if (t == 1) { if (j < 128) return O_CKV + j; const int jp = j - 128;
        if (jp < 32) { const int g = jp >> 3, w = jp & 7; return O_KR + (w < 4 ? 4 * g + w : 16 + 4 * g + (w - 4)); }
        if (jp < 36) return O_MI + (jp - 32); if (jp < 40) return O_MF + (jp - 36); return -1; }
    if (t < 4) return O_GA + 256 * (t - 2) + j;
    if (t == 4) { cs = 0.125f; return O_MQ + j; }
    if (t == 5) return O_MK + j;
    if (t < 8) return O_MV + 256 * (t - 6) + j;
    if (t < 24) { const int kind = (t - 8) >> 2, c0 = ((t - 8) & 3) * 128, jj = j & 127, hi = j >> 7;
        const int a = kind == 0 ? O_MO : kind == 1 ? O_CX : kind == 2 ? O_CB : O_DU, b = kind == 0 ? O_GB : kind == 1 ? O_CC : kind == 2 ? O_GC : O_GD;
        return (hi ? b : a) + c0 + jj; }
    return O_DV + 256 * (t - 24) + j;
}
__host__ __device__ __forceinline__ int map_q(int vc) { if (vc < 512) return (vc >> 6) * 96 + (vc & 63); const int j = vc - 512, hi = j >> 7, jj = j & 127; return (jj >> 4) * 96 + 64 + 16 * hi + (jj & 15); }
__host__ __device__ __forceinline__ int map_kv(int vc) { const int isv = vc >> 9, j = vc & 511; return (j >> 6) * 128 + 64 * isv + (j & 63); }

constexpr size_t MiB = 1u << 20;
constexpr size_t WS_CTL = 0, CTL_ZERO_BYTES = 64 * 1024;
constexpr size_t WS_WB = 1 * MiB;
constexpr size_t WB_IN = 0, WB_GATE = WB_IN + (size_t)NV_IN * 1024 * 2, WB_P = WB_GATE + (size_t)4096 * 1024 * 2  , WB_UQ = WB_P + (size_t)4 * 1024 * 1024 * 2,
                 WB_UKV = WB_UQ + (size_t)768 * 256 * 2, WB_S = WB_UKV + (size_t)1024 * 128 * 2, WB_END = WB_S + (size_t)4 * 128 * 128 * 2;
static_assert(WB_END <= 30 * MiB, "weights");
constexpr size_t WS_H = 31 * MiB  , WS_ZY = WS_H + 2048, WS_ZT = 223 * MiB, WS_Q = 375 * MiB, WS_KN = 423 * MiB, WS_V = 455 * MiB, WS_KR = 487 * MiB;
constexpr size_t WS_ROPE = 489 * MiB, WS_PQ = 493 * MiB, WS_PKV = WS_PQ + MiB / 2, WS_PVS = 494 * MiB, WS_GIF = 496 * MiB, WS_MLS = 497 * MiB, WS_PO = 499 * MiB, WS_MSUM = 501 * MiB, WS_WOUT = 509 * MiB + MiB / 2  , WS_END = 512 * MiB;
constexpr size_t WS_S = WS_ZT, WS_MG = WS_ZT + 64 * MiB, WS_MO = WS_S;
static_assert(WS_ZT + (size_t)M * ZT_LD * 2 <= WS_Q && WS_H + (size_t)M * H_LD * 2 <= WS_ZT && WS_MG + (size_t)M * D * 2 <= WS_Q && WS_WOUT + (size_t)1024 * 1024 * 2 <= WS_END, "ws map");
constexpr int CW_TMO = 0, CW_BAR = 4096;
constexpr size_t WS_RDQ = WS_CTL + 256 * 1024  , WS_CDQ = WS_CTL + 512 * 1024  , WS_CDQI = WS_CTL + 768 * 1024  ;

constexpr int RING_OFF = 0, RING_BYTES = 131072, LDSCTL_OFF = RING_BYTES, MISC_OFF = LDSCTL_OFF + 320, LDS_BYTES = 147456;

#define GAS __attribute__((address_space(1)))
#define LAS __attribute__((address_space(3)))
typedef unsigned short bf16;
typedef unsigned v4u __attribute__((ext_vector_type(4)));
typedef float f32x4 __attribute__((ext_vector_type(4)));
typedef short bf16x8 __attribute__((ext_vector_type(8)));
typedef GAS unsigned gu32;
typedef GAS unsigned long long gu64;
#define RLX_AGENT __ATOMIC_RELAXED, __HIP_MEMORY_SCOPE_AGENT
#define LDS_WAIT() asm volatile("s_waitcnt lgkmcnt(0)" ::: "memory")
#define VM_WAIT() asm volatile("s_waitcnt vmcnt(0)" ::: "memory")
__device__ __forceinline__ unsigned long long rt() { return __builtin_amdgcn_s_memrealtime(); }
__device__ __forceinline__ unsigned f2bf(float f) { unsigned u = __builtin_bit_cast(unsigned, f); return (u + 0x7fffu + ((u >> 16) & 1u)) >> 16; }
__device__ __forceinline__ unsigned pk2(float lo, float hi) { return f2bf(lo) | (f2bf(hi) << 16); }

#define XB_TMO      128
#define XB_XCNT(j)  (256  + 64 * (j))
#define XB_XSUB(j)  (1280 + 64 * (j))
#define XB_XGEN(j)  (2304 + 64 * (j))
#define XB_TOP      3328
#define XB_TOPGEN   3392
#define XCD_BAR_WORDS 3456
#define XB_SPIN_CAP (1u << 18)

__device__ __forceinline__ unsigned xb_ld(unsigned* p)              { return __hip_atomic_load(p, __ATOMIC_RELAXED, __HIP_MEMORY_SCOPE_AGENT); }
__device__ __forceinline__ unsigned xb_add(unsigned* p, unsigned v) { return __hip_atomic_fetch_add(p, v, __ATOMIC_RELAXED, __HIP_MEMORY_SCOPE_AGENT); }
__device__ __forceinline__ unsigned xb_xcc_id() { return (unsigned)__builtin_amdgcn_s_getreg((3 << 11) | 20) & 0xFu; }
#define XB_SPIN(cond, bar) do { unsigned _sp = 0; while (cond) { __builtin_amdgcn_s_sleep(1); \
    if ((++_sp & 255u) == 0u) { if (xb_ld(&(bar)[XB_TMO])) break; if (_sp > XB_SPIN_CAP) { atomicAdd(&(bar)[XB_TMO], 1u); break; } } } } while (0)

struct XcdBarrier {
    unsigned* bar; unsigned x;
    volatile LAS unsigned* st;
};

__device__ __forceinline__ XcdBarrier xcd_barrier_post(unsigned* bar, volatile LAS unsigned* st) {
    XcdBarrier b; b.bar = bar; b.x = xb_xcc_id(); b.st = st;
    if (threadIdx.x == 0) (void)xb_add(&bar[XB_XCNT(b.x)], 1u);
    return b;
}
__device__ __forceinline__ void xcd_barrier_complete(unsigned* bar, unsigned x, unsigned& nloc, unsigned& nx) {
    const unsigned G = gridDim.x * gridDim.y * gridDim.z;
    unsigned sum, cnt, mine, sp = 0u;
    for (;;) {
        sum = 0u; cnt = 0u; mine = 0u;
#pragma unroll
        for (unsigned j = 0; j < 16; ++j) { const unsigned c = xb_ld(&bar[XB_XCNT(j)]); sum += c; cnt += (c > 0u) ? 1u : 0u; mine = (j == x) ? c : mine; }
        if (sum == G) break;
        __builtin_amdgcn_s_sleep(1);
        if ((++sp & 255u) == 0u) { if (xb_ld(&bar[XB_TMO])) break; if (sp > XB_SPIN_CAP) { atomicAdd(&bar[XB_TMO], 1u); break; } }
    }
    nloc = mine > 0u ? mine : 1u; nx = cnt > 0u ? cnt : 1u;
}

__device__ __forceinline__ void xcd_barrier(const XcdBarrier& b) {
    asm volatile("s_waitcnt vmcnt(0)" ::: "memory");
    __syncthreads();
    if (threadIdx.x == 0) {
        unsigned* bar = b.bar;
        __builtin_amdgcn_s_waitcnt(0);
        unsigned nloc = b.st[0], nx = b.st[1];
        if (nloc == 0u) { xcd_barrier_complete(bar, b.x, nloc, nx); b.st[0] = nloc; b.st[1] = nx; }
        const unsigned old = xb_add(&bar[XB_XSUB(b.x)], 1u);
        const unsigned gen = old / nloc;
        if (old + 1u == (gen + 1u) * nloc) {
            __builtin_amdgcn_fence(__ATOMIC_RELEASE, "agent");
            asm volatile("s_waitcnt vmcnt(0)" ::: "memory");
            const unsigned og = xb_add(&bar[XB_TOP], 1u);
            const unsigned tg = og / nx;
            if (og + 1u == (tg + 1u) * nx) xb_add(&bar[XB_TOPGEN], 1u);
            else XB_SPIN(xb_ld(&bar[XB_TOPGEN]) == tg, bar);
            __builtin_amdgcn_fence(__ATOMIC_ACQUIRE, "agent");
            xb_add(&bar[XB_XGEN(b.x)], 1u);
            asm volatile("s_waitcnt vmcnt(0)" ::: "memory");
        } else {
            XB_SPIN(xb_ld(&bar[XB_XGEN(b.x)]) == gen, bar);
            __builtin_amdgcn_fence(__ATOMIC_ACQUIRE, "agent");
            asm volatile("s_waitcnt vmcnt(0)" ::: "memory");
        }
    }
    __syncthreads();
}
namespace att {
using bf16x8 = __attribute__((ext_vector_type(8))) short;
using s16x4  = __attribute__((ext_vector_type(4))) short;
using f32x16 = __attribute__((ext_vector_type(16))) float;
using u32x4  = __attribute__((ext_vector_type(4))) unsigned;
constexpr int NW = 8, QBLK = 32, KVBLK = 64;
constexpr float THR2 = 11.5f;
constexpr int SHM_V = 16384, SHM_K = 16384, SHM_ATTN = 2 * SHM_V + 2 * SHM_K + NW * 64 * 4;
#define KSWZ(row, colB) ((row) * 256 + ((colB) ^ (((row) & 7) << 4)))
#define SBAR() __builtin_amdgcn_sched_barrier(0)
__device__ __forceinline__ int crow(int r, int hi) { return (r & 3) + 8 * (r >> 2) + 4 * hi; }
__device__ __forceinline__ unsigned cvtpk(float lo, float hi) { typedef float f2 __attribute__((ext_vector_type(2))); typedef __bf16 b2 __attribute__((ext_vector_type(2))); f2 v = {lo, hi}; b2 b = __builtin_convertvector(v, b2); return __builtin_bit_cast(unsigned, b); }
__device__ __forceinline__ void partialSM(f32x16& p0, f32x16& p1, float& m_reg, float& mn, float& alpha) {
  float pmax = p0[0];
#pragma unroll
  for (int r = 1; r < 16; ++r) pmax = fmaxf(pmax, p0[r]);
#pragma unroll
  for (int r = 0; r < 16; ++r) pmax = fmaxf(pmax, p1[r]);
  { auto rr = __builtin_amdgcn_permlane32_swap(__float_as_uint(pmax), __float_as_uint(pmax), false, false); pmax = fmaxf(__uint_as_float(rr[0]), __uint_as_float(rr[1])); }
  if (__builtin_expect(__all(pmax - m_reg <= THR2), 1)) { mn = m_reg; alpha = 1.f; }
  else { mn = fmaxf(m_reg, pmax); alpha = __builtin_amdgcn_exp2f(m_reg - mn); m_reg = mn; }
#pragma unroll
  for (int r = 0; r < 16; ++r) p0[r] = p0[r] - mn;
#pragma unroll
  for (int r = 0; r < 16; ++r) p1[r] = p1[r] - mn;
#pragma unroll
  for (int r = 0; r < 16; ++r) p0[r] = __builtin_amdgcn_exp2f(p0[r]);
}
__device__ __forceinline__ void finishSM(f32x16& p0, f32x16& p1, float alpha, float& l_reg, bf16x8& pa0, bf16x8& pa1, bf16x8& pa2, bf16x8& pa3) {
#pragma unroll
  for (int r = 0; r < 16; ++r) p1[r] = __builtin_amdgcn_exp2f(p1[r]);
  float ps = 0;
#pragma unroll
  for (int r = 0; r < 16; ++r) ps += p0[r];
#pragma unroll
  for (int r = 0; r < 16; ++r) ps += p1[r];
  { auto rr = __builtin_amdgcn_permlane32_swap(__float_as_uint(ps), __float_as_uint(ps), false, false); ps = __uint_as_float(rr[0]) + __uint_as_float(rr[1]); }
  l_reg = l_reg * alpha + ps;
#define PK4(P, BASE, OUT) do { unsigned a0 = cvtpk(P[BASE + 0], P[BASE + 1]), a1 = cvtpk(P[BASE + 2], P[BASE + 3]);   \
    unsigned b0 = cvtpk(P[BASE + 4], P[BASE + 5]), b1 = cvtpk(P[BASE + 6], P[BASE + 7]);                              \
    auto r0 = __builtin_amdgcn_permlane32_swap(a0, b0, false, false); auto r1 = __builtin_amdgcn_permlane32_swap(a1, b1, false, false); \
    u32x4 w = {r0[0], r1[0], r0[1], r1[1]}; OUT = __builtin_bit_cast(bf16x8, w); } while (0)
  PK4(p0, 0, pa0); PK4(p0, 8, pa1); PK4(p1, 0, pa2); PK4(p1, 8, pa3);
#undef PK4
}
template <int ND0> __device__ __forceinline__ void qkt(f32x16& p0, f32x16& p1, const char* Ks, const bf16x8* qr, int r32, int hi) {
  bf16x8 kf[2 * ND0];
#pragma unroll
  for (int d0 = 0; d0 < ND0; ++d0) { const int cb = (d0 * 16 + hi * 8) * 2;
    kf[2 * d0] = *reinterpret_cast<const bf16x8*>(Ks + KSWZ(r32, cb)); kf[2 * d0 + 1] = *reinterpret_cast<const bf16x8*>(Ks + KSWZ(32 + r32, cb)); }
  SBAR();
  p0 = f32x16{}; p1 = f32x16{};
#pragma unroll
  for (int d0 = 0; d0 < ND0; ++d0) { p0 = __builtin_amdgcn_mfma_f32_32x32x16_bf16(kf[2 * d0], qr[d0], p0, 0, 0, 0); p1 = __builtin_amdgcn_mfma_f32_32x32x16_bf16(kf[2 * d0 + 1], qr[d0], p1, 0, 0, 0); }
}
__device__ __forceinline__ int v_st(int k, int c) { const int kk = (k & ~0xC) | ((k & 4) << 1) | ((k & 8) >> 1); return ((kk >> 3) * 4 + (c >> 5)) * 512 + ((kk & 7) * 32 + (c & 31)) * 2; }
__device__ __forceinline__ int v_rd_base(int lane) { return ((lane & 3) << 3) | (((lane >> 2) & 3) << 6) | (((lane >> 4) & 1) << 5) | (((lane >> 5) & 1) << 8); }
constexpr int v_rd_off(int d0, int ks, int half) { return d0 * 512 + ks * 4096 + half * 2048; }
template <int OFF> __device__ __forceinline__ s16x4 tr_read(int vb) { s16x4 r; asm volatile("ds_read_b64_tr_b16 %0, %1 offset:%2" : "=&v"(r) : "v"(vb), "i"(OFF) : "memory"); return r; }
template <int D0, bool SWAP> __device__ __forceinline__ void pv_one(f32x16& od, int vb, bf16x8 pa0, bf16x8 pa1, bf16x8 pa2, bf16x8 pa3) {
  const s16x4 l0 = tr_read<v_rd_off(D0, 0, 0)>(vb), h0 = tr_read<v_rd_off(D0, 0, 1)>(vb), l1 = tr_read<v_rd_off(D0, 1, 0)>(vb), h1 = tr_read<v_rd_off(D0, 1, 1)>(vb);
  const s16x4 l2 = tr_read<v_rd_off(D0, 2, 0)>(vb), h2 = tr_read<v_rd_off(D0, 2, 1)>(vb), l3 = tr_read<v_rd_off(D0, 3, 0)>(vb), h3 = tr_read<v_rd_off(D0, 3, 1)>(vb);
  asm volatile("s_waitcnt lgkmcnt(0)" ::: "memory"); SBAR();
#define PK(L, H) (bf16x8){L[0], L[1], L[2], L[3], H[0], H[1], H[2], H[3]}
  if (SWAP) {
    od = __builtin_amdgcn_mfma_f32_32x32x16_bf16(PK(l0, h0), pa0, od, 0, 0, 0); od = __builtin_amdgcn_mfma_f32_32x32x16_bf16(PK(l1, h1), pa1, od, 0, 0, 0);
    od = __builtin_amdgcn_mfma_f32_32x32x16_bf16(PK(l2, h2), pa2, od, 0, 0, 0); od = __builtin_amdgcn_mfma_f32_32x32x16_bf16(PK(l3, h3), pa3, od, 0, 0, 0);
  } else {
    od = __builtin_amdgcn_mfma_f32_32x32x16_bf16(pa0, PK(l0, h0), od, 0, 0, 0); od = __builtin_amdgcn_mfma_f32_32x32x16_bf16(pa1, PK(l1, h1), od, 0, 0, 0);
    od = __builtin_amdgcn_mfma_f32_32x32x16_bf16(pa2, PK(l2, h2), od, 0, 0, 0); od = __builtin_amdgcn_mfma_f32_32x32x16_bf16(pa3, PK(l3, h3), od, 0, 0, 0);
  }
#undef PK
}

__device__ __forceinline__ void pv2(f32x16& o0, f32x16& o1, int vb, bf16x8 pa0, bf16x8 pa1, bf16x8 pa2, bf16x8 pa3) {
  const s16x4 l0 = tr_read<v_rd_off(0, 0, 0)>(vb), h0 = tr_read<v_rd_off(0, 0, 1)>(vb), m0 = tr_read<v_rd_off(1, 0, 0)>(vb), n0 = tr_read<v_rd_off(1, 0, 1)>(vb);
  const s16x4 l1 = tr_read<v_rd_off(0, 1, 0)>(vb), h1 = tr_read<v_rd_off(0, 1, 1)>(vb), m1 = tr_read<v_rd_off(1, 1, 0)>(vb), n1 = tr_read<v_rd_off(1, 1, 1)>(vb);
  const s16x4 l2 = tr_read<v_rd_off(0, 2, 0)>(vb), h2 = tr_read<v_rd_off(0, 2, 1)>(vb), m2 = tr_read<v_rd_off(1, 2, 0)>(vb), n2 = tr_read<v_rd_off(1, 2, 1)>(vb);
  const s16x4 l3 = tr_read<v_rd_off(0, 3, 0)>(vb), h3 = tr_read<v_rd_off(0, 3, 1)>(vb), m3 = tr_read<v_rd_off(1, 3, 0)>(vb), n3 = tr_read<v_rd_off(1, 3, 1)>(vb);
  asm volatile("s_waitcnt lgkmcnt(0)" ::: "memory"); SBAR();
#define PK(L, H) (bf16x8){L[0], L[1], L[2], L[3], H[0], H[1], H[2], H[3]}
  o0 = __builtin_amdgcn_mfma_f32_32x32x16_bf16(pa0, PK(l0, h0), o0, 0, 0, 0); o1 = __builtin_amdgcn_mfma_f32_32x32x16_bf16(pa0, PK(m0, n0), o1, 0, 0, 0);
  o0 = __builtin_amdgcn_mfma_f32_32x32x16_bf16(pa1, PK(l1, h1), o0, 0, 0, 0); o1 = __builtin_amdgcn_mfma_f32_32x32x16_bf16(pa1, PK(m1, n1), o1, 0, 0, 0);
  o0 = __builtin_amdgcn_mfma_f32_32x32x16_bf16(pa2, PK(l2, h2), o0, 0, 0, 0); o1 = __builtin_amdgcn_mfma_f32_32x32x16_bf16(pa2, PK(m2, n2), o1, 0, 0, 0);
  o0 = __builtin_amdgcn_mfma_f32_32x32x16_bf16(pa3, PK(l3, h3), o0, 0, 0, 0); o1 = __builtin_amdgcn_mfma_f32_32x32x16_bf16(pa3, PK(m3, n3), o1, 0, 0, 0);
#undef PK
}
__device__ __forceinline__ void finishSM2(f32x16& p0, f32x16& p1, bf16x8& pa0, bf16x8& pa1, bf16x8& pa2, bf16x8& pa3) {
#pragma unroll
  for (int r = 0; r < 16; ++r) p1[r] = __builtin_amdgcn_exp2f(p1[r]);
#define PK4(P, BASE, OUT) do { unsigned a0 = cvtpk(P[BASE + 0], P[BASE + 1]), a1 = cvtpk(P[BASE + 2], P[BASE + 3]);   \
    unsigned b0 = cvtpk(P[BASE + 4], P[BASE + 5]), b1 = cvtpk(P[BASE + 6], P[BASE + 7]);                              \
    auto r0 = __builtin_amdgcn_permlane32_swap(a0, b0, false, false); auto r1 = __builtin_amdgcn_permlane32_swap(a1, b1, false, false); \
    u32x4 w = {r0[0], r1[0], r0[1], r1[1]}; OUT = __builtin_bit_cast(bf16x8, w); } while (0)
  PK4(p0, 0, pa0); PK4(p0, 8, pa1); PK4(p1, 0, pa2); PK4(p1, 8, pa3);
#undef PK4
}
__device__ __forceinline__ void pv2l(f32x16& o0, f32x16& o1, f32x16& ls, int vb, bf16x8 pa0, bf16x8 pa1, bf16x8 pa2, bf16x8 pa3) {
  const s16x4 l0 = tr_read<v_rd_off(0, 0, 0)>(vb), h0 = tr_read<v_rd_off(0, 0, 1)>(vb), m0 = tr_read<v_rd_off(1, 0, 0)>(vb), n0 = tr_read<v_rd_off(1, 0, 1)>(vb);
  const s16x4 l1 = tr_read<v_rd_off(0, 1, 0)>(vb), h1 = tr_read<v_rd_off(0, 1, 1)>(vb), m1 = tr_read<v_rd_off(1, 1, 0)>(vb), n1 = tr_read<v_rd_off(1, 1, 1)>(vb);
  const s16x4 l2 = tr_read<v_rd_off(0, 2, 0)>(vb), h2 = tr_read<v_rd_off(0, 2, 1)>(vb), m2 = tr_read<v_rd_off(1, 2, 0)>(vb), n2 = tr_read<v_rd_off(1, 2, 1)>(vb);
  const s16x4 l3 = tr_read<v_rd_off(0, 3, 0)>(vb), h3 = tr_read<v_rd_off(0, 3, 1)>(vb), m3 = tr_read<v_rd_off(1, 3, 0)>(vb), n3 = tr_read<v_rd_off(1, 3, 1)>(vb);
  const short one = 0x3f80; const bf16x8 ones = {one, one, one, one, one, one, one, one};
  asm volatile("s_waitcnt lgkmcnt(0)" ::: "memory"); SBAR();
#define PK(L, H) (bf16x8){L[0], L[1], L[2], L[3], H[0], H[1], H[2], H[3]}
  o0 = __builtin_amdgcn_mfma_f32_32x32x16_bf16(pa0, PK(l0, h0), o0, 0, 0, 0); o1 = __builtin_amdgcn_mfma_f32_32x32x16_bf16(pa0, PK(m0, n0), o1, 0, 0, 0); ls = __builtin_amdgcn_mfma_f32_32x32x16_bf16(pa0, ones, ls, 0, 0, 0);
  o0 = __builtin_amdgcn_mfma_f32_32x32x16_bf16(pa1, PK(l1, h1), o0, 0, 0, 0); o1 = __builtin_amdgcn_mfma_f32_32x32x16_bf16(pa1, PK(m1, n1), o1, 0, 0, 0); ls = __builtin_amdgcn_mfma_f32_32x32x16_bf16(pa1, ones, ls, 0, 0, 0);
  o0 = __builtin_amdgcn_mfma_f32_32x32x16_bf16(pa2, PK(l2, h2), o0, 0, 0, 0); o1 = __builtin_amdgcn_mfma_f32_32x32x16_bf16(pa2, PK(m2, n2), o1, 0, 0, 0); ls = __builtin_amdgcn_mfma_f32_32x32x16_bf16(pa2, ones, ls, 0, 0, 0);
  o0 = __builtin_amdgcn_mfma_f32_32x32x16_bf16(pa3, PK(l3, h3), o0, 0, 0, 0); o1 = __builtin_amdgcn_mfma_f32_32x32x16_bf16(pa3, PK(m3, n3), o1, 0, 0, 0); ls = __builtin_amdgcn_mfma_f32_32x32x16_bf16(pa3, ones, ls, 0, 0, 0);
#undef PK
}
__device__ __forceinline__ void pv_kv(f32x16& acc, int vbk, int vbv) {
  const s16x4 al0 = tr_read<v_rd_off(0, 0, 0)>(vbk), ah0 = tr_read<v_rd_off(0, 0, 1)>(vbk), al1 = tr_read<v_rd_off(0, 1, 0)>(vbk), ah1 = tr_read<v_rd_off(0, 1, 1)>(vbk);
  const s16x4 al2 = tr_read<v_rd_off(0, 2, 0)>(vbk), ah2 = tr_read<v_rd_off(0, 2, 1)>(vbk), al3 = tr_read<v_rd_off(0, 3, 0)>(vbk), ah3 = tr_read<v_rd_off(0, 3, 1)>(vbk);
  const s16x4 bl0 = tr_read<v_rd_off(0, 0, 0)>(vbv), bh0 = tr_read<v_rd_off(0, 0, 1)>(vbv), bl1 = tr_read<v_rd_off(0, 1, 0)>(vbv), bh1 = tr_read<v_rd_off(0, 1, 1)>(vbv);
  const s16x4 bl2 = tr_read<v_rd_off(0, 2, 0)>(vbv), bh2 = tr_read<v_rd_off(0, 2, 1)>(vbv), bl3 = tr_read<v_rd_off(0, 3, 0)>(vbv), bh3 = tr_read<v_rd_off(0, 3, 1)>(vbv);
  asm volatile("s_waitcnt lgkmcnt(0)" ::: "memory"); SBAR();
#define PK(L, H) (bf16x8){L[0], L[1], L[2], L[3], H[0], H[1], H[2], H[3]}
  acc = __builtin_amdgcn_mfma_f32_32x32x16_bf16(PK(al0, ah0), PK(bl0, bh0), acc, 0, 0, 0); acc = __builtin_amdgcn_mfma_f32_32x32x16_bf16(PK(al1, ah1), PK(bl1, bh1), acc, 0, 0, 0);
  acc = __builtin_amdgcn_mfma_f32_32x32x16_bf16(PK(al2, ah2), PK(bl2, bh2), acc, 0, 0, 0); acc = __builtin_amdgcn_mfma_f32_32x32x16_bf16(PK(al3, ah3), PK(bl3, bh3), acc, 0, 0, 0);
#undef PK
}
__device__ __forceinline__ void attn_unit(int b, int h, int qb, const bf16* Q, const bf16* __restrict__ KN, const bf16* __restrict__ KR, const bf16* __restrict__ V, bf16* Y, char* lds) {
  int tid = threadIdx.x; asm volatile("" : "+v"(tid));
  const int wid = __builtin_amdgcn_readfirstlane(tid >> 6), lane = tid & 63, r32 = lane & 31, hi = lane >> 5;
  char* V_lds = lds; char* K_lds = lds + 2 * SHM_V;
  float* ws = (float*)(lds + 2 * SHM_V + 2 * SHM_K) + wid * 64; float* li_l = ws; float* al_l = ws + 32;
  float m_reg = -1e30f, l_reg = 0; f32x16 o[2] = {}; bf16x8 qr[6];
  const size_t rowbase = (size_t)b * SEQ; const int q0 = qb * 256;
  const bf16* Qw = Q + (rowbase + q0 + wid * QBLK + r32) * 768 + h * 96 + hi * 8;
#pragma unroll
  for (int d0 = 0; d0 < 6; ++d0) qr[d0] = *reinterpret_cast<const bf16x8*>(Qw + d0 * 16);
  const int sr = tid >> 4, sc = (tid & 15) * 8, vst0 = v_st(sr, sc & 63), vst1 = v_st(32 + sr, sc & 63);
  const bool doK = sc < 96, doV = sc < 64;
  const bf16* ksrc = sc < 64 ? KN + rowbase * 512 + h * 64 + sc : KR + rowbase * 32 + (sc - 64); const int kld = sc < 64 ? 512 : 32;
  const bf16* vsrc = V + rowbase * 512 + h * 64 + (sc & 63);
  const int vb0 = (int)(uintptr_t)V_lds + v_rd_base(lane);
  struct { bf16x8 vs0, vs1, ks0, ks1; } sr_[2];
#define SLOAD(i, k0) do { if (doV) { sr_[i].vs0 = *(const bf16x8*)(vsrc + (size_t)((k0) + sr) * 512); sr_[i].vs1 = *(const bf16x8*)(vsrc + (size_t)((k0) + 32 + sr) * 512); } \
    if (doK) { sr_[i].ks0 = *(const bf16x8*)(ksrc + (size_t)((k0) + sr) * kld); sr_[i].ks1 = *(const bf16x8*)(ksrc + (size_t)((k0) + 32 + sr) * kld); } } while (0)
#define SWRITE(bb, i) do { if (doV) { *(bf16x8*)(V_lds + (bb) * SHM_V + vst0) = sr_[i].vs0; *(bf16x8*)(V_lds + (bb) * SHM_V + vst1) = sr_[i].vs1; } \
    if (doK) { const int kc = sc * 2; *(bf16x8*)(K_lds + (bb) * SHM_K + KSWZ(sr, kc)) = sr_[i].ks0; *(bf16x8*)(K_lds + (bb) * SHM_K + KSWZ(32 + sr, kc)) = sr_[i].ks1; } } while (0)
#define SWAIT() asm volatile("s_waitcnt vmcnt(4)" ::: "memory")
#define RESC(a) do { if (__any((a) < 1.f)) { if (hi == 0) al_l[r32] = (a); asm volatile("s_waitcnt lgkmcnt(0)" ::: "memory"); \
    _Pragma("unroll") for (int d = 0; d < 2; ++d) _Pragma("unroll") for (int r = 0; r < 16; ++r) o[d][r] *= al_l[crow(r, hi)]; } } while (0)
#define MASK(P0, P1, j) do { if ((j) >= NTw) { _Pragma("unroll") for (int r = 0; r < 16; ++r) { P0[r] = -INFINITY; P1[r] = -INFINITY; } } } while (0)
  f32x16 pA0, pA1, pB0, pB1; float mnA, mnB, alA, alB; bf16x8 pa0, pa1, pa2, pa3;
  const int NT = 4 * qb + 4, NTw = 4 * qb + (wid >> 1) + 1;
  constexpr int SE = 0, SO = 1;
  SLOAD(SE, 0); asm volatile("s_waitcnt vmcnt(0)" ::: "memory"); SWRITE(0, SE); __syncthreads();
  qkt<6>(pA0, pA1, K_lds, qr, r32, hi); partialSM(pA0, pA1, m_reg, mnA, alA);
  SLOAD(SO, KVBLK); if (2 < NT) SLOAD(SE, 2 * KVBLK);
  SWAIT(); SWRITE(1, SO); __syncthreads();
  for (int j = 1; j + 1 < NT; j += 2) {
    SBAR(); qkt<6>(pB0, pB1, K_lds + SHM_K, qr, r32, hi); MASK(pB0, pB1, j);
    finishSM(pA0, pA1, alA, l_reg, pa0, pa1, pa2, pa3); SBAR();
    SLOAD(SO, (j + 2) * KVBLK); SBAR();
    pv_one<0, false>(o[0], vb0, pa0, pa1, pa2, pa3); pv_one<1, false>(o[1], vb0, pa0, pa1, pa2, pa3); partialSM(pB0, pB1, m_reg, mnB, alB);
    __syncthreads(); SWAIT(); SWRITE(0, SE);
    RESC(alB); __syncthreads();
    SBAR(); qkt<6>(pA0, pA1, K_lds, qr, r32, hi); MASK(pA0, pA1, j + 1);
    finishSM(pB0, pB1, alB, l_reg, pa0, pa1, pa2, pa3); SBAR();
    if (j + 3 < NT) SLOAD(SE, (j + 3) * KVBLK); SBAR();
    pv_one<0, false>(o[0], vb0 + SHM_V, pa0, pa1, pa2, pa3); pv_one<1, false>(o[1], vb0 + SHM_V, pa0, pa1, pa2, pa3); partialSM(pA0, pA1, m_reg, mnA, alA);
    __syncthreads(); SWAIT(); SWRITE(1, SO);
    RESC(alA); __syncthreads();
  }
  SBAR(); qkt<6>(pB0, pB1, K_lds + SHM_K, qr, r32, hi); MASK(pB0, pB1, NT - 1);
  finishSM(pA0, pA1, alA, l_reg, pa0, pa1, pa2, pa3); SBAR();
  pv_one<0, false>(o[0], vb0, pa0, pa1, pa2, pa3); pv_one<1, false>(o[1], vb0, pa0, pa1, pa2, pa3); partialSM(pB0, pB1, m_reg, mnB, alB);
  __syncthreads(); RESC(alB);
  finishSM(pB0, pB1, alB, l_reg, pa0, pa1, pa2, pa3); SBAR();
  pv_one<0, false>(o[0], vb0 + SHM_V, pa0, pa1, pa2, pa3); pv_one<1, false>(o[1], vb0 + SHM_V, pa0, pa1, pa2, pa3);
  if (hi == 0) li_l[r32] = l_reg; asm volatile("s_waitcnt lgkmcnt(0)" ::: "memory");
  bf16* Yw = Y + (rowbase + q0 + wid * QBLK) * ZY_LD + YA + h * 64;
#pragma unroll
  for (int r = 0; r < 16; ++r) { const int orow = crow(r, hi); const float rl = __builtin_amdgcn_rcpf(li_l[orow]);
#pragma unroll
    for (int d0 = 0; d0 < 2; ++d0) { bf16* p = Yw + (size_t)orow * ZY_LD + d0 * 32 + r32; const float g = __uint_as_float((unsigned)*p << 16); *p = (bf16)f2bf(o[d0][r] * rl * g); } }
  __syncthreads();
#undef SLOAD
#undef SWRITE
#undef SWAIT
#undef RESC
#undef MASK
}

__device__ __forceinline__ void glds16(const void* gsrc, unsigned lds_dst) { unsigned keep;
  asm volatile("s_mov_b32 %0, m0\n\ts_mov_b32 m0, %2\n\ts_nop 0\n\tglobal_load_lds_dwordx4 %1, off\n\ts_mov_b32 m0, %0" : "=&s"(keep) : "v"(gsrc), "s"(lds_dst) : "memory"); }
#define WAIT_BAR(N) asm volatile("s_waitcnt vmcnt(" #N ") lgkmcnt(0)\n\ts_barrier" ::: "memory")
template <int ND0> __device__ __forceinline__ void qkt_c(f32x16& p0, f32x16& p1, const f32x16& c, const char* Ks, const bf16x8* qr, int r32, int hi) {
  bf16x8 kf[2 * ND0];
#pragma unroll
  for (int d0 = 0; d0 < ND0; ++d0) { const int cb = (d0 * 16 + hi * 8) * 2;
    kf[2 * d0] = *reinterpret_cast<const bf16x8*>(Ks + KSWZ(r32, cb)); kf[2 * d0 + 1] = *reinterpret_cast<const bf16x8*>(Ks + KSWZ(32 + r32, cb)); }
  SBAR();
#pragma unroll
  for (int d0 = 0; d0 < ND0; ++d0) {
    if (d0 == 0) { p0 = __builtin_amdgcn_mfma_f32_32x32x16_bf16(kf[0], qr[0], c, 0, 0, 0); p1 = __builtin_amdgcn_mfma_f32_32x32x16_bf16(kf[1], qr[0], c, 0, 0, 0); }
    else { p0 = __builtin_amdgcn_mfma_f32_32x32x16_bf16(kf[2 * d0], qr[d0], p0, 0, 0, 0); p1 = __builtin_amdgcn_mfma_f32_32x32x16_bf16(kf[2 * d0 + 1], qr[d0], p1, 0, 0, 0); } }
}
__device__ __forceinline__ void partialSM2(f32x16& p0, f32x16& p1, float& m_reg, f32x16& negm, float& alpha, bool first) {
  float pmax = p0[0];
#pragma unroll
  for (int r = 1; r < 16; ++r) pmax = fmaxf(pmax, p0[r]);
#pragma unroll
  for (int r = 0; r < 16; ++r) pmax = fmaxf(pmax, p1[r]);
  { auto rr = __builtin_amdgcn_permlane32_swap(__float_as_uint(pmax), __float_as_uint(pmax), false, false); pmax = fmaxf(__uint_as_float(rr[0]), __uint_as_float(rr[1])); }
  alpha = 1.f;
  if (__builtin_expect(first || __any(pmax > THR2), 0)) { const float dl = first ? pmax : fmaxf(pmax, 0.f); m_reg += dl; alpha = __builtin_amdgcn_exp2f(-dl);
#pragma unroll
    for (int r = 0; r < 16; ++r) { p0[r] -= dl; p1[r] -= dl; negm[r] = -m_reg; } }
#pragma unroll
  for (int r = 0; r < 16; ++r) p0[r] = __builtin_amdgcn_exp2f(p0[r]);
}

__device__ __forceinline__ void attn_unit2(int b, int h, int qb, const bf16* Q, const bf16* __restrict__ KN, const bf16* __restrict__ KR, const bf16* __restrict__ V, bf16* Y, char* lds) {
  int tid = threadIdx.x; asm volatile("" : "+v"(tid));
  const int wid = __builtin_amdgcn_readfirstlane(tid >> 6), lane = tid & 63, r32 = lane & 31, hi = lane >> 5;
  constexpr int OFF_K = 0, OFF_V = 3 * SHM_K, OFF_WS = 3 * SHM_K + 3 * SHM_V;
  const unsigned lds0 = (unsigned)(uintptr_t)lds;
  float* ws = (float*)(lds + OFF_WS) + wid * 64; float* li_l = ws; float* al_l = ws + 32;
  const size_t rowbase = (size_t)b * SEQ; const int q0 = qb * 256;
  bf16x8 qr[6];
  const bf16* ksrc[2]; bool kval[2];
#pragma unroll
  for (int i = 0; i < 2; ++i) { const int row = 8 * wid + 4 * i + (lane >> 4), gc = (lane & 15) ^ (row & 7); kval[i] = gc < 12;
    ksrc[i] = gc < 8 ? KN + (rowbase + row) * 512 + h * 64 + gc * 8 : KR + (rowbase + row) * 32 + ((gc - 8) & 3) * 8; }
  const int kstr0 = 512 * 64, kstr1 = 32 * 64;
  const bf16* vsrc; { const int kk = 8 * wid + ((lane & 31) >> 2), k = (kk & ~0xC) | ((kk & 4) << 1) | ((kk & 8) >> 1); vsrc = V + (rowbase + k) * 512 + h * 64 + (lane >> 5) * 32 + (lane & 3) * 8; }
  const unsigned kdst = lds0 + OFF_K + wid * 2048, vdst = lds0 + OFF_V + wid * 2048;
#define DMA_K(t, slot) do { _Pragma("unroll") for (int i_ = 0; i_ < 2; ++i_) { const bool isn = ((lane & 15) ^ ((4 * i_ + (lane >> 4)) & 7)) < 8; \
    if (kval[i_]) glds16(ksrc[i_] + (size_t)(t) * (isn ? kstr0 : kstr1), (unsigned)__builtin_amdgcn_readfirstlane(kdst + (slot) * SHM_K + i_ * 1024)); } } while (0)
#define DMA_V(t, slot) glds16(vsrc + (size_t)(t) * (512 * 64), (unsigned)__builtin_amdgcn_readfirstlane(vdst + (slot) * SHM_V))
  const int vb0 = (int)(lds0 + OFF_V) + v_rd_base(lane);
  float m_reg = 0.f; f32x16 o[2] = {}; f32x16 lacc = {}; f32x16 negm = {}; asm volatile("" : "+v"(negm));
  f32x16 pA0, pA1, pB0, pB1; float alA = 1.f, alB = 1.f; bf16x8 pa0, pa1, pa2, pa3;
  const int NT = 4 * qb + 4, NTw = 4 * qb + (wid >> 1) + 1;
#define RESC(a) do { if (__any((a) < 1.f)) { if (hi == 0) al_l[r32] = (a); asm volatile("s_waitcnt lgkmcnt(0)" ::: "memory"); \
    _Pragma("unroll") for (int r = 0; r < 16; ++r) { const float f_ = al_l[crow(r, hi)]; o[0][r] *= f_; o[1][r] *= f_; lacc[r] *= f_; } } } while (0)
  int sk = 0, sv = 2;
#define ROT3(s) ((s) == 2 ? 0 : (s) + 1)
#define STEP(C0, C1, ALC, P0, P1, ALP, t, FIRST) do { \
    const int nk_ = ((t) + 2 < NT) ? 2 : 0, nv_ = ((t) + 1 < NT) ? 1 : 0; \
    if (nk_) DMA_K((t) + 2, (sk == 0 ? 2 : sk - 1)); if (nv_) DMA_V((t) + 1, (sv == 0 ? 2 : sv - 1)); \
    const bool vc_ = (t) < NTw, vp_ = !(FIRST) && ((t) - 1) < NTw; \
    if (vc_) { SBAR(); qkt_c<6>(C0, C1, negm, lds + OFF_K + sk * SHM_K, qr, r32, hi); } \
    if (vp_) { finishSM2(P0, P1, pa0, pa1, pa2, pa3); SBAR(); pv2l(o[0], o[1], lacc, vb0 + sv * SHM_V, pa0, pa1, pa2, pa3); } \
    if (vc_) { partialSM2(C0, C1, m_reg, negm, ALC, (FIRST)); RESC(ALC); } \
    if (nk_ + nv_ == 3) WAIT_BAR(3); else if (nk_ + nv_ == 1) WAIT_BAR(1); else WAIT_BAR(0); \
    sk = ROT3(sk); sv = ROT3(sv); } while (0)
  DMA_K(0, 0); DMA_V(0, 0); DMA_K(1, 1);
  { const bf16* Qw = Q + (rowbase + q0 + wid * QBLK + r32) * 768 + h * 96 + hi * 8;
#pragma unroll
    for (int d0 = 0; d0 < 6; ++d0) qr[d0] = *reinterpret_cast<const bf16x8*>(Qw + d0 * 16);
#pragma unroll
    for (int d0 = 0; d0 < 6; ++d0) asm volatile("" : "+v"(qr[d0])); }
  WAIT_BAR(0);
  STEP(pA0, pA1, alA, pB0, pB1, alB, 0, true);
  for (int t = 1; t + 1 < NT; t += 2) {
    STEP(pB0, pB1, alB, pA0, pA1, alA, t, false);
    STEP(pA0, pA1, alA, pB0, pB1, alB, t + 1, false);
  }
  STEP(pB0, pB1, alB, pA0, pA1, alA, NT - 1, false);
  if (NT - 1 < NTw) { finishSM2(pB0, pB1, pa0, pa1, pa2, pa3); SBAR(); pv2l(o[0], o[1], lacc, vb0 + sv * SHM_V, pa0, pa1, pa2, pa3); }
  asm volatile("s_waitcnt vmcnt(0) lgkmcnt(0)\n\ts_barrier" ::: "memory");
  { char* T = lds + OFF_K + wid * 4608;
    bf16* Yw = Y + (rowbase + q0 + wid * QBLK) * ZY_LD + YA + h * 64;
    typedef unsigned u32x4a __attribute__((ext_vector_type(4)));
    u32x4a gv[4];
#pragma unroll
    for (int i = 0; i < 4; ++i) { const int c = lane + 64 * i; gv[i] = *(const u32x4a*)(Yw + (size_t)(c >> 3) * ZY_LD + (c & 7) * 8); }
#pragma unroll
    for (int r = 0; r < 16; ++r) { const int orow = crow(r, hi); const float rl = __builtin_amdgcn_rcpf(lacc[r]);
#pragma unroll
      for (int d0 = 0; d0 < 2; ++d0) *(bf16*)(T + orow * 144 + (d0 * 32 + r32) * 2) = (bf16)f2bf(o[d0][r] * rl); }
    asm volatile("s_waitcnt lgkmcnt(0)" ::: "memory");
#pragma unroll
    for (int i = 0; i < 4; ++i) { const int c = lane + 64 * i; const u32x4a tv = *(const u32x4a*)(T + (c >> 3) * 144 + (c & 7) * 16); u32x4a ov;
#pragma unroll
      for (int k = 0; k < 4; ++k) { const float lo = __uint_as_float(tv[k] << 16) * __uint_as_float(gv[i][k] << 16), hi2 = __uint_as_float(tv[k] & 0xffff0000u) * __uint_as_float(gv[i][k] & 0xffff0000u);
        ov[k] = (unsigned)f2bf(lo) | ((unsigned)f2bf(hi2) << 16); }
      *(u32x4a*)(Yw + (size_t)(c >> 3) * ZY_LD + (c & 7) * 8) = ov; } }
  asm volatile("s_waitcnt vmcnt(0) lgkmcnt(0)\n\ts_barrier" ::: "memory");
#undef DMA_K
#undef DMA_V
#undef RESC
#undef ROT3
#undef STEP
}
#undef WAIT_BAR
#undef KSWZ
#undef SBAR
}
namespace mls {
using att::bf16x8; using att::s16x4; using att::f32x16; using att::u32x4;
typedef unsigned u32x2g __attribute__((ext_vector_type(2)));
__device__ __forceinline__ float blo(unsigned w) { return __uint_as_float(w << 16); }
__device__ __forceinline__ float bhi(unsigned w) { return __uint_as_float(w & 0xffff0000u); }
constexpr int SHM_V = 16384, SHM_K = 16384, SHM_AP = 256, OFF_ST = 2 * SHM_V + 2 * SHM_K + 2 * SHM_AP + 512  , OFF_NS = OFF_ST + 16384, OFF_MX = OFF_NS + 256, SHM_TOT = OFF_MX + 64;
#define KSWZ(row, colB) ((row) * 256 + ((colB) ^ (((row) & 7) << 4)))
__device__ __forceinline__ void mlstm_unit(int b, int h, int qb, const bf16* __restrict__ ZT, const float* __restrict__ MLS, const float* __restrict__ gmh, const bf16* __restrict__ CK, const float* __restrict__ NK, const float* __restrict__ ML, bf16* Y, char* lds) {
  int tid = threadIdx.x; asm volatile("" : "+v"(tid));
  const int wid = __builtin_amdgcn_readfirstlane(tid >> 6), lane = tid & 63, r32 = lane & 31, hi = lane >> 5;
  char* V_lds = lds; char* K_lds = lds + 2 * SHM_V; float* AP = (float*)(lds + 2 * SHM_V + 2 * SHM_K);
  const size_t rowbase = (size_t)b * SEQ; const int q0 = qb * 256, tq = q0 + wid * 32 + r32; const size_t qrow = rowbase + tq;
  bf16x8 qr[4];
#pragma unroll
  for (int d0 = 0; d0 < 4; ++d0) qr[d0] = *reinterpret_cast<const bf16x8*>(ZT + qrow * ZT_LD + ZT_MQ + h * 64 + d0 * 16 + hi * 8);
  const f32x4 me = *(const f32x4*)(MLS + (qrow * 4 + h) * 4); const float At2 = me.y * 1.4426950409f, mt = me.z;
  const int sr = tid >> 4, sc = (tid & 15) * 8, vst0 = att::v_st(sr, sc), vst1 = att::v_st(32 + sr, sc); const bool doK = sc < 64;
  const bf16* ksrc = ZT + rowbase * ZT_LD + ZT_MK + h * 64 + (sc & 63); const bf16* vsrc = ZT + rowbase * ZT_LD + ZT_MV + h * 128 + sc;
  const int vb0 = (int)(uintptr_t)V_lds + att::v_rd_base(lane);
  bf16x8 vs0, vs1, ks0, ks1; float aps = 0.f;
#define SLOAD(k0) do { vs0 = *(const bf16x8*)(vsrc + (size_t)((k0) + sr) * ZT_LD); vs1 = *(const bf16x8*)(vsrc + (size_t)((k0) + 32 + sr) * ZT_LD); \
    if (doK) { ks0 = *(const bf16x8*)(ksrc + (size_t)((k0) + sr) * ZT_LD); ks1 = *(const bf16x8*)(ksrc + (size_t)((k0) + 32 + sr) * ZT_LD); } \
    if (tid < 64) aps = MLS[((rowbase + (k0) + tid) * 4 + h) * 4] * 1.4426950409f; } while (0)
#define SWRITE(bb) do { *(bf16x8*)(V_lds + (bb) * SHM_V + vst0) = vs0; *(bf16x8*)(V_lds + (bb) * SHM_V + vst1) = vs1; \
    if (doK) { const int kc = sc * 2; *(bf16x8*)(K_lds + (bb) * SHM_K + KSWZ(sr, kc)) = ks0; *(bf16x8*)(K_lds + (bb) * SHM_K + KSWZ(32 + sr, kc)) = ks1; } \
    if (tid < 64) AP[(bb) * 64 + tid] = aps; } while (0)
  f32x16 o[4] = {}; float den = 0.f;
  const int J0 = 4 * qb, NT = 4 * qb + 4, jd = 4 * qb + (wid >> 1);
  SLOAD(J0 * 64);
  if (qb > 0) {
    float* MX = (float*)(lds + OFF_MX); float* NS = (float*)(lds + OFF_NS); const int u0 = (b * 4 + h) * 16;
    if (tid < 16) { float Mj = -INFINITY; if (tid < qb) { float Bst = 0.f; if (tid > 0) { const f32x4 pr = *(const f32x4*)(MLS + ((rowbase + tid * 256 - 1) * 4 + h) * 4); Bst = pr.z - pr.y; } Mj = ML[u0 + tid] - Bst; } MX[tid] = Mj * 1.4426950409f; }
    __syncthreads();
    float Mp = MX[0];
    for (int j = 1; j < qb; ++j) Mp = fmaxf(Mp, MX[j]);
    float c0[8], c1[8]; float ns = 0.f;
#pragma unroll
    for (int e = 0; e < 8; ++e) { c0[e] = 0.f; c1[e] = 0.f; }
    for (int j0 = 0; j0 < qb; j0 += 4) {
      v4u x0[4], x1[4]; float fj[4], nk[4];
#pragma unroll
      for (int d = 0; d < 4; ++d) { const int j = j0 + d; const bool ok = j < qb; const int jj = ok ? j : j0; fj[d] = ok ? __builtin_amdgcn_exp2f(MX[jj] - Mp) : 0.f;
        const bf16* cj = CK + (size_t)(u0 + jj) * 8192 + sc; x0[d] = *(const v4u*)(cj + sr * 128); x1[d] = *(const v4u*)(cj + (32 + sr) * 128); nk[d] = tid < 64 ? NK[(u0 + jj) * 64 + tid] : 0.f; }
#pragma unroll
      for (int d = 0; d < 4; ++d) { const float f = fj[d];
#pragma unroll
        for (int k = 0; k < 4; ++k) { c0[2 * k] += f * blo(x0[d][k]); c0[2 * k + 1] += f * bhi(x0[d][k]); c1[2 * k] += f * blo(x1[d][k]); c1[2 * k + 1] += f * bhi(x1[d][k]); }
        ns += f * nk[d]; } }
    { v4u w0, w1;
#pragma unroll
      for (int k = 0; k < 4; ++k) { w0[k] = pk2(c0[2 * k], c0[2 * k + 1]); w1[k] = pk2(c1[2 * k], c1[2 * k + 1]); }
      *(v4u*)(lds + OFF_ST + vst0) = w0; *(v4u*)(lds + OFF_ST + vst1) = w1; if (tid < 64) NS[tid] = ns; }
    __syncthreads();
    const float ft = __builtin_amdgcn_exp2f(Mp - At2); bf16x8 qs[4]; float dn = 0.f;
#pragma unroll
    for (int d0 = 0; d0 < 4; ++d0) { const u32x4 qw = __builtin_bit_cast(u32x4, qr[d0]); u32x4 sw; const f32x4 n0 = *(const f32x4*)(NS + 16 * d0 + 8 * hi), n1 = *(const f32x4*)(NS + 16 * d0 + 8 * hi + 4);
      const float nn[8] = {n0[0], n0[1], n0[2], n0[3], n1[0], n1[1], n1[2], n1[3]};
#pragma unroll
      for (int k = 0; k < 4; ++k) { const float a = blo(qw[k]), c = bhi(qw[k]); dn += a * nn[2 * k] + c * nn[2 * k + 1]; sw[k] = pk2(ft * a, ft * c); }
      qs[d0] = __builtin_bit_cast(bf16x8, sw); }
    den += ft * dn;
    const int vbs = (int)(uintptr_t)(lds + OFF_ST) + att::v_rd_base(lane);
    att::pv_one<0, true>(o[0], vbs, qs[0], qs[1], qs[2], qs[3]); att::pv_one<1, true>(o[1], vbs, qs[0], qs[1], qs[2], qs[3]);
    att::pv_one<2, true>(o[2], vbs, qs[0], qs[1], qs[2], qs[3]); att::pv_one<3, true>(o[3], vbs, qs[0], qs[1], qs[2], qs[3]);
  }
  SWRITE(J0 & 1); __syncthreads();
  for (int j = J0; j < NT; ++j) { const int bb = j & 1;
    if (j + 1 < NT) SLOAD((j + 1) * 64);
    if (j <= jd) {
      f32x16 p0, p1; att::qkt<4>(p0, p1, K_lds + bb * SHM_K, qr, r32, hi);
      const float* ap = AP + bb * 64;
#pragma unroll
      for (int g = 0; g < 4; ++g) { const f32x4 a0 = *(const f32x4*)(ap + 8 * g + 4 * hi), a1 = *(const f32x4*)(ap + 32 + 8 * g + 4 * hi);
#pragma unroll
        for (int e = 0; e < 4; ++e) { p0[4 * g + e] *= __builtin_amdgcn_exp2f(a0[e] - At2); p1[4 * g + e] *= __builtin_amdgcn_exp2f(a1[e] - At2); } }
      if (j == jd) { const int kb = 64 * j + 4 * hi;
#pragma unroll
        for (int r = 0; r < 16; ++r) { const int kv = kb + (r & 3) + 8 * (r >> 2); if (kv > tq) p0[r] = 0.f; if (kv + 32 > tq) p1[r] = 0.f; } }
      float ps = 0.f;
#pragma unroll
      for (int r = 0; r < 16; ++r) ps += p0[r] + p1[r];
      den += ps;
      bf16x8 pa0, pa1, pa2, pa3;
#define PK4(P, BASE, OUT) do { unsigned a0_ = att::cvtpk(P[BASE + 0], P[BASE + 1]), a1_ = att::cvtpk(P[BASE + 2], P[BASE + 3]);   \
    unsigned b0_ = att::cvtpk(P[BASE + 4], P[BASE + 5]), b1_ = att::cvtpk(P[BASE + 6], P[BASE + 7]);                              \
    auto r0 = __builtin_amdgcn_permlane32_swap(a0_, b0_, false, false); auto r1 = __builtin_amdgcn_permlane32_swap(a1_, b1_, false, false); \
    u32x4 w = {r0[0], r1[0], r0[1], r1[1]}; OUT = __builtin_bit_cast(bf16x8, w); } while (0)
      PK4(p0, 0, pa0); PK4(p0, 8, pa1); PK4(p1, 0, pa2); PK4(p1, 8, pa3);
#undef PK4
      const int vb = vb0 + bb * SHM_V;
      att::pv_one<0, true>(o[0], vb, pa0, pa1, pa2, pa3); att::pv_one<1, true>(o[1], vb, pa0, pa1, pa2, pa3);
      att::pv_one<2, true>(o[2], vb, pa0, pa1, pa2, pa3); att::pv_one<3, true>(o[3], vb, pa0, pa1, pa2, pa3);
    }
    if (j + 1 < NT) SWRITE(bb ^ 1);
    __syncthreads();
  }
  { auto rr = __builtin_amdgcn_permlane32_swap(__float_as_uint(den), __float_as_uint(den), false, false); den = __uint_as_float(rr[0]) + __uint_as_float(rr[1]); }
  const float rd = __builtin_amdgcn_rcpf(fmaxf(fabsf(den), __builtin_amdgcn_exp2f(-mt * 1.4426950409f)));
  float ss = 0.f;
#pragma unroll
  for (int d = 0; d < 4; ++d)
#pragma unroll
    for (int r = 0; r < 16; ++r) ss += o[d][r] * o[d][r];
  { auto rr = __builtin_amdgcn_permlane32_swap(__float_as_uint(ss), __float_as_uint(ss), false, false); ss = __uint_as_float(rr[0]) + __uint_as_float(rr[1]); }
  const float rn = rd * __builtin_amdgcn_rsqf(rd * rd * ss * (1.f / 128.f) + RMS_EPS);
  { const float* gm = gmh + h * 128; char* T = lds + wid * 8704;
    bf16* yw = Y + (rowbase + q0 + wid * 32) * ZY_LD + YB + h * 128;
    typedef unsigned u32x4m __attribute__((ext_vector_type(4)));
    u32x4m og[8];
#pragma unroll
    for (int i = 0; i < 8; ++i) { const int c = lane + 64 * i; og[i] = *(const u32x4m*)(yw + (size_t)(c >> 4) * ZY_LD + (c & 15) * 8); }
#pragma unroll
    for (int d = 0; d < 4; ++d)
#pragma unroll
      for (int g = 0; g < 4; ++g) { const int c = 32 * d + 8 * g + 4 * hi; const f32x4 gv = *(const f32x4*)(gm + c); u32x2g w;
        w.x = pk2(o[d][4 * g] * rn * gv[0], o[d][4 * g + 1] * rn * gv[1]); w.y = pk2(o[d][4 * g + 2] * rn * gv[2], o[d][4 * g + 3] * rn * gv[3]);
        *(u32x2g*)(T + r32 * 272 + c * 2) = w; }
    asm volatile("s_waitcnt lgkmcnt(0)" ::: "memory");
#pragma unroll
    for (int i = 0; i < 8; ++i) { const int c = lane + 64 * i; const u32x4m tv = *(const u32x4m*)(T + (c >> 4) * 272 + (c & 15) * 16); u32x4m ov;
#pragma unroll
      for (int k = 0; k < 4; ++k) ov[k] = pk2(blo(tv[k]) * blo(og[i][k]), bhi(tv[k]) * bhi(og[i][k]));
      *(u32x4m*)(yw + (size_t)(c >> 4) * ZY_LD + (c & 15) * 8) = ov; } }
  __syncthreads();
#undef SLOAD
#undef SWRITE
}

__device__ __forceinline__ void mlstm_summary(int u, int h, size_t r0, const bf16* __restrict__ ZT, const float* __restrict__ GIF, float fb, bf16* CK, float* NK, float* ML, char* lds) {
  int tid = threadIdx.x; asm volatile("" : "+v"(tid));
  const int wid = __builtin_amdgcn_readfirstlane(tid >> 6), lane = tid & 63, r32 = lane & 31, hi = lane >> 5;
  char* Kt = lds; char* Vt = lds + 16384; float* WL = (float*)(lds + 32768); float* RED = (float*)(lds + 32768 + 1024); float* NKP = (float*)(lds + 32768 + 2048);
  float lf = 0.f, ai = 0.f; if (tid < 256) { const float f = GIF[(r0 + tid) * 8 + 4 + h] + fb; lf = fminf(f, 0.f) - 0.69314718056f * __builtin_amdgcn_logf(1.f + __builtin_amdgcn_exp2f(-1.4426950409f * fabsf(f))); ai = GIF[(r0 + tid) * 8 + h]; }
  float incl = lf;
#pragma unroll
  for (int o = 1; o < 64; o <<= 1) { const float t = __int_as_float(__builtin_amdgcn_ds_bpermute(((lane - o) & 63) << 2, __float_as_int(incl))); if (lane >= o) incl += t; }
  if (lane == 63) RED[wid] = incl;
  __syncthreads();
  float B = incl;
#pragma unroll
  for (int w = 0; w < 4; ++w) if (w < wid) B += RED[w];
  float a = tid < 256 ? ai - B : -INFINITY, mx = a;
  mx = fmaxf(mx, __int_as_float(__builtin_amdgcn_ds_swizzle(__float_as_int(mx), (1 << 10) | 0x1f))); mx = fmaxf(mx, __int_as_float(__builtin_amdgcn_ds_swizzle(__float_as_int(mx), (2 << 10) | 0x1f)));
  mx = fmaxf(mx, __int_as_float(__builtin_amdgcn_ds_swizzle(__float_as_int(mx), (4 << 10) | 0x1f))); mx = fmaxf(mx, __int_as_float(__builtin_amdgcn_ds_swizzle(__float_as_int(mx), (8 << 10) | 0x1f)));
  mx = fmaxf(mx, __int_as_float(__builtin_amdgcn_ds_swizzle(__float_as_int(mx), (16 << 10) | 0x1f)));
  { auto rr = __builtin_amdgcn_permlane32_swap(__float_as_uint(mx), __float_as_uint(mx), false, false); mx = fmaxf(__uint_as_float(rr[0]), __uint_as_float(rr[1])); }
  if (lane == 0) RED[8 + wid] = mx;
  __syncthreads();
  const float Mloc = fmaxf(fmaxf(RED[8], RED[9]), fmaxf(RED[10], RED[11]));
  if (tid < 256) WL[tid] = __builtin_amdgcn_exp2f((a - Mloc) * 1.4426950409f);
  __syncthreads();
  const int sr = tid >> 4, sc = (tid & 15) * 8, vst0 = att::v_st(sr, sc), vst1 = att::v_st(32 + sr, sc); const bool doK = sc < 64;
  const int ab = wid & 1, db = wid >> 1;
  const int vbk = (int)(uintptr_t)Kt + att::v_rd_base(lane) + ab * 512, vbv = (int)(uintptr_t)Vt + att::v_rd_base(lane) + db * 512;
  f32x16 acc = {}; float nk8[8];
#pragma unroll
  for (int e = 0; e < 8; ++e) nk8[e] = 0.f;
  v4u vs0, vs1, x0 = {0u, 0u, 0u, 0u}, x1 = {0u, 0u, 0u, 0u};
#define MS_LOAD(st_) do { const size_t ra_ = r0 + (st_) * 64 + sr, rb_ = ra_ + 32; vs0 = *(const v4u*)(ZT + ra_ * ZT_LD + ZT_MV + h * 128 + sc); vs1 = *(const v4u*)(ZT + rb_ * ZT_LD + ZT_MV + h * 128 + sc); \
    if (doK) { x0 = *(const v4u*)(ZT + ra_ * ZT_LD + ZT_MK + h * 64 + sc); x1 = *(const v4u*)(ZT + rb_ * ZT_LD + ZT_MK + h * 64 + sc); } } while (0)
  MS_LOAD(0);
  for (int st = 0; st < 4; ++st) { v4u k0 = {0u, 0u, 0u, 0u}, k1 = {0u, 0u, 0u, 0u}; const v4u w0v = vs0, w1v = vs1;
    if (doK) { const float w0 = WL[st * 64 + sr], w1 = WL[st * 64 + 32 + sr];
#pragma unroll
      for (int k = 0; k < 4; ++k) { const float a0 = w0 * blo(x0[k]), b0 = w0 * bhi(x0[k]), a1 = w1 * blo(x1[k]), b1 = w1 * bhi(x1[k]); nk8[2 * k] += a0 + a1; nk8[2 * k + 1] += b0 + b1; k0[k] = pk2(a0, b0); k1[k] = pk2(a1, b1); } }
    if (st > 0) __syncthreads();
    *(v4u*)(Vt + vst0) = w0v; *(v4u*)(Vt + vst1) = w1v; if (doK) { *(v4u*)(Kt + vst0) = k0; *(v4u*)(Kt + vst1) = k1; }
    if (st + 1 < 4) MS_LOAD(st + 1);
    __syncthreads();
    att::pv_kv(acc, vbk, vbv); }
#undef MS_LOAD
  if (doK) { *(f32x4*)(NKP + sr * 64 + sc) = (f32x4){nk8[0], nk8[1], nk8[2], nk8[3]}; *(f32x4*)(NKP + sr * 64 + sc + 4) = (f32x4){nk8[4], nk8[5], nk8[6], nk8[7]}; }
  __syncthreads();
  bf16* ck = CK + (size_t)u * 8192 + (ab * 32) * 128 + db * 32 + r32;
#pragma unroll
  for (int r = 0; r < 16; ++r) ck[att::crow(r, hi) * 128] = (bf16)f2bf(acc[r]);
  if (tid < 64) { float s = 0.f;
#pragma unroll 8
    for (int q = 0; q < 32; ++q) s += NKP[q * 64 + tid];
    NK[u * 64 + tid] = s; }
  if (tid == 0) ML[u] = Mloc;
  __syncthreads();
}
#undef KSWZ
}
namespace sgu {
using att::bf16x8; using att::f32x16;
typedef float f32x2s __attribute__((ext_vector_type(2)));
typedef unsigned u32x2s __attribute__((ext_vector_type(2)));
__device__ __forceinline__ float blo(unsigned w) { return __uint_as_float(w << 16); }
__device__ __forceinline__ float bhi(unsigned w) { return __uint_as_float(w & 0xffff0000u); }
__device__ __forceinline__ void sgu_unit(int bn, int g, const bf16* __restrict__ ZT, const float* __restrict__ PVS, const bf16* __restrict__ WS, const float* __restrict__ gsv, const float* __restrict__ bs, bf16* Y, char* lds) {
  int tid = threadIdx.x; asm volatile("" : "+v"(tid));
  const int wid = __builtin_amdgcn_readfirstlane(tid >> 6), lane = tid & 63, r32 = lane & 31, hi = lane >> 5;
  char* V_lds = lds; f32x2s* st = (f32x2s*)(lds + 32768);
  const size_t base = (size_t)bn * 128;
  const int sr = tid >> 4, sc = (tid & 15) * 8;
  const int tb = wid & 3, ch = wid >> 2, t = 32 * tb + r32;
  v4u xv[4];
#pragma unroll
  for (int q = 0; q < 4; ++q) xv[q] = __builtin_nontemporal_load((const v4u*)(ZT + (base + 32 * q + sr) * ZT_LD + ZT_V + g * 128 + sc));
  f32x2s pp[8];
  if (tid < 128) {
#pragma unroll
    for (int k = 0; k < 8; ++k) pp[k] = *(const f32x2s*)(PVS + ((base + tid) * 8 + k) * 2); }
  bf16* yw = Y + (base + 32 * tb) * ZY_LD + YD + g * 128 + 64 * ch;
  v4u ugv[4];
#pragma unroll
  for (int i = 0; i < 4; ++i) { const int c = lane + 64 * i; ugv[i] = *(const v4u*)(yw + (size_t)(c >> 3) * ZY_LD + (c & 7) * 8); }
  if (tid < 128) { float s1 = 0.f, s2 = 0.f;
#pragma unroll
    for (int k = 0; k < 8; ++k) { s1 += pp[k].x; s2 += pp[k].y; }
    const float mean = s1 * (1.f / 512.f), var = fmaxf(s2 * (1.f / 512.f) - mean * mean, 0.f); f32x2s o; o.x = mean; o.y = __builtin_amdgcn_rsqf(var + RMS_EPS); st[tid] = o; }
  __syncthreads();
#pragma unroll
  for (int q = 0; q < 4; ++q) { const int s = 32 * q + sr; const f32x2s ms = st[s]; const v4u x = xv[q]; v4u w;
#pragma unroll
    for (int k = 0; k < 4; ++k) w[k] = pk2((blo(x[k]) - ms.x) * ms.y, (bhi(x[k]) - ms.x) * ms.y);
    *(v4u*)(V_lds + (q >> 1) * 16384 + att::v_st(32 * (q & 1) + sr, sc)) = w; }
  __syncthreads();
  f32x16 o[2] = {};
  const bf16* wrow = WS + ((size_t)g * 128 + t) * 128 + hi * 8;
  const int vb = (int)(uintptr_t)V_lds + att::v_rd_base(lane);
#pragma unroll
  for (int st_ = 0; st_ < 2; ++st_) { if (st_ == 1 && tb < 2) break;
    const bf16x8 pa0 = *(const bf16x8*)(wrow + 64 * st_), pa1 = *(const bf16x8*)(wrow + 64 * st_ + 16), pa2 = *(const bf16x8*)(wrow + 64 * st_ + 32), pa3 = *(const bf16x8*)(wrow + 64 * st_ + 48);
    if (ch == 0) { att::pv_one<0, true>(o[0], vb + st_ * 16384, pa0, pa1, pa2, pa3); att::pv_one<1, true>(o[1], vb + st_ * 16384, pa0, pa1, pa2, pa3); }
    else         { att::pv_one<2, true>(o[0], vb + st_ * 16384, pa0, pa1, pa2, pa3); att::pv_one<3, true>(o[1], vb + st_ * 16384, pa0, pa1, pa2, pa3); } }
  const float bt = bs[g * 128 + t]; const float* gp = gsv + g * 128 + 64 * ch;
  char* T = lds + 34816 + wid * 4608;
#pragma unroll
  for (int d = 0; d < 2; ++d)
#pragma unroll
    for (int q = 0; q < 4; ++q) { const int c = 32 * d + 8 * q + 4 * hi; const f32x4 gv = *(const f32x4*)(gp + c); u32x2s w;
      w.x = pk2(o[d][4 * q] * gv[0] + bt, o[d][4 * q + 1] * gv[1] + bt); w.y = pk2(o[d][4 * q + 2] * gv[2] + bt, o[d][4 * q + 3] * gv[3] + bt);
      *(u32x2s*)(T + r32 * 144 + c * 2) = w; }
  asm volatile("s_waitcnt lgkmcnt(0)" ::: "memory");
#pragma unroll
  for (int i = 0; i < 4; ++i) { const int c = lane + 64 * i; const v4u tv = *(const v4u*)(T + (c >> 3) * 144 + (c & 7) * 16); v4u ov;
#pragma unroll
    for (int k = 0; k < 4; ++k) ov[k] = pk2(blo(tv[k]) * blo(ugv[i][k]), bhi(tv[k]) * bhi(ugv[i][k]));
    *(v4u*)(yw + (size_t)(c >> 3) * ZY_LD + (c & 7) * 8) = ov; }
  __syncthreads();
}
}

typedef float f32x2g __attribute__((ext_vector_type(2)));
typedef unsigned u32x2g __attribute__((ext_vector_type(2)));
__device__ __forceinline__ float fexp2g(float x) { return __builtin_amdgcn_exp2f(x); }
struct Args { const void* in[23]; float* out; unsigned char* ws; int ph_lo, ph_hi; };
struct Frame {
    LAS unsigned char* lds; volatile LAS unsigned* MISC; gu32* ctl; unsigned char* ws;
    int tid, lane, wave, G, gw, NGW;
};
#define WSP(T, off) ((T*)(F.ws + (off)))

template <int X> __device__ __forceinline__ float swz_xor(float v) { return __int_as_float(__builtin_amdgcn_ds_swizzle(__float_as_int(v), (X << 10) | 0x1f)); }
__device__ __forceinline__ float sum_xor32(float v) { auto r = __builtin_amdgcn_permlane32_swap(__float_as_uint(v), __float_as_uint(v), false, false); return __uint_as_float(r[0]) + __uint_as_float(r[1]); }
__device__ __forceinline__ float wave_sum(float v) { v += swz_xor<1>(v); v += swz_xor<2>(v); v += swz_xor<4>(v); v += swz_xor<8>(v); v += swz_xor<16>(v); return sum_xor32(v); }
__device__ __forceinline__ float lane_up(float v, int lane, int o) { return __int_as_float(__builtin_amdgcn_ds_bpermute(((lane - o) & 63) << 2, __float_as_int(v))); }
__device__ __forceinline__ float bf2f(bf16 h) { return __uint_as_float((unsigned)h << 16); }
__device__ __forceinline__ float blo(unsigned w) { return __uint_as_float(w << 16); }
__device__ __forceinline__ float bhi(unsigned w) { return __uint_as_float(w & 0xffff0000u); }

template <int MAP> __device__ __forceinline__ void cvt_item(const float* W, int K, int Nsrc, const float* kscale, bf16* WT, LAS float* scr, int item, int nblk, int lane, int ldk = 0) {
    if (ldk == 0) ldk = K;
    const int kb = item / nblk, nb = item % nblk, k0 = 64 * kb, n0 = 32 * nb;
    float cs = 1.f; int sc; const int vc = n0 + 4 * (lane & 7);
    if (MAP == 0) sc = vc; else if (MAP == 1) sc = map_in(vc, cs); else if (MAP == 2) { sc = map_q(vc); cs = QSCALE; } else sc = map_kv(vc);
#pragma unroll
    for (int i = 0; i < 8; ++i) { const int kk = 8 * i + (lane >> 3); f32x4 v = {0.f, 0.f, 0.f, 0.f};
        if (sc >= 0) { v = __builtin_nontemporal_load((const GAS f32x4*)(W + (size_t)(k0 + kk) * Nsrc + sc)); float s = cs; if (kscale) s *= kscale[k0 + kk]; v = v * s; }
        LAS float* d = scr + kk * 33 + 4 * (lane & 7); d[0] = v.x; d[1] = v.y; d[2] = v.z; d[3] = v.w; }
    LDS_WAIT(); asm volatile("" ::: "memory");
    const int c = lane & 7;
#pragma unroll
    for (int j = 0; j < 4; ++j) { const int n = (lane >> 3) + 8 * j; const LAS float* s = scr + (8 * c) * 33 + n;
        v4u o; o.x = pk2(s[0 * 33], s[1 * 33]); o.y = pk2(s[2 * 33], s[3 * 33]); o.z = pk2(s[4 * 33], s[5 * 33]); o.w = pk2(s[6 * 33], s[7 * 33]);
        *(GAS v4u*)(WT + (size_t)(n0 + n) * ldk + k0 + 8 * c) = o; }
    LDS_WAIT(); asm volatile("" ::: "memory");
}
__device__ __forceinline__ void p0_weights_part(Frame& F, const Args& A, int l, int part, int w0, int nw) {
    LAS float* scr = (LAS float*)(F.lds + RING_OFF + F.wave * 16384);
    constexpr int I_UQ = 4 * 24, I_UKV = 2 * 32, I_P = 8 * 32, I_O = 16 * 32;
    if (part == 0) {
        for (int it = w0; it < I_UQ + I_UKV; it += nw) { int r = it;
            if (r < I_UQ) { cvt_item<2>(((const float*)A.in[9]) + (size_t)l * 256 * 768, 256, 768, ((const float*)A.in[7]) + l * 256, WSP(bf16, WS_WB + WB_UQ), scr, r, 24, F.lane); continue; } r -= I_UQ;
            cvt_item<3>(((const float*)A.in[10]) + (size_t)l * 128 * 1024, 128, 1024, ((const float*)A.in[8]) + l * 128, WSP(bf16, WS_WB + WB_UKV), scr, r, 32, F.lane); }
        const float* wsrc = ((const float*)A.in[16]) + (size_t)l * 65536; bf16* wd = WSP(bf16, WS_WB + WB_S);
        for (int i = w0 * 64 + F.lane; i < 65536; i += nw * 64) { const int t = (i >> 7) & 127, s = i & 127; wd[i] = (bf16)f2bf(s <= t ? wsrc[i] : 0.f); }
    } else {
        for (int it = w0; it < 4 * I_P + I_O; it += nw) { int r = it;
            if (r < 4 * I_P) { const int i = r / I_P; const float* wp = (const float*)A.in[18 + i]; cvt_item<0>(wp + (size_t)l * 512 * 1024, 512, 1024, nullptr, WSP(bf16, WS_WB + WB_P) + (size_t)(i >> 1) * 1024 * 1024 + (i & 1) * 512, scr, r % I_P, 32, F.lane, 1024); continue; } r -= 4 * I_P;
            cvt_item<0>(((const float*)A.in[22]) + (size_t)l * 1024 * 1024, 1024, 1024, nullptr, WSP(bf16, WS_WOUT), scr, r, 32, F.lane); }
    }
}
__device__ __forceinline__ void p0_weights(Frame& F, const Args& A, int l) {
    p0_weights_part(F, A, l, 0, F.gw, F.NGW);
    if (F.G != 256) p0_weights_part(F, A, l, 1, F.gw, F.NGW);
}
__device__ __forceinline__ void p2_wlate(Frame& F, const Args& A, int l) {
    if (F.G != 256 || blockIdx.x < 128) return;
    p0_weights_part(F, A, l, 1, ((int)blockIdx.x - 128) * NWAVES + F.wave, 128 * NWAVES);
    __syncthreads();
}
__device__ __forceinline__ float max_xor32(float v) { auto r = __builtin_amdgcn_permlane32_swap(__float_as_uint(v), __float_as_uint(v), false, false); return fmaxf(__uint_as_float(r[0]), __uint_as_float(r[1])); }
__device__ __forceinline__ float wave_max(float v) { v = fmaxf(v, swz_xor<1>(v)); v = fmaxf(v, swz_xor<2>(v)); v = fmaxf(v, swz_xor<4>(v)); v = fmaxf(v, swz_xor<8>(v)); v = fmaxf(v, swz_xor<16>(v)); return max_xor32(v); }
__device__ __forceinline__ unsigned pk4_i8(float a, float b, float c, float d) {
    const int ia = (int)__builtin_rintf(a), ib = (int)__builtin_rintf(b), ic = (int)__builtin_rintf(c), id = (int)__builtin_rintf(d);
    return ((unsigned)ia & 0xffu) | (((unsigned)ib & 0xffu) << 8) | (((unsigned)ic & 0xffu) << 16) | ((unsigned)id << 24); }
template <int MAP, int KI, int ROT> __device__ __forceinline__ void quant_cols(Frame& F, const float* W, int Nsrc, int nitems, unsigned char* dst, float* cdq) {
    LAS float* red = (LAS float*)(F.lds + RING_OFF);
    for (int it = blockIdx.x; it < nitems; it += F.G) {
        const int cg = F.tid & 7, n0 = it * 32 + 4 * cg, kg = F.tid >> 3, k0 = kg * 16; float cs = 1.f; const int sc = MAP == 1 ? map_in(n0, cs) : n0;
        const bool q8 = k0 < KI;
        f32x4 v[16]; f32x4 mx = {0.f, 0.f, 0.f, 0.f};
#pragma unroll
        for (int i = 0; i < 16; ++i) { v[i] = sc >= 0 ? __builtin_nontemporal_load((const GAS f32x4*)(W + (size_t)(k0 + i) * Nsrc + sc)) : (f32x4){0.f, 0.f, 0.f, 0.f};
            if (q8) { mx.x = fmaxf(mx.x, fabsf(v[i].x)); mx.y = fmaxf(mx.y, fabsf(v[i].y)); mx.z = fmaxf(mx.z, fabsf(v[i].z)); mx.w = fmaxf(mx.w, fabsf(v[i].w)); } }
#pragma unroll
        for (int c = 0; c < 4; ++c) { float t = mx[c]; t = fmaxf(t, swz_xor<8>(t)); t = fmaxf(t, swz_xor<16>(t)); mx[c] = max_xor32(t); }
        __syncthreads();
        if (F.lane < 8) { LAS float* d = red + F.wave * 32 + 4 * F.lane; d[0] = mx.x; d[1] = mx.y; d[2] = mx.z; d[3] = mx.w; }
        __syncthreads();
        f32x4 cm = {0.f, 0.f, 0.f, 0.f};
#pragma unroll
        for (int w = 0; w < 8; ++w) { const LAS float* s = red + w * 32 + 4 * cg; cm.x = fmaxf(cm.x, s[0]); cm.y = fmaxf(cm.y, s[1]); cm.z = fmaxf(cm.z, s[2]); cm.w = fmaxf(cm.w, s[3]); }
#pragma unroll
        for (int c = 0; c < 4; ++c) { unsigned char* drow = dst + (size_t)(n0 + c) * 2048;
            if (q8) { const float s = cm[c] > 0.f ? 127.f / cm[c] : 0.f; v4u o;
                o.x = pk4_i8(v[0][c] * s, v[1][c] * s, v[2][c] * s, v[3][c] * s); o.y = pk4_i8(v[4][c] * s, v[5][c] * s, v[6][c] * s, v[7][c] * s);
                o.z = pk4_i8(v[8][c] * s, v[9][c] * s, v[10][c] * s, v[11][c] * s); o.w = pk4_i8(v[12][c] * s, v[13][c] * s, v[14][c] * s, v[15][c] * s);
                *(GAS v4u*)(drow + ((k0 + ROT) & 1023)) = o;
                if (kg == 0) cdq[n0 + c] = cs * cm[c] * (1.f / 127.f); }
            else { v4u o0, o1; o0.x = pk2(v[0][c] * cs, v[1][c] * cs); o0.y = pk2(v[2][c] * cs, v[3][c] * cs); o0.z = pk2(v[4][c] * cs, v[5][c] * cs); o0.w = pk2(v[6][c] * cs, v[7][c] * cs);
                o1.x = pk2(v[8][c] * cs, v[9][c] * cs); o1.y = pk2(v[10][c] * cs, v[11][c] * cs); o1.z = pk2(v[12][c] * cs, v[13][c] * cs); o1.w = pk2(v[14][c] * cs, v[15][c] * cs);
                GAS v4u* d2 = (GAS v4u*)(drow + KI + 2 * (k0 - KI)); d2[0] = o0; d2[1] = o1; } }
    }
    __syncthreads();
}
struct QItem { const float* W; int Nsrc, n0, sc, KI, ROT; float cs; unsigned char* dst; float* cdq; };
constexpr int Q_NITEMS = NV_IN / 32 + 4096 / 32;
template <int KI8> __device__ __forceinline__ QItem q_item(Frame& F, const Args& A, int l, int it) {
    QItem q; const int cg = F.tid & 7; q.cs = 1.f;
    if (it < NV_IN / 32) { q.W = ((const float*)A.in[4]) + (size_t)l * 1024 * IN_DIM; q.Nsrc = IN_DIM; q.n0 = it * 32 + 4 * cg; q.sc = map_in(q.n0, q.cs); q.KI = KI8; q.ROT = 0; q.dst = WSP(unsigned char, WS_WB + WB_IN); q.cdq = WSP(float, WS_CDQI); }
    else { q.W = ((const float*)A.in[5]) + (size_t)l * 1024 * 4096; q.Nsrc = 4096; q.n0 = (it - NV_IN / 32) * 32 + 4 * cg; q.sc = q.n0; q.KI = 1024; q.ROT = 1024 - KI8; q.dst = WSP(unsigned char, WS_WB + WB_GATE); q.cdq = WSP(float, WS_CDQ); }
    return q;
}
__device__ __forceinline__ void q_load(Frame& F, const QItem& q, f32x4 (&v)[16]) {
    const int k0 = (F.tid >> 3) * 16;
#pragma unroll
    for (int i = 0; i < 16; ++i) v[i] = q.sc >= 0 ? __builtin_nontemporal_load((const GAS f32x4*)(q.W + (size_t)(k0 + i) * q.Nsrc + q.sc)) : (f32x4){0.f, 0.f, 0.f, 0.f};
}
__device__ __forceinline__ void q_finish(Frame& F, const QItem& q, f32x4 (&v)[16]) {
    LAS float* red = (LAS float*)(F.lds + RING_OFF);
    const int cg = F.tid & 7, kg = F.tid >> 3, k0 = kg * 16; const bool q8 = k0 < q.KI;
    f32x4 mx = {0.f, 0.f, 0.f, 0.f};
    if (q8) {
#pragma unroll
        for (int i = 0; i < 16; ++i) { mx.x = fmaxf(mx.x, fabsf(v[i].x)); mx.y = fmaxf(mx.y, fabsf(v[i].y)); mx.z = fmaxf(mx.z, fabsf(v[i].z)); mx.w = fmaxf(mx.w, fabsf(v[i].w)); } }
#pragma unroll
    for (int c = 0; c < 4; ++c) { float t = mx[c]; t = fmaxf(t, swz_xor<8>(t)); t = fmaxf(t, swz_xor<16>(t)); mx[c] = max_xor32(t); }
    __syncthreads();
    if (F.lane < 8) { LAS float* d = red + F.wave * 32 + 4 * F.lane; d[0] = mx.x; d[1] = mx.y; d[2] = mx.z; d[3] = mx.w; }
    __syncthreads();
    f32x4 cm = {0.f, 0.f, 0.f, 0.f};
#pragma unroll
    for (int w = 0; w < 8; ++w) { const LAS float* s = red + w * 32 + 4 * cg; cm.x = fmaxf(cm.x, s[0]); cm.y = fmaxf(cm.y, s[1]); cm.z = fmaxf(cm.z, s[2]); cm.w = fmaxf(cm.w, s[3]); }
#pragma unroll
    for (int c = 0; c < 4; ++c) { unsigned char* drow = q.dst + (size_t)(q.n0 + c) * 2048; const float cs = q.cs;
        if (q8) { const float s = cm[c] > 0.f ? 127.f / cm[c] : 0.f; v4u o;
            o.x = pk4_i8(v[0][c] * s, v[1][c] * s, v[2][c] * s, v[3][c] * s); o.y = pk4_i8(v[4][c] * s, v[5][c] * s, v[6][c] * s, v[7][c] * s);
            o.z = pk4_i8(v[8][c] * s, v[9][c] * s, v[10][c] * s, v[11][c] * s); o.w = pk4_i8(v[12][c] * s, v[13][c] * s, v[14][c] * s, v[15][c] * s);
            *(GAS v4u*)(drow + ((k0 + q.ROT) & 1023)) = o;
            if (kg == 0) q.cdq[q.n0 + c] = cs * cm[c] * (1.f / 127.f); }
        else { v4u o0, o1; o0.x = pk2(v[0][c] * cs, v[1][c] * cs); o0.y = pk2(v[2][c] * cs, v[3][c] * cs); o0.z = pk2(v[4][c] * cs, v[5][c] * cs); o0.w = pk2(v[6][c] * cs, v[7][c] * cs);
            o1.x = pk2(v[8][c] * cs, v[9][c] * cs); o1.y = pk2(v[10][c] * cs, v[11][c] * cs); o1.z = pk2(v[12][c] * cs, v[13][c] * cs); o1.w = pk2(v[14][c] * cs, v[15][c] * cs);
            GAS v4u* d2 = (GAS v4u*)(drow + q.KI + 2 * (k0 - q.KI)); d2[0] = o0; d2[1] = o1; } }
}
template <int KI8> __device__ __forceinline__ void p0_rows(Frame& F, const Args& A, int stage) {
    const float* xsrc = stage == 2 ? A.out : ((const float*)A.in[0]);
    f32x4 gpo[4], gpr[4];
#pragma unroll
    for (int j = 0; j < 4; ++j) { gpo[j] = stage >= 1 ? *((const GAS f32x4*)(((const float*)A.in[3]) + (stage - 1) * D) + F.lane + 64 * j) : (f32x4){0.f, 0.f, 0.f, 0.f};
        gpr[j] = stage < 2 ? *((const GAS f32x4*)(((const float*)A.in[2]) + stage * D) + F.lane + 64 * j) : (f32x4){0.f, 0.f, 0.f, 0.f}; }
    f32x4 v[4], vn[4]; u32x2g mo[4], mon[4]; float po = 0.f, pon = 0.f;
#define ROW_LOAD(V, MO, PO, m_) do { if (stage == 2) { _Pragma("unroll") for (int j = 0; j < 4; ++j) { const u32x2g xb_ = __builtin_nontemporal_load((const GAS u32x2g*)((const char*)A.out + (size_t)(m_) * 4096) + F.lane + 64 * j); V[j].x = __uint_as_float(xb_.x); V[j].y = __uint_as_float(xb_.y); } } \
        else { _Pragma("unroll") for (int j = 0; j < 4; ++j) V[j] = __builtin_nontemporal_load((const GAS f32x4*)(xsrc + (size_t)(m_) * D) + F.lane + 64 * j); } \
        if (stage >= 1) { _Pragma("unroll") for (int j = 0; j < 4; ++j) MO[j] = __builtin_nontemporal_load((const GAS u32x2g*)(WSP(bf16, WS_MO) + (size_t)(m_) * D) + F.lane + 64 * j); PO = F.lane < 16 ? WSP(float, WS_PO)[(size_t)(m_) * 16 + F.lane] : 0.f; } } while (0)
    int m = F.gw; if (m < M) ROW_LOAD(v, mo, po, m);
    for (; m < M; m += F.NGW) {
        const int mn = m + F.NGW; if (mn < M) ROW_LOAD(vn, mon, pon, mn);
        if (stage == 2) {
#pragma unroll
            for (int j = 0; j < 4; ++j) { const unsigned w0 = __float_as_uint(v[j].x), w1 = __float_as_uint(v[j].y); v[j].x = blo(w0); v[j].y = bhi(w0); v[j].z = blo(w1); v[j].w = bhi(w1); } }
        if (stage >= 1) {
            const float rs = __builtin_amdgcn_rsqf(wave_sum(po) * (1.f / 1024.f) + RMS_EPS);
#pragma unroll
            for (int j = 0; j < 4; ++j) { v[j].x += blo(mo[j].x) * rs * gpo[j].x; v[j].y += bhi(mo[j].x) * rs * gpo[j].y; v[j].z += blo(mo[j].y) * rs * gpo[j].z; v[j].w += bhi(mo[j].y) * rs * gpo[j].w;
                if (stage == 1) { u32x2g o; o.x = pk2(v[j].x, v[j].y); o.y = pk2(v[j].z, v[j].w); __builtin_nontemporal_store(o, (GAS u32x2g*)((char*)A.out + (size_t)m * 4096) + F.lane + 64 * j); }
                else __builtin_nontemporal_store(v[j], (GAS f32x4*)(A.out + (size_t)m * D) + F.lane + 64 * j); }
        }
        if (stage < 2) {
            float s2 = 0.f;
#pragma unroll
            for (int j = 0; j < 4; ++j) s2 += (v[j].x * v[j].x + v[j].y * v[j].y) + (v[j].z * v[j].z + v[j].w * v[j].w);
            const float rs = __builtin_amdgcn_rsqf(wave_sum(s2) * (1.f / D) + RMS_EPS);
#pragma unroll
            for (int j = 0; j < 4; ++j) { v[j].x *= rs * gpr[j].x; v[j].y *= rs * gpr[j].y; v[j].z *= rs * gpr[j].z; v[j].w *= rs * gpr[j].w; }
            float mx = 0.f;
#pragma unroll
            for (int j = 0; j < 4; ++j) mx = fmaxf(fmaxf(mx, fmaxf(fabsf(v[j].x), fabsf(v[j].y))), fmaxf(fabsf(v[j].z), fabsf(v[j].w)));
            mx = wave_max(mx); const float qs = mx > 0.f ? 127.f / mx : 0.f;
#pragma unroll
            for (int j = 0; j < 4; ++j) { unsigned char* hrow = WSP(unsigned char, WS_H) + (size_t)m * (H_LD * 2); const int k = 256 * j + 4 * F.lane;
                *(GAS unsigned*)(hrow + ((k + 1024 - KI8) & 1023)) = pk4_i8(v[j].x * qs, v[j].y * qs, v[j].z * qs, v[j].w * qs);
                if (256 * j >= KI8) { u32x2g o; o.x = pk2(v[j].x, v[j].y); o.y = pk2(v[j].z, v[j].w); *(GAS u32x2g*)(hrow + 1024 + 2 * (k - KI8)) = o; } }
            if (F.lane == 0) WSP(float, WS_RDQ)[m] = mx * (1.f / 127.f);
        }
#pragma unroll
        for (int j = 0; j < 4; ++j) { v[j] = vn[j]; mo[j] = mon[j]; } po = pon;
    }
#undef ROW_LOAD
}
template <int KI8> __device__ __forceinline__ void p0_all(Frame& F, const Args& A, int l) {
    const int nit = F.G == 256 ? NV_IN / 32 : Q_NITEMS;
    const int it0 = blockIdx.x; f32x4 qv[16]; QItem q0 = q_item<KI8>(F, A, l, it0 < nit ? it0 : 0);
    if (it0 < nit) q_load(F, q0, qv);
    p0_rows<KI8>(F, A, l);
    p0_weights(F, A, l);
    if (it0 < nit) q_finish(F, q0, qv);
    for (int it = it0 + F.G; it < nit; it += F.G) { QItem q = q_item<KI8>(F, A, l, it); q_load(F, q, qv); q_finish(F, q, qv); }
    __syncthreads();
}
template <int KI8> __device__ __forceinline__ void p2_gateq(Frame& F, const Args& A, int l) {
    if (F.G != 256 || blockIdx.x < 128) return;
    f32x4 qv[16]; QItem q = q_item<KI8>(F, A, l, NV_IN / 32 + ((int)blockIdx.x - 128)); q_load(F, q, qv); q_finish(F, q, qv);
    __syncthreads();
}
__device__ __forceinline__ void p0_rope(Frame& F, const Args& A) {
    const int gt = F.gw * 64 + F.lane, NT = F.NGW * 64;
    for (int i = gt; i < M * 16; i += NT) { const int row = i >> 4, j = i & 15;
        const float inv = exp2f(-(float)j * 0.83048202372184058f);     const float ang = (float)((const int*)A.in[1])[row] * inv; const double rv = (double)ang * 0.15915494309189535; const float fr = (float)(rv - rint(rv)); const float s = __builtin_amdgcn_sinf(fr), c = __builtin_amdgcn_cosf(fr);
        f32x2g o; o.x = c; o.y = s; *(GAS f32x2g*)(WSP(float, WS_ROPE) + (size_t)i * 2) = o; }
}
__device__ __forceinline__ void p2_conv(Frame& F, const Args& A, int l) {
    const float* wc = ((const float*)A.in[13]) + l * 3 * 512; const float* bc = ((const float*)A.in[14]) + l * 512; const int c0 = F.lane * 8;
    float w0[8], w1[8], w2[8], bb[8];
    { const f32x4 a0 = *(const GAS f32x4*)(wc + c0), a1 = *(const GAS f32x4*)(wc + c0 + 4), b0 = *(const GAS f32x4*)(wc + 512 + c0), b1 = *(const GAS f32x4*)(wc + 512 + c0 + 4),
                  d0 = *(const GAS f32x4*)(wc + 1024 + c0), d1 = *(const GAS f32x4*)(wc + 1024 + c0 + 4), e0 = *(const GAS f32x4*)(bc + c0), e1 = *(const GAS f32x4*)(bc + c0 + 4);
#pragma unroll
      for (int q = 0; q < 4; ++q) { w0[q] = a0[q]; w0[4 + q] = a1[q]; w1[q] = b0[q]; w1[4 + q] = b1[q]; w2[q] = d0[q]; w2[4 + q] = d1[q]; bb[q] = e0[q]; bb[4 + q] = e1[q]; } }
    for (int r0 = F.gw * 16; r0 < M; r0 += F.NGW * 16) {
        const int t0 = r0 & (SEQ - 1);
        const bf16* up = WSP(bf16, WS_ZT) + (size_t)r0 * ZT_LD + ZT_U + c0; bf16* gp = WSP(bf16, WS_ZY) + (size_t)r0 * ZY_LD + YC + c0;
        v4u um2 = {0u, 0u, 0u, 0u}, um1 = {0u, 0u, 0u, 0u};
        if (t0 > 0) { um2 = *(const GAS v4u*)(up - 2 * ZT_LD); um1 = *(const GAS v4u*)(up - ZT_LD); }
#pragma unroll
        for (int hb = 0; hb < 2; ++hb) { v4u uu[8], gg[8];
#pragma unroll
            for (int i = 0; i < 8; ++i) { uu[i] = __builtin_nontemporal_load((const GAS v4u*)(up + (size_t)(8 * hb + i) * ZT_LD)); gg[i] = __builtin_nontemporal_load((const GAS v4u*)(gp + (size_t)(8 * hb + i) * ZY_LD)); }
#pragma unroll
            for (int i = 0; i < 8; ++i) { v4u o;
#pragma unroll
                for (int q = 0; q < 4; ++q) {
                    const float ylo = w0[2 * q] * blo(um2[q]) + w1[2 * q] * blo(um1[q]) + w2[2 * q] * blo(uu[i][q]) + bb[2 * q];
                    const float yhi = w0[2 * q + 1] * bhi(um2[q]) + w1[2 * q + 1] * bhi(um1[q]) + w2[2 * q + 1] * bhi(uu[i][q]) + bb[2 * q + 1];
                    o[q] = pk2(blo(gg[i][q]) * ylo, bhi(gg[i][q]) * yhi); }
                *(GAS v4u*)(gp + (size_t)(8 * hb + i) * ZY_LD) = o; um2 = um1; um1 = uu[i]; } }
    }
}
__device__ __forceinline__ float logsig(float x) { return fminf(x, 0.f) - 0.69314718056f * __builtin_amdgcn_logf(1.f + __builtin_amdgcn_exp2f(-1.4426950409f * fabsf(x))); }
__device__ __forceinline__ void p2_mscan(Frame& F, const Args& A, int l) {
    if (blockIdx.x >= 32) return;
    const int b = blockIdx.x >> 2, h = blockIdx.x & 3, lane = F.lane, wave = F.wave; const float fb = ((const float*)A.in[11])[l * 4 + h];
    const size_t r0 = (size_t)b * SEQ + F.tid * 8; const float* G = WSP(float, WS_GIF); LAS float* X = (LAS float*)(F.lds + RING_OFF);
    float lf[8], ai[8];
#pragma unroll
    for (int i = 0; i < 8; ++i) { lf[i] = G[(r0 + i) * 8 + 4 + h]; ai[i] = G[(r0 + i) * 8 + h]; }
    float ls = 0.f;
#pragma unroll
    for (int i = 0; i < 8; ++i) { lf[i] = logsig(lf[i] + fb); ls += lf[i]; }
    float incl = ls;
#pragma unroll
    for (int o = 1; o < 64; o <<= 1) { const float t = lane_up(incl, lane, o); if (lane >= o) incl += t; }
    if (lane == 63) X[wave] = incl;
    __syncthreads();
    float B = incl - ls;
#pragma unroll
    for (int w = 0; w < 8; ++w) if (w < wave) B += X[w];
    float lm = -INFINITY;
#pragma unroll
    for (int i = 0; i < 8; ++i) { B += lf[i]; ai[i] -= B; lf[i] = B; lm = fmaxf(lm, ai[i]); }
    float im = lm;
#pragma unroll
    for (int o = 1; o < 64; o <<= 1) { const float t = lane_up(im, lane, o); if (lane >= o) im = fmaxf(im, t); }
    if (lane == 63) X[8 + wave] = im;
    __syncthreads();
    float run = lane_up(im, lane, 1); if (lane == 0) run = -INFINITY; run = fmaxf(run, 0.f);
#pragma unroll
    for (int w = 0; w < 8; ++w) if (w < wave) run = fmaxf(run, X[8 + w]);
    float* O = WSP(float, WS_MLS);
#pragma unroll
    for (int i = 0; i < 8; ++i) { run = fmaxf(run, ai[i]); f32x4 o; o.x = ai[i]; o.y = run; o.z = lf[i] + run; o.w = 0.f; *(GAS f32x4*)(O + ((r0 + i) * 4 + h) * 4) = o; }
    __syncthreads();
}
#if MK_NAIVE_SGU
__device__ __forceinline__ void p2_sgu_naive(Frame& F, const Args& A, int l) {
    LAS f32x2g* st = (LAS f32x2g*)(F.lds + RING_OFF);
    const int c = F.tid & 127, tq = F.tid >> 7;
    for (int u = blockIdx.x; u < 1024; u += F.G) { const int g = u & 3, bn = u >> 2; const size_t base = (size_t)bn * 128;
        if (F.tid < 128) { float s1 = 0.f, s2 = 0.f;
            for (int k = 0; k < 8; ++k) { const f32x2g p = *(const GAS f32x2g*)(WSP(float, WS_PVS) + ((base + F.tid) * 8 + k) * 2); s1 += p.x; s2 += p.y; }
            const float mean = s1 * (1.f / 512.f), var = fmaxf(s2 * (1.f / 512.f) - mean * mean, 0.f); f32x2g o; o.x = mean; o.y = 1.0f / sqrtf(var + RMS_EPS); st[F.tid] = o; }
        __syncthreads();
        const float* W = ((const float*)A.in[16]) + ((size_t)l * 4 + g) * 128 * 128;
        float acc[32];
#pragma unroll
        for (int i = 0; i < 32; ++i) acc[i] = 0.f;
        for (int s = 0; s < 128; ++s) { const f32x2g ms = st[s]; const float vn = (bf2f(WSP(bf16, WS_ZT)[(base + s) * ZT_LD + ZT_V + g * 128 + c]) - ms.x) * ms.y;
#pragma unroll
            for (int i = 0; i < 32; ++i) { const int tt = tq + 4 * i; if (tt >= s) acc[i] += W[tt * 128 + s] * vn; } }
        const float gs = ((const float*)A.in[15])[l * 512 + g * 128 + c];
#pragma unroll
        for (int i = 0; i < 32; ++i) { const int tt = tq + 4 * i; GAS bf16* p = (GAS bf16*)(WSP(bf16, WS_ZY) + (base + tt) * ZY_LD + YD + g * 128 + c);
            const float mixed = acc[i] * gs + ((const float*)A.in[17])[(l * 4 + g) * 128 + tt]; *p = (bf16)f2bf(bf2f(*p) * mixed); }
        __syncthreads();
    }
}
#endif
#if !MK_NAIVE_SGU
__device__ __forceinline__ void p2_sgu(Frame& F, const Args& A, int l) {
    for (int u = blockIdx.x; u < 1024; u += F.G)
        sgu::sgu_unit(u >> 2, u & 3, WSP(bf16, WS_ZT), WSP(float, WS_PVS), WSP(bf16, WS_WB + WB_S), ((const float*)A.in[15]) + l * 512, ((const float*)A.in[17]) + l * 512, WSP(bf16, WS_ZY), (char*)F.lds + RING_OFF);
}
#endif
#if MK_NAIVE_ATTN
__device__ __forceinline__ void p3_attn_naive(Frame& F, const Args& A, bf16* Yunused) {
    const int lane = F.lane;
    for (int pass = 0; pass < 2; ++pass) { const int u = pass == 0 ? F.gw : 4095 - F.gw; if (F.gw >= 2048) break;
        const int c = u & 63, h = (u >> 6) & 7, b = u >> 9; const size_t row = (size_t)b * SEQ + c * 64 + lane;
        v4u q[12];
#pragma unroll
        for (int i = 0; i < 12; ++i) q[i] = *(const GAS v4u*)(WSP(bf16, WS_Q) + row * 768 + h * 96 + 8 * i);
        float o[64];
#pragma unroll
        for (int i = 0; i < 64; ++i) o[i] = 0.f;
        float mx = -1e30f, lsum = 0.f; const int nk = 64 * (c + 1);
        for (int k0 = 0; k0 < nk; ++k0) { const size_t kr = (size_t)b * SEQ + k0; float a = 0.f;
#pragma unroll
            for (int i = 0; i < 8; ++i) { const v4u w = *(const GAS v4u*)(WSP(bf16, WS_KN) + kr * 512 + h * 64 + 8 * i);
#pragma unroll
                for (int k = 0; k < 4; ++k) a += blo(q[i][k]) * blo(w[k]) + bhi(q[i][k]) * bhi(w[k]); }
#pragma unroll
            for (int i = 0; i < 4; ++i) { const v4u w = *(const GAS v4u*)(WSP(bf16, WS_KR) + kr * 32 + 8 * i);
#pragma unroll
                for (int k = 0; k < 4; ++k) a += blo(q[8 + i][k]) * blo(w[k]) + bhi(q[8 + i][k]) * bhi(w[k]); }
            if (__any(a > mx)) { const float mn = fmaxf(a, mx), al = fexp2g(mx - mn); mx = mn; lsum *= al;
#pragma unroll
                for (int i = 0; i < 64; ++i) o[i] *= al; }
            const float p = fexp2g(a - mx); lsum += p;
#pragma unroll
            for (int i = 0; i < 8; ++i) { const v4u w = *(const GAS v4u*)(WSP(bf16, WS_V) + kr * 512 + h * 64 + 8 * i);
#pragma unroll
                for (int k = 0; k < 4; ++k) { o[8 * i + 2 * k] += p * blo(w[k]); o[8 * i + 2 * k + 1] += p * bhi(w[k]); } }
        }
        const float rl = 1.0f / lsum; GAS v4u* yp = (GAS v4u*)(WSP(bf16, WS_ZY) + row * ZY_LD + YA + h * 64);
#pragma unroll
        for (int i = 0; i < 8; ++i) { const v4u g = yp[i]; v4u w;
#pragma unroll
            for (int k = 0; k < 4; ++k) w[k] = pk2(o[8 * i + 2 * k] * rl * blo(g[k]), o[8 * i + 2 * k + 1] * rl * bhi(g[k]));
            yp[i] = w; }
    }
}
#endif
#if !MK_NAIVE_ATTN
#if MK_ATTN_V2 == 2
#define ATTN_UNIT attn_unit3
#elif MK_ATTN_V2
#define ATTN_UNIT attn_unit2
#else
#define ATTN_UNIT attn_unit
#endif
__device__ __forceinline__ void p3_attn(Frame& F, const Args& A, bf16* Y) {
    const int bx = blockIdx.x, vcu = (F.G % 8 == 0) ? (bx % 8) * (F.G / 8) + bx / 8 : bx;
    for (int u = vcu; u < 1024; u += F.G) { const int v = u & 255, i = u >> 8, bh = v >> 2, s = v & 3, qb = i == 0 ? s : i == 1 ? 7 - s : i == 2 ? 8 + s : 15 - s;
        att::ATTN_UNIT(bh >> 3, bh & 7, qb, WSP(bf16, WS_Q), WSP(bf16, WS_KN), WSP(bf16, WS_KR), WSP(bf16, WS_V), Y, (char*)F.lds + RING_OFF); }
}
#endif
#if MK_NAIVE_MLSTM
__device__ __forceinline__ void p3_mlstm_naive(Frame& F, const Args& A, int l, bf16* Yunused) {
    const int lane = F.lane, hf = lane >> 5;
    for (int pass = 0; pass < 2; ++pass) { const int u = pass == 0 ? F.gw : 4095 - F.gw; if (F.gw >= 2048) break;
        const int w = u & 127, h = (u >> 7) & 3, b = u >> 9; const int t = w * 32 + (lane & 31); const size_t row = (size_t)b * SEQ + t;
        v4u q[8];
#pragma unroll
        for (int i = 0; i < 8; ++i) q[i] = *(const GAS v4u*)(WSP(bf16, WS_ZT) + row * ZT_LD + ZT_MQ + h * 64 + 8 * i);
        float acc[64];
#pragma unroll
        for (int i = 0; i < 64; ++i) acc[i] = 0.f;
        const f32x4 me = *(const GAS f32x4*)(WSP(float, WS_MLS) + (row * 4 + h) * 4); const float At = me.y, mt = me.z; float den = 0.f;
        const int nk = 32 * (w + 1);
        for (int s = 0; s < nk; ++s) { const size_t sr = (size_t)b * SEQ + s; float dot = 0.f;
#pragma unroll
            for (int i = 0; i < 8; ++i) { const v4u x = *(const GAS v4u*)(WSP(bf16, WS_ZT) + sr * ZT_LD + ZT_MK + h * 64 + 8 * i);
#pragma unroll
                for (int k = 0; k < 4; ++k) dot += blo(q[i][k]) * blo(x[k]) + bhi(q[i][k]) * bhi(x[k]); }
            const float ap = WSP(float, WS_MLS)[(sr * 4 + h) * 4]; const float p = s <= t ? dot * fexp2g((ap - At) * 1.4426950409f) : 0.f; den += p;
#pragma unroll
            for (int i = 0; i < 8; ++i) { const v4u x = *(const GAS v4u*)(WSP(bf16, WS_ZT) + sr * ZT_LD + ZT_MV + h * 128 + hf * 64 + 8 * i);
#pragma unroll
                for (int k = 0; k < 4; ++k) { acc[8 * i + 2 * k] += p * blo(x[k]); acc[8 * i + 2 * k + 1] += p * bhi(x[k]); } } }
        const float rd = 1.0f / fmaxf(fabsf(den), fexp2g(-mt * 1.4426950409f)); float ss = 0.f;
#pragma unroll
        for (int i = 0; i < 64; ++i) ss += acc[i] * acc[i];
        ss = sum_xor32(ss);
        const float rn = rd * __builtin_amdgcn_rsqf(rd * rd * ss * (1.f / 128.f) + RMS_EPS);
        const float* gm = ((const float*)A.in[12]) + l * 512 + h * 128 + hf * 64;
        GAS v4u* yp = (GAS v4u*)(WSP(bf16, WS_ZY) + row * ZY_LD + YB + h * 128 + hf * 64);
#pragma unroll
        for (int i = 0; i < 8; ++i) { const v4u g = yp[i]; v4u o;
#pragma unroll
            for (int k = 0; k < 4; ++k) o[k] = pk2(acc[8 * i + 2 * k] * rn * gm[8 * i + 2 * k] * blo(g[k]), acc[8 * i + 2 * k + 1] * rn * gm[8 * i + 2 * k + 1] * bhi(g[k]));
            yp[i] = o; }
    }
}
#endif
#if !MK_NAIVE_MLSTM
__device__ __forceinline__ void p3_mlstm(Frame& F, const Args& A, int l, bf16* Y) {
    const int bx = blockIdx.x, vcu = (F.G % 8 == 0) ? (bx % 8) * (F.G / 8) + bx / 8 : bx;
    for (int u = vcu; u < 512; u += F.G) { const int bh = u >> 4, qb = (u < 256) ? (u & 15) : 15 - (u & 15);
        mls::mlstm_unit(bh >> 2, bh & 3, qb, WSP(bf16, WS_ZT), WSP(float, WS_MLS), ((const float*)A.in[12]) + l * 512, WSP(bf16, WS_MSUM), WSP(float, WS_MSUM + 8 * MiB), WSP(float, WS_MSUM + 8 * MiB + 256 * 1024), Y, (char*)F.lds + RING_OFF); }
}
__device__ __forceinline__ void p2_msum(Frame& F, const Args& A, int l) {
    for (int u = blockIdx.x; u < 512; u += F.G) { const int bh = u >> 4, J = u & 15, h = bh & 3;
        mls::mlstm_summary(u, h, (size_t)(bh >> 2) * SEQ + J * 256, WSP(bf16, WS_ZT), WSP(float, WS_GIF), ((const float*)A.in[11])[l * 4 + h], WSP(bf16, WS_MSUM), WSP(float, WS_MSUM + 8 * MiB), WSP(float, WS_MSUM + 8 * MiB + 256 * 1024), (char*)F.lds + RING_OFF); }
}
#endif

#if MK_NAIVE_MLSTM
#define P2_MSUM(F, a, l) do {} while (0)
#else
#define P2_MSUM p2_msum
#endif
#if MK_NAIVE_SGU
#define P2_SGU p2_sgu_naive
#else
#define P2_SGU p2_sgu
#endif
#if MK_NAIVE_MLSTM
#define P3_MLSTM p3_mlstm_naive
#else
#define P3_MLSTM p3_mlstm
#endif
#if MK_NAIVE_ATTN
#define P3_ATTN p3_attn_naive
#else
#define P3_ATTN p3_attn
#endif
__global__ void __launch_bounds__(NTHREADS, 2) mk_fwd(Args args) {
    extern __shared__ __attribute__((aligned(16))) unsigned char lds[];
    Frame F;
    F.lds = (LAS unsigned char*)lds; F.MISC = (volatile LAS unsigned*)(F.lds + MISC_OFF);
    F.tid = threadIdx.x; F.lane = F.tid & 63; F.wave = __builtin_amdgcn_readfirstlane(F.tid >> 6); F.G = gridDim.x; F.gw = blockIdx.x * NWAVES + F.wave; F.NGW = F.G * NWAVES;
    F.ws = args.ws; F.ctl = (gu32*)(F.ws + WS_CTL);
    const Args& A = args;
    for (int u = F.tid; u < (LDS_BYTES - LDSCTL_OFF) / 4; u += NTHREADS) ((LAS unsigned*)(F.lds + LDSCTL_OFF))[u] = 0u;
    __syncthreads();
    const int lo = args.ph_lo, hi = args.ph_hi;
    XcdBarrier bar; bar.bar = (unsigned*)(F.ctl + CW_BAR); bar.x = 0; bar.st = nullptr;
    if (hi - lo > 1) bar = xcd_barrier_post((unsigned*)(F.ctl + CW_BAR), F.MISC + 8);
#define IN(k) (lo <= (k) && (k) < hi)
#define PROBE(b) ((MK_PROBE >> (b)) & 1)
#define NREP(b) (1 + PROBE(b))
#define FRESH() do { int z_ = 0; asm volatile("" : "+v"(z_)); F.ws = args.ws + __builtin_amdgcn_readfirstlane(z_); int t_ = threadIdx.x; asm volatile("" : "+v"(t_)); F.tid = t_; F.lane = t_ & 63; \
        F.wave = __builtin_amdgcn_readfirstlane(t_ >> 6); F.gw = blockIdx.x * NWAVES + F.wave; } while (0)
#define SEAM(k) do { if (IN(k) && IN((k) + 1)) xcd_barrier(bar); } while (0)
    typedef pg8::StaticOrder SO;
#define LAYER(l) do { \
        const int pb = 6 * l; \
        if (IN(pb + 0)) for (int rep_ = 0; rep_ < NREP(3); ++rep_) { FRESH(); if (l == 0) p0_rope(F, args); FRESH(); p0_all<ki8_of(l)>(F, args, l); } \
        SEAM(pb + 0); \
        if (IN(pb + 1)) for (int rep_ = 0; rep_ < NREP(0); ++rep_) { FRESH(); \
            pg8::Gemm g{WSP(bf16, WS_H), WSP(bf16, WS_WB + WB_IN), M, NV_IN, 1024, H_LD}; SO S; S.init(M, NV_IN, F.G, (int)blockIdx.x, 64 * (ki8_of(l) / 128 + (1024 - ki8_of(l)) / 64)  , 1024u - ki8_of(l)); \
            pg8::EpiIn<ki8_of(l)> E{WSP(bf16, WS_ZT), WSP(bf16, WS_ZY), WSP(bf16, WS_KR), WSP(float, WS_PQ), WSP(float, WS_PKV), WSP(float, WS_PVS), WSP(float, WS_GIF), WSP(float, WS_ROPE), WSP(float, WS_RDQ), WSP(float, WS_CDQI)}; \
            pg8::gemm_phase<pg8::EpiIn<ki8_of(l)>, SO, true, true>(F.lds + RING_OFF, g, S, E); \
        } \
        SEAM(pb + 1); \
        if (IN(pb + 2)) { for (int rep_ = 0; rep_ < NREP(6); ++rep_) { FRESH(); \
            { pg8::Gemm g{WSP(bf16, WS_ZT) + ZT_CQ, WSP(bf16, WS_WB + WB_UQ), M, 768, 256, ZT_LD}; SO S; S.init(M, 768, F.G, (int)blockIdx.x, 256); pg8::EpiUpQ E{WSP(bf16, WS_Q), WSP(float, WS_PQ), WSP(float, WS_ROPE)}; \
              pg8::gemm_phase<pg8::EpiUpQ, SO, true, true>(F.lds + RING_OFF, g, S, E); } \
            FRESH(); if (rep_ == 0) { p2_gateq<ki8_of(l)>(F, args, l); FRESH(); p2_wlate(F, args, l); FRESH(); } \
            { pg8::Gemm g{WSP(bf16, WS_ZT) + ZT_CKV, WSP(bf16, WS_WB + WB_UKV), M, 1024, 128, ZT_LD}; SO S; S.init(M, 1024, F.G, (int)blockIdx.x, 128); pg8::EpiUpKV E{WSP(bf16, WS_KN), WSP(bf16, WS_V), WSP(float, WS_PKV)}; \
              pg8::gemm_phase<pg8::EpiUpKV, SO, true, true>(F.lds + RING_OFF, g, S, E); } \
            __syncthreads(); } \
            for (int rep_ = 0; rep_ < NREP(7); ++rep_) { FRESH(); \
            p2_mscan(F, args, l); FRESH(); \
            P2_MSUM(F, args, l); } \
            FRESH(); \
            p2_conv(F, args, l); FRESH(); \
            P2_SGU(F, args, l); \
        } \
        SEAM(pb + 2); \
        if (IN(pb + 3)) { FRESH(); P3_ATTN(F, args, WSP(bf16, WS_ZY)); if (PROBE(4) && l == 0) { FRESH(); P3_ATTN(F, args, (bf16*)args.out); } FRESH(); P3_MLSTM(F, args, l, WSP(bf16, WS_ZY)); if (PROBE(5) && l == 0) { FRESH(); P3_MLSTM(F, args, l, (bf16*)args.out); } } \
        SEAM(pb + 3); \
        if (IN(pb + 4)) for (int rep_ = 0; rep_ < NREP(1); ++rep_) { FRESH(); \
            pg8::Gemm g{WSP(bf16, WS_H), WSP(bf16, WS_WB + WB_GATE), M, 1024, 1024, H_LD}; pg8::P4Order S; S.init(M, F.G, (int)blockIdx.x, (unsigned)(WB_P - WB_GATE)); \
            pg8::EpiP4 E{WSP(unsigned char, WS_S), WSP(bf16, WS_MG), ((const float*)A.in[6]) + l * 4096, WSP(float, WS_RDQ), WSP(float, WS_CDQ)}; \
            pg8::gemm_phase<pg8::EpiP4, pg8::P4Order, true, true>(F.lds + RING_OFF, g, S, E); \
        } \
        SEAM(pb + 4); \
        if (IN(pb + 5)) for (int rep_ = 0; rep_ < NREP(2); ++rep_) { FRESH(); \
            pg8::Gemm g{WSP(bf16, WS_MG), WSP(bf16, WS_WOUT), M, 1024, 1024, 1024}; SO S; S.init(M, 1024, F.G, (int)blockIdx.x, 1024); pg8::EpiOut E{WSP(bf16, WS_MO), WSP(float, WS_PO)}; \
            pg8::gemm_phase<pg8::EpiOut, SO, true, true>(F.lds + RING_OFF, g, S, E); \
        } \
        SEAM(pb + 5); \
    } while (0)
    LAYER(0);
    LAYER(1);
#undef LAYER
    if (IN(12)) { FRESH(); p0_rows<512>(F, args, 2); }
#undef IN
#undef SEAM
}

extern "C" void kernel_launch(void* const* d_in, const int* in_sizes, int n_in, void* d_out, int out_size, void* d_ws, size_t ws_size, hipStream_t stream) {
    static int grid = 0;
    if (grid == 0) {
        if (n_in != 23 || in_sizes[0] != M * D || out_size != M * D || ws_size < WS_END) { fprintf(stderr, "kernel_launch: unexpected shapes (n_in %d, in0 %d, out %d, ws %zu < %zu)\n", n_in, n_in > 0 ? in_sizes[0] : -1, out_size, ws_size, (size_t)WS_END); grid = -1; return; }
        int dev = 0, cus = 0, per_cu = 0;
        if (hipGetDevice(&dev) != hipSuccess || hipDeviceGetAttribute(&cus, hipDeviceAttributeMultiprocessorCount, dev) != hipSuccess) { grid = -1; return; }
        if (hipFuncSetAttribute((const void*)mk_fwd, hipFuncAttributeMaxDynamicSharedMemorySize, LDS_BYTES) != hipSuccess) { fprintf(stderr, "kernel_launch: hipFuncSetAttribute failed\n"); grid = -1; return; }
        if (hipOccupancyMaxActiveBlocksPerMultiprocessor(&per_cu, (const void*)mk_fwd, NTHREADS, LDS_BYTES) != hipSuccess || per_cu < 1) fprintf(stderr, "kernel_launch: occupancy query reports %d\n", per_cu);
        (void)hipGetLastError();
        grid = cus;
    }
    if (grid < 0) return;
    if (hipMemsetAsync((char*)d_ws + WS_CTL, 0, CTL_ZERO_BYTES, stream) != hipSuccess) return;
    Args a{};
    for (int i = 0; i < 23; ++i) a.in[i] = d_in[i];
    a.out = (float*)d_out; a.ws = (unsigned char*)d_ws;
#if MK_ONE_LAUNCH
    a.ph_lo = 0; a.ph_hi = N_PHASES;
    hipLaunchKernelGGL(mk_fwd, dim3(grid), dim3(NTHREADS), LDS_BYTES, stream, a);
#else
    for (int p = 0; p < N_PHASES; ++p) { a.ph_lo = p; a.ph_hi = p + 1; hipLaunchKernelGGL(mk_fwd, dim3(grid), dim3(NTHREADS), LDS_BYTES, stream, a); }
#endif
    const hipError_t le = hipPeekAtLastError();
    if (le != hipSuccess) fprintf(stderr, "kernel_launch: launch failed: %s\n", hipGetErrorName(le));
}
```

```cpp
#include <hip/hip_runtime.h>
#include <cstdio>
#include <cstdint>
#include <cmath>
constexpr int ZT_LD = 2432, ZT_CQ = 0, ZT_CKV = 256, ZT_MQ = 384, ZT_MK = 640, ZT_MV = 896, ZT_U = 1408, ZT_V = 1920;
constexpr int H_LD = 3072, ZY_LD = 3072, YA = 0, YB = 512, YC = 1024, YD = 1536;
__host__ __device__ __forceinline__ size_t hz_off(size_t row, int ecol) { return (((row >> 8) * 48 + (size_t)(ecol >> 6)) * 256 + (row & 255)) * 64 + (size_t)(ecol & 63); }
constexpr float RMS_EPS = 1e-6f;
#ifndef MK_KI0
#define MK_KI0 512
#endif
#ifndef MK_KI1
#define MK_KI1 1024
#endif
constexpr int ki8_of(int l) { return l == 0 ? MK_KI0 : MK_KI1; }
namespace pg8 {
#define PG8_LAS __attribute__((address_space(3)))
typedef unsigned short bf16_t;
typedef short bf16x8 __attribute__((ext_vector_type(8)));
typedef float f32x4 __attribute__((ext_vector_type(4)));
typedef int i32x4 __attribute__((ext_vector_type(4)));
typedef unsigned u32x4 __attribute__((ext_vector_type(4)));
constexpr int BM = 256, BK = 64, HALF = 128, HTB = HALF * BK * 2  , STAGE_BYTES = 8 * HTB, NXCD = 8, WGM = 8;

__host__ __device__ __forceinline__ int lds_byte(int r, int c) { const int st = (r >> 4) * 2 + (c >> 5), rr = r & 15, cc = c & 31, ob = rr * 64 + cc * 2; return st * 1024 + (ob ^ (((ob >> 9) & 1) << 5)); }
__host__ __device__ __forceinline__ void stage_rc(int b, int& R, int& C) { const int st = b / 1024, sb = b % 1024, swz = sb ^ (((sb >> 9) & 1) << 5); R = (st >> 1) * 16 + swz / 64; C = (st & 1) * 32 + (swz % 64) / 2; }
__host__ __device__ __forceinline__ int perm32(int rho) { const int n = rho >> 4, i = rho & 15; return 8 * (i >> 2) + 4 * n + (i & 3); }

struct Unit { int pm, pn, nt, br, kind; unsigned aoff, boff; };
struct Gemm { const bf16_t* A; const bf16_t* Bt; int M, N, K, lda; unsigned kstepA = 0, tstepA = 0; };

struct StaticOrder {
    int nM, nN, nwg, G, c, nt; unsigned a0;
    __host__ __device__ __forceinline__ void init(int M, int N, int G_, int c_, int K_, unsigned a0_ = 0u) { nM = M / BM; nN = N / BM; nwg = nM * nN; G = G_; c = c_; nt = K_ / BK; a0 = a0_; }
    __host__ __device__ __forceinline__ bool next(int i, Unit& u) const {
        const long L = (long)i * G + c; if (L >= nwg) return false;
        int wgid = (int)L; { const int q = nwg / NXCD, r = nwg % NXCD, xcd = wgid % NXCD, off = wgid / NXCD; wgid = (xcd < r ? xcd * (q + 1) : r * (q + 1) + (xcd - r) * q) + off; }
        const int nig = WGM * nN, gid = wgid / nig, fm = gid * WGM, gsz = (nM - fm) < WGM ? (nM - fm) : WGM;
        u.pm = fm + ((wgid % nig) % gsz); u.pn = (wgid % nig) / gsz; u.nt = nt; u.br = 0; u.kind = 0; u.aoff = a0; u.boff = 0u; return true;
    }
    __device__ __forceinline__ void a_ready(const Unit&) const {}
    __device__ __forceinline__ void done(const Unit&) const {}
};

typedef __bf16 bf16x2_t __attribute__((ext_vector_type(2)));
__device__ __forceinline__ unsigned cvt_pk_bf16(float lo, float hi) { typedef float f32x2_t __attribute__((ext_vector_type(2))); f32x2_t v = {lo, hi}; bf16x2_t b = __builtin_convertvector(v, bf16x2_t); return __builtin_bit_cast(unsigned, b); }
typedef float f32x2 __attribute__((ext_vector_type(2)));
typedef unsigned u32x2 __attribute__((ext_vector_type(2)));
__device__ __forceinline__ float fexp2(float x) { return __builtin_amdgcn_exp2f(x); }
__device__ __forceinline__ float frcp(float x) { return __builtin_amdgcn_rcpf(x); }
__device__ __forceinline__ float sigm(float x) { return frcp(1.f + fexp2(-1.4426950409f * x)); }
__device__ __forceinline__ float silu(float x) { return x * sigm(x); }
__device__ __forceinline__ float gelu_t(float x) { const float u = x + 0.044715f * x * x * x; return x * frcp(1.f + fexp2(-2.302208198f * u)); }
__device__ __forceinline__ float bflo(unsigned w) { return __uint_as_float(w << 16); }
__device__ __forceinline__ float bfhi(unsigned w) { return __uint_as_float(w & 0xffff0000u); }
__device__ __forceinline__ u32x4 pack8(const float (&o)[8]) { u32x4 w; w.x = cvt_pk_bf16(o[0], o[1]); w.y = cvt_pk_bf16(o[2], o[3]); w.z = cvt_pk_bf16(o[4], o[5]); w.w = cvt_pk_bf16(o[6], o[7]); return w; }
__device__ __forceinline__ void st_nt(u32x4* p, u32x4 v) { __builtin_nontemporal_store(v, p); }
__device__ __forceinline__ float quad_sum(float s) {
    s += __int_as_float(__builtin_amdgcn_ds_swizzle(__float_as_int(s), (16 << 10) | 0x1f)); auto r = __builtin_amdgcn_permlane32_swap(__float_as_uint(s), __float_as_uint(s), false, false); return __uint_as_float(r[0]) + __uint_as_float(r[1]); }

template <int KI8> struct EpiIn {
    static constexpr bool PERM = true, AFTER_DRAIN = false, HAS_MID = false, HAS_I8 = true;
    static constexpr int SPLIT_T = KI8 / 128;
    bf16_t* ZT; bf16_t* ZY; bf16_t* KR; float* PQ; float* PKV; float* PVS; float* GIF; const float* ROPE; const float* rdq; const float* cdq;
    __device__ __forceinline__ void dequant(f32x4 (&acc)[2][2][4][2], const Unit& u, int wr, int wc, int fr_, int fq_) const {
        int fr = fr_, fq = fq_; asm volatile("" : "+v"(fr), "+v"(fq));
        const int row0 = u.pm * BM + wr * 64 + fr; const float* cp = cdq + u.pn * 256 + wc * 32 + 8 * fq;
        float rq[8];
#pragma unroll
        for (int g = 0; g < 8; ++g) rq[g] = rdq[row0 + (g >> 2) * HALF + (g & 3) * 16];
#pragma unroll
        for (int bj = 0; bj < 2; ++bj) { const f32x4 c0 = *(const f32x4*)(cp + bj * HALF), c1 = *(const f32x4*)(cp + bj * HALF + 4);
#pragma unroll
            for (int ai = 0; ai < 2; ++ai)
#pragma unroll
                for (int m = 0; m < 4; ++m)
#pragma unroll
                    for (int e = 0; e < 8; ++e) acc[ai][bj][m][e >> 2][e & 3] = (float)__float_as_int(acc[ai][bj][m][e >> 2][e & 3]) * rq[ai * 4 + m] * (e < 4 ? c0[e & 3] : c1[e & 3]); }
    }
    template <int KIND> __device__ __forceinline__ void pair_tile(const f32x4 (&acc)[2][2][4][2], bf16_t* dst, int ld, int row0, int c0) const {
#pragma unroll
        for (int ai = 0; ai < 2; ++ai)
#pragma unroll
            for (int m = 0; m < 4; ++m) { const size_t row = (size_t)(row0 + ai * HALF + m * 16); float o[8];
#pragma unroll
                for (int e = 0; e < 8; ++e) { const float a = acc[ai][0][m][e >> 2][e & 3], b = acc[ai][1][m][e >> 2][e & 3];
                    o[e] = KIND == 0 ? b * frcp((1.f + fexp2(-1.4426950409f * a)) * (1.f + fexp2(-1.4426950409f * b)))
                         : KIND == 1 ? a * b : KIND == 2 ? a * silu(b)
                         : a * b * frcp((1.f + fexp2(-2.302208198f * (a + 0.044715f * a * a * a))) * (1.f + fexp2(-1.4426950409f * b))); }
                st_nt((u32x4*)(ld ? dst + row * ld + c0 : dst + hz_off(row, c0)), pack8(o)); }
    }
    template <int ACT, int ST> __device__ __forceinline__ void plain_tile(const f32x4 (&acc)[2][2][4][2], bf16_t* dst, int ld, int row0, int cw, int t, int wc, int fq) const {
#pragma unroll
        for (int ai = 0; ai < 2; ++ai)
#pragma unroll
            for (int m = 0; m < 4; ++m) { const size_t row = (size_t)(row0 + ai * HALF + m * 16); float s1 = 0.f, s2 = 0.f;
#pragma unroll
                for (int bj = 0; bj < 2; ++bj) { float o[8];
#pragma unroll
                    for (int e = 0; e < 8; ++e) { float v = acc[ai][bj][m][e >> 2][e & 3]; v = ACT == 1 ? silu(v) : ACT == 2 ? gelu_t(v) : v; o[e] = v; if (ST == 2) s1 += v; if (ST) s2 += v * v; }
                    st_nt((u32x4*)(ld ? dst + row * ld + bj * HALF + cw : dst + hz_off(row, bj * HALF + cw)), pack8(o)); }
                if (ST == 1) { s2 = quad_sum(s2); if (fq == 0) PQ[row * 4 + wc] = s2; }
                if (ST == 2) { s1 = quad_sum(s1); s2 = quad_sum(s2); if (fq == 0) { f32x2 p; p.x = s1; p.y = s2; *(f32x2*)(PVS + (row * 8 + (t - 24) * 4 + wc) * 2) = p; } } }
    }
    __device__ __forceinline__ void operator()(const f32x4 (&acc)[2][2][4][2], const Unit& u, int wr, int wc, int fr_, int fq_) const {
        int fr = fr_, fq = fq_; asm volatile("" : "+v"(fr), "+v"(fq));
        const int t = u.pn, row0 = u.pm * BM + wr * 64 + fr, cw = wc * 32 + 8 * fq;
        if (t >= 8 && t < 24) {
            const int kind = (t - 8) >> 2, c0 = ((t - 8) & 3) * 128 + cw;
            if (kind == 0) pair_tile<0>(acc, ZY, 0, row0, 1024 + YB + c0); else if (kind == 1) pair_tile<1>(acc, ZT + ZT_U, ZT_LD, row0, c0);
            else if (kind == 2) pair_tile<2>(acc, ZY, 0, row0, 1024 + YC + c0); else pair_tile<3>(acc, ZY, 0, row0, 1024 + YD + c0);
            return;
        }
        if (t == 1) {
#pragma unroll
            for (int ai = 0; ai < 2; ++ai)
#pragma unroll
                for (int m = 0; m < 4; ++m) { const size_t row = (size_t)(row0 + ai * HALF + m * 16); float o[8]; float ss = 0.f;
#pragma unroll
                    for (int e = 0; e < 8; ++e) { o[e] = acc[ai][0][m][e >> 2][e & 3]; ss += o[e] * o[e]; }
                    st_nt((u32x4*)(ZT + row * ZT_LD + ZT_CKV + cw), pack8(o));
                    ss = quad_sum(ss); if (fq == 0) PKV[row * 4 + wc] = ss;
                    if (wc == 0) { const f32x4 t1 = acc[ai][1][m][0], t2 = acc[ai][1][m][1];
                        const f32x4 cs0 = *(const f32x4*)(ROPE + row * 32 + 8 * fq), cs1 = *(const f32x4*)(ROPE + row * 32 + 8 * fq + 4);
                        const float c[4] = {cs0[0], cs0[2], cs1[0], cs1[2]}, s[4] = {cs0[1], cs0[3], cs1[1], cs1[3]};
                        u32x2 w1, w2; w1.x = cvt_pk_bf16(t1[0] * c[0] - t2[0] * s[0], t1[1] * c[1] - t2[1] * s[1]); w1.y = cvt_pk_bf16(t1[2] * c[2] - t2[2] * s[2], t1[3] * c[3] - t2[3] * s[3]);
                        w2.x = cvt_pk_bf16(t1[0] * s[0] + t2[0] * c[0], t1[1] * s[1] + t2[1] * c[1]); w2.y = cvt_pk_bf16(t1[2] * s[2] + t2[2] * c[2], t1[3] * s[3] + t2[3] * c[3]);
                        *(u32x2*)(KR + row * 32 + 4 * fq) = w1; *(u32x2*)(KR + row * 32 + 16 + 4 * fq) = w2; }
                    if (wc == 1 && fq == 0) { *(f32x4*)(GIF + row * 8) = acc[ai][1][m][0]; *(f32x4*)(GIF + row * 8 + 4) = acc[ai][1][m][1]; } }
            return;
        }
        if (t == 0) plain_tile<0, 1>(acc, ZT + ZT_CQ, ZT_LD, row0, cw, t, wc, fq);
        else if (t < 4) plain_tile<1, 0>(acc, ZY, 0, row0, 1024 + YA + (t - 2) * 256 + cw, t, wc, fq);
        else if (t < 8) plain_tile<0, 0>(acc, ZT + (t == 4 ? ZT_MQ : t == 5 ? ZT_MK : ZT_MV + (t - 6) * 256), ZT_LD, row0, cw, t, wc, fq);
        else plain_tile<2, 2>(acc, ZT + ZT_V + (t - 24) * 256, ZT_LD, row0, cw, t, wc, fq);
    }
};
struct EpiUpQ {
    static constexpr bool PERM = true, AFTER_DRAIN = false, HAS_MID = false, HAS_I8 = false; static constexpr int SPLIT_T = 0;
    bf16_t* Q; const float* PQ; const float* ROPE;
    __device__ __forceinline__ void operator()(const f32x4 (&acc)[2][2][4][2], const Unit& u, int wr, int wc, int fr_, int fq_) const {
        int fr = fr_, fq = fq_; asm volatile("" : "+v"(fr), "+v"(fq));
        const int t = u.pn, row0 = u.pm * BM + wr * 64 + fr;
        float rsv[8];
#pragma unroll
        for (int g = 0; g < 8; ++g) { const f32x4 pq = *(const f32x4*)(PQ + (size_t)(row0 + (g >> 2) * HALF + (g & 3) * 16) * 4); rsv[g] = __builtin_amdgcn_rsqf(((pq[0] + pq[1]) + (pq[2] + pq[3])) * (1.f / 256.f) + RMS_EPS); }
#pragma unroll
        for (int ai = 0; ai < 2; ++ai)
#pragma unroll
            for (int m = 0; m < 4; ++m) { const size_t row = (size_t)(row0 + ai * HALF + m * 16);
                const float rs = rsv[ai * 4 + m];
                if (t < 2) {
#pragma unroll
                    for (int bj = 0; bj < 2; ++bj) { float o[8];
#pragma unroll
                        for (int e = 0; e < 8; ++e) o[e] = acc[ai][bj][m][e >> 2][e & 3] * rs;
                        *(u32x4*)(Q + row * 768 + (4 * t + 2 * bj + (wc >> 1)) * 96 + (wc & 1) * 32 + 8 * fq) = pack8(o); }
                } else {
                    const int head = 2 * wc + (fq >> 1), j0 = 8 * (fq & 1);
#pragma unroll
                    for (int n = 0; n < 2; ++n) { const int j = j0 + 4 * n;
                        const f32x4 ca = *(const f32x4*)(ROPE + row * 32 + 2 * j), cb = *(const f32x4*)(ROPE + row * 32 + 2 * j + 4);
                        const f32x4 t1 = acc[ai][0][m][n] * rs, t2 = acc[ai][1][m][n] * rs;
                        u32x2 w1, w2; w1.x = cvt_pk_bf16(t1[0] * ca[0] - t2[0] * ca[1], t1[1] * ca[2] - t2[1] * ca[3]); w1.y = cvt_pk_bf16(t1[2] * cb[0] - t2[2] * cb[1], t1[3] * cb[2] - t2[3] * cb[3]);
                        w2.x = cvt_pk_bf16(t1[0] * ca[1] + t2[0] * ca[0], t1[1] * ca[3] + t2[1] * ca[2]); w2.y = cvt_pk_bf16(t1[2] * cb[1] + t2[2] * cb[0], t1[3] * cb[3] + t2[3] * cb[2]);
                        *(u32x2*)(Q + row * 768 + head * 96 + 64 + j) = w1; *(u32x2*)(Q + row * 768 + head * 96 + 80 + j) = w2; }
                } }
    }
};
struct EpiUpKV {
    static constexpr bool PERM = true, AFTER_DRAIN = false, HAS_MID = false, HAS_I8 = false; static constexpr int SPLIT_T = 0;
    bf16_t* KN; bf16_t* V; const float* PKV;
    __device__ __forceinline__ void operator()(const f32x4 (&acc)[2][2][4][2], const Unit& u, int wr, int wc, int fr_, int fq_) const {
        int fr = fr_, fq = fq_; asm volatile("" : "+v"(fr), "+v"(fq));
        const int t = u.pn, row0 = u.pm * BM + wr * 64 + fr, cw = wc * 32 + 8 * fq; bf16_t* dst = (t < 2 ? KN : V) + (t & 1) * 256;
        float rsv[8];
#pragma unroll
        for (int g = 0; g < 8; ++g) { const f32x4 pq = *(const f32x4*)(PKV + (size_t)(row0 + (g >> 2) * HALF + (g & 3) * 16) * 4); rsv[g] = __builtin_amdgcn_rsqf(((pq[0] + pq[1]) + (pq[2] + pq[3])) * (1.f / 128.f) + RMS_EPS); }
#pragma unroll
        for (int ai = 0; ai < 2; ++ai)
#pragma unroll
            for (int m = 0; m < 4; ++m) { const size_t row = (size_t)(row0 + ai * HALF + m * 16);
                const float rs = rsv[ai * 4 + m];
#pragma unroll
                for (int bj = 0; bj < 2; ++bj) { float o[8];
#pragma unroll
                    for (int e = 0; e < 8; ++e) o[e] = acc[ai][bj][m][e >> 2][e & 3] * rs;
                    st_nt((u32x4*)(dst + row * 512 + bj * HALF + cw), pack8(o)); } }
    }
};
struct P4Order {
    StaticOrder base; unsigned boff_p;
    __device__ __forceinline__ void init(int M, int G_, int c_, unsigned boff_p_) { base.init(M, 1024, G_, c_, 1024); boff_p = boff_p_; }
    __device__ __forceinline__ bool next(int j, Unit& u) const {
        const int tile = j / 6, sub = j - 6 * tile;
        if (!base.next(tile, u)) return false;
        const int pair = sub >= 3, q = sub - 3 * pair; u.nt = 16;
        if (q < 2) { u.kind = 0; u.nt = 8; u.br = 2 * pair + q; u.aoff = 0u; u.boff = (unsigned)u.br * (1024u * 1024u * 2u); }
        else { u.kind = 2; u.br = 2 * pair; u.aoff = (unsigned)(16 + 16 * pair) * 32768u;     u.boff = boff_p + (unsigned)pair * (1024u * 1024u * 2u); }
        return true;
    }
    __device__ __forceinline__ void a_ready(const Unit&) const {}
    __device__ __forceinline__ void done(const Unit&) const {}
};
struct EpiP4 {
    static constexpr bool PERM = true, AFTER_DRAIN = false, HAS_MID = true, HAS_I8 = true; static constexpr int SPLIT_T = 0;
    unsigned char* S; bf16_t* MG; const float* bias; const float* rdq; const float* cdq; unsigned char* MGP;
    static __device__ __forceinline__ float ub(unsigned w, int i) { return (float)((w >> (8 * i)) & 0xffu); }
    static __device__ __forceinline__ void swap16(unsigned& a, unsigned& b) { auto r = __builtin_amdgcn_permlane16_swap(a, b, false, false); a = r[0]; b = r[1]; }
    static __device__ __forceinline__ u32x4 join16(u32x2 w0, u32x2 w1) { unsigned a = w0.x, b = w0.y, c = w1.x, d = w1.y; swap16(a, c); swap16(b, d); return (u32x4){a, b, c, d}; }
    static __device__ __forceinline__ void split16(u32x4 v, u32x2& w0, u32x2& w1) { unsigned a = v.x, b = v.y, c = v.z, d = v.w; swap16(a, c); swap16(b, d); w0 = (u32x2){a, b}; w1 = (u32x2){c, d}; }
    __device__ __forceinline__ void mid(f32x4 (&acc)[2][2][4][2], const Unit& u, int wr, int wc, int fr_, int fq_) const {
        int fr = fr_, fq = fq_; asm volatile("" : "+v"(fr), "+v"(fq));
        const size_t toff = (size_t)(u.pm * 4 + u.pn) * 65536 + (size_t)(((wr * 4 + wc) * 64 + fq * 16 + fr) * 16);
        const unsigned char* Sa = S + toff; const unsigned char* Sb = S + (size_t)32768 * 1024 + toff;
        u32x4 la[8], lb[8];
#pragma unroll
        for (int g = 0; g < 8; ++g) { la[g] = *(const u32x4*)(Sa + g * 8192); lb[g] = *(const u32x4*)(Sb + g * 8192); }
#pragma unroll
        for (int g = 0; g < 8; ++g) { const int ai = g >> 2, mm = g & 3; const u32x2 sa[2] = {{la[g].x, la[g].y}, {la[g].z, la[g].w}}, sb[2] = {{lb[g].x, lb[g].y}, {lb[g].z, lb[g].w}};
#pragma unroll
            for (int bj = 0; bj < 2; ++bj)
#pragma unroll
                for (int e = 0; e < 8; ++e) { const unsigned wa = e < 4 ? sa[bj].x : sa[bj].y, wb = e < 4 ? sb[bj].x : sb[bj].y;
                    acc[ai][bj][mm][e >> 2][e & 3] *= ub(wa, e & 3) * frcp(ub(wb, e & 3)); } }
    }
    __device__ __forceinline__ void operator()(const f32x4 (&acc)[2][2][4][2], const Unit& u, int wr, int wc, int fr_, int fq_) const {
        int fr = fr_, fq = fq_; asm volatile("" : "+v"(fr), "+v"(fq));
        const int row0 = u.pm * BM + wr * 64 + fr, col0 = u.pn * BM + wc * 32 + 8 * fq;
        const size_t toff = (size_t)(u.pm * 4 + u.pn) * 65536 + (size_t)(((wr * 4 + wc) * 64 + fq * 16 + fr) * 16);
        if (u.kind == 0) {
            unsigned char* Sme = S + (size_t)(u.br & 1) * ((size_t)32768 * 1024);
            const float* bp = bias + u.br * 1024 + col0; const float* cp = cdq + u.br * 1024 + col0; float rq[8];
#pragma unroll
            for (int g = 0; g < 8; ++g) rq[g] = rdq[row0 + (g >> 2) * HALF + (g & 3) * 16];
            u32x2 w0[8];
#pragma unroll
            for (int bj = 0; bj < 2; ++bj) { f32x2 bv[4], cv[4];
#pragma unroll
                for (int n = 0; n < 2; ++n) { const f32x4 b4 = *(const f32x4*)(bp + bj * HALF + 4 * n), c4 = *(const f32x4*)(cp + bj * HALF + 4 * n);
                    bv[2 * n] = (f32x2){b4.x, b4.y} * -1.4426950409f; bv[2 * n + 1] = (f32x2){b4.z, b4.w} * -1.4426950409f; cv[2 * n] = (f32x2){c4.x, c4.y} * -1.4426950409f; cv[2 * n + 1] = (f32x2){c4.z, c4.w} * -1.4426950409f; }
#pragma unroll
                for (int g = 0; g < 8; ++g) { const int ai = g >> 2, m = g & 3; const float rs = rq[g]; u32x2 w = {0u, 0u};
#pragma unroll
                    for (int p = 0; p < 4; ++p) { const f32x4 a4 = acc[ai][bj][m][p >> 1];
                        f32x2 t = {(float)__float_as_int(a4[2 * (p & 1)]), (float)__float_as_int(a4[2 * (p & 1) + 1])};
                        t = (t * rs) * cv[p] + bv[p];
                        f32x2 d = {fexp2(t.x), fexp2(t.y)}; d = d * (1.f / 255.f) + (1.f / 255.f);
                        const float s0 = fmaxf(frcp(d.x), 1.f), s1 = fmaxf(frcp(d.y), 1.f);
                        if (p < 2) { w.x = __builtin_amdgcn_cvt_pk_u8_f32(s0, 2 * p, w.x); w.x = __builtin_amdgcn_cvt_pk_u8_f32(s1, 2 * p + 1, w.x); }
                        else { w.y = __builtin_amdgcn_cvt_pk_u8_f32(s0, 2 * p - 4, w.y); w.y = __builtin_amdgcn_cvt_pk_u8_f32(s1, 2 * p - 3, w.y); } }
                    if (bj == 0) w0[g] = w;
                    else *(u32x4*)(Sme + toff + g * 8192) = (u32x4){w0[g].x, w0[g].y, w.x, w.y}; } }
            return;
        }
        const int first = u.br == 0; const unsigned char* Sb = S + (size_t)32768 * 1024;
        unsigned char* mp = MGP + (size_t)(u.pm * 4 + u.pn) * 131072 + (size_t)(((wr * 4 + wc) * 64 + fq * 16 + fr) * 16);
#pragma unroll
        for (int h = 0; h < 2; ++h) { u32x4 ls[4]; u32x4 mv[4][2];
#pragma unroll
            for (int q = 0; q < 4; ++q) { const int g = h * 4 + q;
                ls[q] = *(const u32x4*)(Sb + toff + g * 8192);
                if (!first) { mv[q][0] = *(const u32x4*)(mp + (2 * g) * 8192); mv[q][1] = *(const u32x4*)(mp + (2 * g + 1) * 8192); } else { mv[q][0] = (u32x4){0u, 0u, 0u, 0u}; mv[q][1] = (u32x4){0u, 0u, 0u, 0u}; } }
#pragma unroll
            for (int q = 0; q < 4; ++q) { const int g = h * 4 + q; const size_t off = (size_t)(row0 + h * HALF + q * 16) * 1024 + col0; const u32x2 sv[2] = {{ls[q].x, ls[q].y}, {ls[q].z, ls[q].w}};
#pragma unroll
                for (int bj = 0; bj < 2; ++bj) { float o[8];
#pragma unroll
                    for (int e = 0; e < 8; ++e) { const unsigned sw = e < 4 ? sv[bj].x : sv[bj].y; const float s = ub(sw, e & 3) * (1.f / 255.f);
                        const unsigned mw = mv[q][bj][e >> 1]; const float mprev = (e & 1) ? bfhi(mw) : bflo(mw);
                        o[e] = mprev + s * acc[h][bj][q][e >> 2][e & 3]; }
                    if (first) *(u32x4*)(mp + (2 * g + bj) * 8192) = pack8(o);
                    else *(u32x4*)((unsigned char*)MG + ((size_t)((u.pm * 16 + u.pn * 4 + bj * 2 + (wc >> 1)) * 256 + (wr * 64 + fr + h * HALF + q * 16)) * 128 + (size_t)((wc & 1) * 32 + 8 * fq) * 2)) = pack8(o); } } }
    }
};
struct EpiOut {
    static constexpr bool PERM = true, AFTER_DRAIN = false, HAS_MID = false, HAS_I8 = false; static constexpr int SPLIT_T = 0;
    bf16_t* MO; float* PO;
    __device__ __forceinline__ void operator()(const f32x4 (&acc)[2][2][4][2], const Unit& u, int wr, int wc, int fr_, int fq_) const {
        int fr = fr_, fq = fq_; asm volatile("" : "+v"(fr), "+v"(fq));
        const int row0 = u.pm * BM + wr * 64 + fr, col0 = u.pn * BM + wc * 32 + 8 * fq;
#pragma unroll
        for (int ai = 0; ai < 2; ++ai)
#pragma unroll
            for (int m = 0; m < 4; ++m) { const size_t row = (size_t)(row0 + ai * HALF + m * 16); float ss = 0.f;
#pragma unroll
                for (int bj = 0; bj < 2; ++bj) { float o[8];
#pragma unroll
                    for (int e = 0; e < 8; ++e) { o[e] = acc[ai][bj][m][e >> 2][e & 3]; ss += o[e] * o[e]; }
                    *(u32x4*)(MO + row * 1024 + col0 + bj * HALF) = pack8(o); }
                ss = quad_sum(ss); if (fq == 0) PO[row * 16 + u.pn * 4 + wc] = ss; }
    }
};
template <class Epi, class Sched, bool ALIGN_EPI = false, bool SP2 = false>
__device__ __forceinline__ void gemm_phase(PG8_LAS unsigned char* lds, const Gemm g, const Sched& S, const Epi& E) {
    int tid_ = threadIdx.x; asm volatile("" : "+v"(tid_));
    const int tid = tid_, wid = __builtin_amdgcn_readfirstlane(tid >> 6), lane = tid & 63, wr = wid >> 2, wc = wid & 3, fr = lane & 15, fq = lane >> 4;
    const int K = g.K;
    unsigned voffA[2], voffB[2];
#pragma unroll
    for (int i = 0; i < 2; ++i) { int R, C; stage_rc(tid * 16 + i * 8192, R, C); const int Rb = Epi::PERM ? ((R & ~31) + perm32(R & 31)) : R;
        voffA[i] = (unsigned)(R * g.lda + C) * 2u; voffB[i] = (unsigned)(Rb * K + C) * 2u; }
    const size_t kstep = (size_t)(BK * 2);
    const size_t hstepB = (size_t)HALF * K * 2, hstepA = (size_t)HALF * g.lda * 2;
    const size_t kstepA = g.kstepA ? (size_t)g.kstepA : kstep, tstepA = g.tstepA ? (size_t)g.tstepA : 2 * hstepA, tstepB = 2 * hstepB;
    const unsigned ldsw = (unsigned)wid * 1024u;
    const int aoff = lds_byte(wr * 64 + fr, fq * 8), boff = lds_byte(wc * 32 + fr, fq * 8);
#define PG8_SA(b, h) (((b) * 2 + (h)) * HTB)
#define PG8_SB(b, h) ((4 + (b) * 2 + (h)) * HTB)
#define PG8_STAGE(bufoff, gbase, voff) do { _Pragma("unroll") for (int _i = 0; _i < 2; ++_i) { unsigned vo_ = (voff)[_i]; asm volatile("" : "+v"(vo_));     \
        __builtin_amdgcn_global_load_lds((const unsigned*)((const char*)(gbase) + vo_), (PG8_LAS unsigned*)(lds + (bufoff) + ldsw + _i * 8192), 16, 0, 0); } } while (0)
#define PG8_LDA(dst, b, h) do { _Pragma("unroll") for (int m = 0; m < 4; ++m) _Pragma("unroll") for (int k = 0; k < 2; ++k) dst[m][k] = *(const PG8_LAS bf16x8*)(lds + PG8_SA(b, h) + aoff + m * 2048 + k * 1024); } while (0)
#define PG8_LDB(dst, b, h) do { _Pragma("unroll") for (int n = 0; n < 2; ++n) _Pragma("unroll") for (int k = 0; k < 2; ++k) dst[n][k] = *(const PG8_LAS bf16x8*)(lds + PG8_SB(b, h) + boff + n * 2048 + k * 1024); } while (0)
#define PG8_MMA(ai, bj, At, Bt) do { __builtin_amdgcn_s_setprio(1); _Pragma("unroll") for (int m = 0; m < 4; ++m) _Pragma("unroll") for (int n = 0; n < 2; ++n) _Pragma("unroll") for (int k = 0; k < 2; ++k) \
        acc[ai][bj][m][n] = __builtin_amdgcn_mfma_f32_16x16x32_bf16(Bt[n][k], At[m][k], acc[ai][bj][m][n], 0, 0, 0); __builtin_amdgcn_s_setprio(0); } while (0)
#define PG8_MMA_I8(ai, bj, At, Bt) do { __builtin_amdgcn_s_setprio(1); _Pragma("unroll") for (int m = 0; m < 4; ++m) _Pragma("unroll") for (int n = 0; n < 2; ++n) _Pragma("unroll") for (int k = 0; k < 2; ++k) \
        acc[ai][bj][m][n] = __builtin_bit_cast(f32x4, __builtin_amdgcn_mfma_i32_16x16x64_i8(__builtin_bit_cast(i32x4, Bt[n][k]), __builtin_bit_cast(i32x4, At[m][k]), __builtin_bit_cast(i32x4, acc[ai][bj][m][n]), 0, 0, 0)); __builtin_amdgcn_s_setprio(0); } while (0)
#define PG8_WAIT_V(n) asm volatile("s_waitcnt vmcnt(" #n ")" ::: "memory")
#define PG8_WAIT_L(n) asm volatile("s_waitcnt lgkmcnt(" #n ")" ::: "memory")
#define PG8_BAR __builtin_amdgcn_s_barrier()
#define PG8_SCHED __builtin_amdgcn_sched_barrier(0)
#define PG8_KLOOP(MMAX, T0, T1) \
        for (int t = (T0); t < (T1); t += 2) { \
            const bool last = (t == nt - 2); \
            const char* a1 = cA + (size_t)(t + 1) * kstepA; \
            const char* a2 = last ? nA : cA + (size_t)(t + 2) * kstepA; const char* b2 = last ? nB : cB + (size_t)(t + 2) * kstep; \
            const char* a3 = a2 + kstepA; const char* b3 = b2 + kstep; \
            if (last && has_next) S.a_ready(nxt); \
            if constexpr (Epi::HAS_MID) { if (t == 8 && cur.kind == 2) E.mid(acc, cur, wr, wc, fr, fq); } \
            PG8_LDB(B0, 0, 0); PG8_LDB(B1, 0, 1); PG8_SCHED; PG8_LDA(At, 0, 0); PG8_STAGE(PG8_SA(1, 1), a1 + hstepA, voffA); \
            PG8_WAIT_V(8); PG8_WAIT_L(0); PG8_BAR; MMAX(0, 0, At, B0); MMAX(0, 1, At, B1); PG8_BAR; PG8_SCHED; \
            PG8_LDA(At, 0, 1); PG8_STAGE(PG8_SB(0, 0), b2, voffB); PG8_STAGE(PG8_SB(0, 1), b2 + hstepB, voffB); PG8_STAGE(PG8_SA(0, 0), a2, voffA); \
            PG8_WAIT_V(8); PG8_WAIT_L(0); PG8_BAR; MMAX(1, 0, At, B0); MMAX(1, 1, At, B1); PG8_BAR; PG8_SCHED; \
            PG8_LDB(B0, 1, 0); PG8_LDB(B1, 1, 1); PG8_SCHED; PG8_LDA(At, 1, 0); PG8_STAGE(PG8_SA(0, 1), a2 + hstepA, voffA); \
            PG8_WAIT_V(8); PG8_WAIT_L(0); PG8_BAR; MMAX(0, 0, At, B0); MMAX(0, 1, At, B1); PG8_BAR; PG8_SCHED; \
            PG8_LDA(At, 1, 1); PG8_STAGE(PG8_SB(1, 0), b3, voffB); PG8_STAGE(PG8_SB(1, 1), b3 + hstepB, voffB); PG8_STAGE(PG8_SA(1, 0), a3, voffA); \
            PG8_WAIT_V(8); PG8_WAIT_L(0); PG8_BAR; MMAX(1, 0, At, B0); MMAX(1, 1, At, B1); PG8_BAR; PG8_SCHED; \
        }
    Unit cur, nxt; int ui = 0;
    if (!S.next(0, cur)) return;
    f32x4 acc[2][2][4][2];
#pragma unroll
    for (int a = 0; a < 2; ++a)
#pragma unroll
        for (int b = 0; b < 2; ++b)
#pragma unroll
            for (int m = 0; m < 4; ++m)
#pragma unroll
                for (int n = 0; n < 2; ++n) acc[a][b][m][n] = (f32x4){0.f, 0.f, 0.f, 0.f};
    bf16x8 At[4][2], B0[2][2], B1[2][2];
    const char* cA = (const char*)g.A + (size_t)cur.pm * tstepA + cur.aoff; const char* cB = (const char*)g.Bt + (size_t)cur.pn * tstepB + cur.boff;
    S.a_ready(cur);
    if constexpr (SP2) {
        PG8_STAGE(PG8_SB(0, 0), cB, voffB); PG8_STAGE(PG8_SB(0, 1), cB + hstepB, voffB); PG8_STAGE(PG8_SA(0, 0), cA, voffA); PG8_STAGE(PG8_SA(0, 1), cA + hstepA, voffA);
        if (wr == 1) PG8_BAR;
        PG8_WAIT_V(2); PG8_BAR;
        PG8_STAGE(PG8_SB(1, 0), cB + kstep, voffB); PG8_STAGE(PG8_SA(1, 0), cA + kstepA, voffA); PG8_STAGE(PG8_SB(1, 1), cB + hstepB + kstep, voffB);
        PG8_WAIT_V(6); PG8_BAR;
    } else {
        PG8_STAGE(PG8_SB(0, 0), cB, voffB); PG8_STAGE(PG8_SA(0, 0), cA, voffA); PG8_STAGE(PG8_SB(0, 1), cB + hstepB, voffB); PG8_STAGE(PG8_SA(0, 1), cA + hstepA, voffA);
        if (wr == 1) PG8_BAR;
        PG8_WAIT_V(4); PG8_BAR;
        PG8_STAGE(PG8_SB(1, 0), cB + kstep, voffB); PG8_STAGE(PG8_SA(1, 0), cA + kstepA, voffA); PG8_STAGE(PG8_SB(1, 1), cB + hstepB + kstep, voffB);
        PG8_WAIT_V(6); PG8_BAR;
    }
    for (;;) {
        const bool has_next = S.next(ui + 1, nxt);
        const char* nA = has_next ? (const char*)g.A + (size_t)nxt.pm * tstepA + nxt.aoff : cA; const char* nB = has_next ? (const char*)g.Bt + (size_t)nxt.pn * tstepB + nxt.boff : cB;
        const int nt = cur.nt; const bool i8u = Epi::HAS_I8 && cur.kind == 0;
        static_assert(SP2, "only the two-super-phase K-loop is kept");
        if (Epi::HAS_I8 && i8u) {
            if constexpr (Epi::SPLIT_T > 0) {
                PG8_KLOOP(PG8_MMA_I8, 0, Epi::SPLIT_T) E.dequant(acc, cur, wr, wc, fr, fq); PG8_KLOOP(PG8_MMA, Epi::SPLIT_T, nt)
            } else { PG8_KLOOP(PG8_MMA_I8, 0, nt) }
        } else { PG8_KLOOP(PG8_MMA, 0, nt) }
        if constexpr (ALIGN_EPI) { if (wr == 0) PG8_BAR; }
        if constexpr (!Epi::AFTER_DRAIN) { E(acc, cur, wr, wc, fr, fq); S.done(cur); }
        if (!has_next) break;
#pragma unroll
        for (int a = 0; a < 2; ++a)
#pragma unroll
            for (int b = 0; b < 2; ++b)
#pragma unroll
                for (int m = 0; m < 4; ++m)
#pragma unroll
                    for (int n = 0; n < 2; ++n) acc[a][b][m][n] = (f32x4){0.f, 0.f, 0.f, 0.f};
        cur = nxt; cA = nA; cB = nB; ++ui;
        if constexpr (ALIGN_EPI) { if (wr == 1) PG8_BAR; }
    }
    PG8_WAIT_V(0);
    if constexpr (!ALIGN_EPI) { if (wr == 0) PG8_BAR; }
    PG8_BAR;
    if constexpr (Epi::AFTER_DRAIN) { E.fused(acc, cur, wr, wc, fr, fq, lds, wid, lane); S.done(cur); }
#undef PG8_SA
#undef PG8_SB
#undef PG8_STAGE
#undef PG8_LDA
#undef PG8_LDB
#undef PG8_MMA
#undef PG8_MMA_I8
#undef PG8_KLOOP
#undef PG8_WAIT_V
#undef PG8_WAIT_L
#undef PG8_BAR
#undef PG8_SCHED
}
}

constexpr int NWAVES = 8, NTHREADS = 512;
constexpr int NB = 8, SEQ = 4096, D = 1024, M = NB * SEQ, DEPTH = 2;
constexpr int IN_DIM = 6568, NV_IN = 6656;
constexpr int O_CQ = 0, O_CKV = 256, O_KR = 384, O_GA = 416, O_MQ = 928, O_MK = 1184, O_MV = 1440, O_MI = 1952, O_MF = 1956, O_MO = 1960, O_GB = 2472,
              O_CX = 2984, O_CB = 3496, O_CC = 4008, O_GC = 4520, O_DU = 5032, O_DV = 5544, O_GD = 6056;
constexpr float QSCALE = 0.10206207261596577f * 1.4426950408889634f;
constexpr int N_PHASES = 13;
#ifndef MK_ONE_LAUNCH
#define MK_ONE_LAUNCH 1
#endif
#ifndef MK_PROBE
#define MK_PROBE 0
#endif
#ifndef MK_ATTN_V2
#define MK_ATTN_V2 1
#endif
#ifndef MK_NAIVE_ATTN
#define MK_NAIVE_ATTN 0
#endif
#ifndef MK_NAIVE_MLSTM
#define MK_NAIVE_MLSTM 0
#endif
#ifndef MK_NAIVE_SGU
#define MK_NAIVE_SGU 0
#endif

__host__ __device__ __forceinline__ int map_in(int vc, float& cs) {
    const int t = vc >> 8, j = vc & 255; cs = 1.f;
    if (t == 0) return O_CQ + j;
    if (t == 1) { if (j < 128) return O_CKV + j; const int jp = j - 128;
        if (jp < 32) { const int g = jp >> 3, w = jp & 7; return O_KR + (w < 4 ? 4 * g + w : 16 + 4 * g + (w - 4)); }
        if (jp < 36) return O_MI + (jp - 32); if (jp < 40) return O_MF + (jp - 36); return -1; }
    if (t < 4) return O_GA + 256 * (t - 2) + j;
    if (t == 4) { cs = 0.125f; return O_MQ + j; }
    if (t == 5) return O_MK + j;
    if (t < 8) return O_MV + 256 * (t - 6) + j;
    if (t < 24) { const int kind = (t - 8) >> 2, c0 = ((t - 8) & 3) * 128, jj = j & 127, hi = j >> 7;
        const int a = kind == 0 ? O_MO : kind == 1 ? O_CX : kind == 2 ? O_CB : O_DU, b = kind == 0 ? O_GB : kind == 1 ? O_CC : kind == 2 ? O_GC : O_GD;
        return (hi ? b : a) + c0 + jj; }
    return O_DV + 256 * (t - 24) + j;
}
__host__ __device__ __forceinline__ int map_q(int vc) { if (vc < 512) return (vc >> 6) * 96 + (vc & 63); const int j = vc - 512, hi = j >> 7, jj = j & 127; return (jj >> 4) * 96 + 64 + 16 * hi + (jj & 15); }
__host__ __device__ __forceinline__ int map_kv(int vc) { const int isv = vc >> 9, j = vc & 511; return (j >> 6) * 128 + 64 * isv + (j & 63); }

constexpr size_t MiB = 1u << 20;
constexpr size_t WS_CTL = 0, CTL_ZERO_BYTES = 64 * 1024;
constexpr size_t WS_WB = 1 * MiB;
constexpr size_t WB_IN = 0, WB_GATE = WB_IN + (size_t)NV_IN * 1024 * 2, WB_P = WB_GATE + (size_t)4096 * 1024 * 2  , WB_UQ = WB_P + (size_t)4 * 1024 * 1024 * 2,
                 WB_UKV = WB_UQ + (size_t)768 * 256 * 2, WB_S = WB_UKV + (size_t)1024 * 128 * 2, WB_END = WB_S + (size_t)4 * 128 * 128 * 2;
static_assert(WB_END <= 30 * MiB, "weights");
constexpr size_t WS_H = 31 * MiB  , WS_ZY = WS_H + 2048, WS_ZT = 223 * MiB, WS_Q = 375 * MiB, WS_KN = 423 * MiB, WS_V = 455 * MiB, WS_KR = 487 * MiB;
constexpr size_t WS_ROPE = 489 * MiB, WS_PQ = 493 * MiB, WS_PKV = WS_PQ + MiB / 2, WS_PVS = 494 * MiB, WS_GIF = 496 * MiB, WS_MLS = 497 * MiB, WS_PO = 499 * MiB, WS_MSUM = 501 * MiB, WS_WOUT = 509 * MiB + MiB / 2  , WS_END = 512 * MiB;
constexpr size_t WS_S = WS_ZT, WS_MG = WS_ZT + 64 * MiB, WS_MO = WS_S;
static_assert(WS_ZT + (size_t)M * ZT_LD * 2 <= WS_Q && WS_H + (size_t)M * H_LD * 2 <= WS_ZT && WS_MG + (size_t)M * D * 2 <= WS_Q && WS_WOUT + (size_t)1024 * 1024 * 2 <= WS_END, "ws map");
constexpr int CW_TMO = 0, CW_BAR = 4096;
constexpr size_t WS_RDQ = WS_CTL + 256 * 1024  , WS_CDQ = WS_CTL + 512 * 1024  , WS_CDQI = WS_CTL + 768 * 1024  ;

constexpr int RING_OFF = 0, RING_BYTES = 131072, LDSCTL_OFF = RING_BYTES, MISC_OFF = LDSCTL_OFF + 320, LDS_BYTES = 147456;

#define GAS __attribute__((address_space(1)))
#define LAS __attribute__((address_space(3)))
typedef unsigned short bf16;
typedef unsigned v4u __attribute__((ext_vector_type(4)));
typedef float f32x4 __attribute__((ext_vector_type(4)));
typedef short bf16x8 __attribute__((ext_vector_type(8)));
typedef GAS unsigned gu32;
typedef GAS unsigned long long gu64;
#define RLX_AGENT __ATOMIC_RELAXED, __HIP_MEMORY_SCOPE_AGENT
#define LDS_WAIT() asm volatile("s_waitcnt lgkmcnt(0)" ::: "memory")
#define VM_WAIT() asm volatile("s_waitcnt vmcnt(0)" ::: "memory")
__device__ __forceinline__ unsigned long long rt() { return __builtin_amdgcn_s_memrealtime(); }
__device__ __forceinline__ unsigned f2bf(float f) { unsigned u = __builtin_bit_cast(unsigned, f); return (u + 0x7fffu + ((u >> 16) & 1u)) >> 16; }
__device__ __forceinline__ unsigned pk2(float lo, float hi) { return f2bf(lo) | (f2bf(hi) << 16); }

#define XB_TMO      128
#define XB_XCNT(j)  (256  + 64 * (j))
#define XB_XSUB(j)  (1280 + 64 * (j))
#define XB_XGEN(j)  (2304 + 64 * (j))
#define XB_TOP      3328
#define XB_TOPGEN   3392
#define XCD_BAR_WORDS 3456
#define XB_SPIN_CAP (1u << 18)

__device__ __forceinline__ unsigned xb_ld(unsigned* p)              { return __hip_atomic_load(p, __ATOMIC_RELAXED, __HIP_MEMORY_SCOPE_AGENT); }
__device__ __forceinline__ unsigned xb_add(unsigned* p, unsigned v) { return __hip_atomic_fetch_add(p, v, __ATOMIC_RELAXED, __HIP_MEMORY_SCOPE_AGENT); }
__device__ __forceinline__ unsigned xb_xcc_id() { return (unsigned)__builtin_amdgcn_s_getreg((3 << 11) | 20) & 0xFu; }
#define XB_SPIN(cond, bar) do { unsigned _sp = 0; while (cond) { __builtin_amdgcn_s_sleep(1); \
    if ((++_sp & 255u) == 0u) { if (xb_ld(&(bar)[XB_TMO])) break; if (_sp > XB_SPIN_CAP) { atomicAdd(&(bar)[XB_TMO], 1u); break; } } } } while (0)

struct XcdBarrier {
    unsigned* bar; unsigned x;
    volatile LAS unsigned* st;
};

__device__ __forceinline__ XcdBarrier xcd_barrier_post(unsigned* bar, volatile LAS unsigned* st) {
    XcdBarrier b; b.bar = bar; b.x = xb_xcc_id(); b.st = st;
    if (threadIdx.x == 0) (void)xb_add(&bar[XB_XCNT(b.x)], 1u);
    return b;
}
__device__ __forceinline__ void xcd_barrier_complete(unsigned* bar, unsigned x, unsigned& nloc, unsigned& nx) {
    const unsigned G = gridDim.x * gridDim.y * gridDim.z;
    unsigned sum, cnt, mine, sp = 0u;
    for (;;) {
        sum = 0u; cnt = 0u; mine = 0u;
#pragma unroll
        for (unsigned j = 0; j < 16; ++j) { const unsigned c = xb_ld(&bar[XB_XCNT(j)]); sum += c; cnt += (c > 0u) ? 1u : 0u; mine = (j == x) ? c : mine; }
        if (sum == G) break;
        __builtin_amdgcn_s_sleep(1);
        if ((++sp & 255u) == 0u) { if (xb_ld(&bar[XB_TMO])) break; if (sp > XB_SPIN_CAP) { atomicAdd(&bar[XB_TMO], 1u); break; } }
    }
    nloc = mine > 0u ? mine : 1u; nx = cnt > 0u ? cnt : 1u;
}

__device__ __forceinline__ void xcd_barrier(const XcdBarrier& b) {
    asm volatile("s_waitcnt vmcnt(0)" ::: "memory");
    __syncthreads();
    if (threadIdx.x == 0) {
        unsigned* bar = b.bar;
        __builtin_amdgcn_s_waitcnt(0);
        unsigned nloc = b.st[0], nx = b.st[1];
        if (nloc == 0u) { xcd_barrier_complete(bar, b.x, nloc, nx); b.st[0] = nloc; b.st[1] = nx; }
        const unsigned old = xb_add(&bar[XB_XSUB(b.x)], 1u);
        const unsigned gen = old / nloc;
        if (old + 1u == (gen + 1u) * nloc) {
            __builtin_amdgcn_fence(__ATOMIC_RELEASE, "agent");
            asm volatile("s_waitcnt vmcnt(0)" ::: "memory");
            const unsigned og = xb_add(&bar[XB_TOP], 1u);
            const unsigned tg = og / nx;
            if (og + 1u == (tg + 1u) * nx) xb_add(&bar[XB_TOPGEN], 1u);
            else XB_SPIN(xb_ld(&bar[XB_TOPGEN]) == tg, bar);
            __builtin_amdgcn_fence(__ATOMIC_ACQUIRE, "agent");
            xb_add(&bar[XB_XGEN(b.x)], 1u);
            asm volatile("s_waitcnt vmcnt(0)" ::: "memory");
        } else {
            XB_SPIN(xb_ld(&bar[XB_XGEN(b.x)]) == gen, bar);
            __builtin_amdgcn_fence(__ATOMIC_ACQUIRE, "agent");
            asm volatile("s_waitcnt vmcnt(0)" ::: "memory");
        }
    }
    __syncthreads();
}
namespace att {
using bf16x8 = __attribute__((ext_vector_type(8))) short;
using s16x4  = __attribute__((ext_vector_type(4))) short;
using f32x16 = __attribute__((ext_vector_type(16))) float;
using u32x4  = __attribute__((ext_vector_type(4))) unsigned;
constexpr int NW = 8, QBLK = 32, KVBLK = 64;
constexpr float THR2 = 11.5f;
constexpr int SHM_V = 16384, SHM_K = 16384, SHM_ATTN = 2 * SHM_V + 2 * SHM_K + NW * 64 * 4;
#define KSWZ(row, colB) ((row) * 256 + ((colB) ^ (((row) & 7) << 4)))
#define SBAR() __builtin_amdgcn_sched_barrier(0)
__device__ __forceinline__ int crow(int r, int hi) { return (r & 3) + 8 * (r >> 2) + 4 * hi; }
__device__ __forceinline__ unsigned cvtpk(float lo, float hi) { typedef float f2 __attribute__((ext_vector_type(2))); typedef __bf16 b2 __attribute__((ext_vector_type(2))); f2 v = {lo, hi}; b2 b = __builtin_convertvector(v, b2); return __builtin_bit_cast(unsigned, b); }
__device__ __forceinline__ void partialSM(f32x16& p0, f32x16& p1, float& m_reg, float& mn, float& alpha) {
  float pmax = p0[0];
#pragma unroll
  for (int r = 1; r < 16; ++r) pmax = fmaxf(pmax, p0[r]);
#pragma unroll
  for (int r = 0; r < 16; ++r) pmax = fmaxf(pmax, p1[r]);
  { auto rr = __builtin_amdgcn_permlane32_swap(__float_as_uint(pmax), __float_as_uint(pmax), false, false); pmax = fmaxf(__uint_as_float(rr[0]), __uint_as_float(rr[1])); }
  if (__builtin_expect(__all(pmax - m_reg <= THR2), 1)) { mn = m_reg; alpha = 1.f; }
  else { mn = fmaxf(m_reg, pmax); alpha = __builtin_amdgcn_exp2f(m_reg - mn); m_reg = mn; }
#pragma unroll
  for (int r = 0; r < 16; ++r) p0[r] = p0[r] - mn;
#pragma unroll
  for (int r = 0; r < 16; ++r) p1[r] = p1[r] - mn;
#pragma unroll
  for (int r = 0; r < 16; ++r) p0[r] = __builtin_amdgcn_exp2f(p0[r]);
}
__device__ __forceinline__ void finishSM(f32x16& p0, f32x16& p1, float alpha, float& l_reg, bf16x8& pa0, bf16x8& pa1, bf16x8& pa2, bf16x8& pa3) {
#pragma unroll
  for (int r = 0; r < 16; ++r) p1[r] = __builtin_amdgcn_exp2f(p1[r]);
  float ps = 0;
#pragma unroll
  for (int r = 0; r < 16; ++r) ps += p0[r];
#pragma unroll
  for (int r = 0; r < 16; ++r) ps += p1[r];
  { auto rr = __builtin_amdgcn_permlane32_swap(__float_as_uint(ps), __float_as_uint(ps), false, false); ps = __uint_as_float(rr[0]) + __uint_as_float(rr[1]); }
  l_reg = l_reg * alpha + ps;
#define PK4(P, BASE, OUT) do { unsigned a0 = cvtpk(P[BASE + 0], P[BASE + 1]), a1 = cvtpk(P[BASE + 2], P[BASE + 3]);   \
    unsigned b0 = cvtpk(P[BASE + 4], P[BASE + 5]), b1 = cvtpk(P[BASE + 6], P[BASE + 7]);                              \
    auto r0 = __builtin_amdgcn_permlane32_swap(a0, b0, false, false); auto r1 = __builtin_amdgcn_permlane32_swap(a1, b1, false, false); \
    u32x4 w = {r0[0], r1[0], r0[1], r1[1]}; OUT = __builtin_bit_cast(bf16x8, w); } while (0)
  PK4(p0, 0, pa0); PK4(p0, 8, pa1); PK4(p1, 0, pa2); PK4(p1, 8, pa3);
#undef PK4
}
template <int ND0> __device__ __forceinline__ void qkt(f32x16& p0, f32x16& p1, const char* Ks, const bf16x8* qr, int r32, int hi) {
  bf16x8 kf[2 * ND0];
#pragma unroll
  for (int d0 = 0; d0 < ND0; ++d0) { const int cb = (d0 * 16 + hi * 8) * 2;
    kf[2 * d0] = *reinterpret_cast<const bf16x8*>(Ks + KSWZ(r32, cb)); kf[2 * d0 + 1] = *reinterpret_cast<const bf16x8*>(Ks + KSWZ(32 + r32, cb)); }
  SBAR();
  p0 = f32x16{}; p1 = f32x16{};
#pragma unroll
  for (int d0 = 0; d0 < ND0; ++d0) { p0 = __builtin_amdgcn_mfma_f32_32x32x16_bf16(kf[2 * d0], qr[d0], p0, 0, 0, 0); p1 = __builtin_amdgcn_mfma_f32_32x32x16_bf16(kf[2 * d0 + 1], qr[d0], p1, 0, 0, 0); }
}
__device__ __forceinline__ int v_st(int k, int c) { const int kk = (k & ~0xC) | ((k & 4) << 1) | ((k & 8) >> 1); return ((kk >> 3) * 4 + (c >> 5)) * 512 + ((kk & 7) * 32 + (c & 31)) * 2; }
__device__ __forceinline__ int v_rd_base(int lane) { return ((lane & 3) << 3) | (((lane >> 2) & 3) << 6) | (((lane >> 4) & 1) << 5) | (((lane >> 5) & 1) << 8); }
constexpr int v_rd_off(int d0, int ks, int half) { return d0 * 512 + ks * 4096 + half * 2048; }
template <int OFF> __device__ __forceinline__ s16x4 tr_read(int vb) { s16x4 r; asm volatile("ds_read_b64_tr_b16 %0, %1 offset:%2" : "=&v"(r) : "v"(vb), "i"(OFF) : "memory"); return r; }
template <int D0, bool SWAP> __device__ __forceinline__ void pv_one(f32x16& od, int vb, bf16x8 pa0, bf16x8 pa1, bf16x8 pa2, bf16x8 pa3) {
  const s16x4 l0 = tr_read<v_rd_off(D0, 0, 0)>(vb), h0 = tr_read<v_rd_off(D0, 0, 1)>(vb), l1 = tr_read<v_rd_off(D0, 1, 0)>(vb), h1 = tr_read<v_rd_off(D0, 1, 1)>(vb);
  const s16x4 l2 = tr_read<v_rd_off(D0, 2, 0)>(vb), h2 = tr_read<v_rd_off(D0, 2, 1)>(vb), l3 = tr_read<v_rd_off(D0, 3, 0)>(vb), h3 = tr_read<v_rd_off(D0, 3, 1)>(vb);
  asm volatile("s_waitcnt lgkmcnt(0)" ::: "memory"); SBAR();
#define PK(L, H) (bf16x8){L[0], L[1], L[2], L[3], H[0], H[1], H[2], H[3]}
  if (SWAP) {
    od = __builtin_amdgcn_mfma_f32_32x32x16_bf16(PK(l0, h0), pa0, od, 0, 0, 0); od = __builtin_amdgcn_mfma_f32_32x32x16_bf16(PK(l1, h1), pa1, od, 0, 0, 0);
    od = __builtin_amdgcn_mfma_f32_32x32x16_bf16(PK(l2, h2), pa2, od, 0, 0, 0); od = __builtin_amdgcn_mfma_f32_32x32x16_bf16(PK(l3, h3), pa3, od, 0, 0, 0);
  } else {
    od = __builtin_amdgcn_mfma_f32_32x32x16_bf16(pa0, PK(l0, h0), od, 0, 0, 0); od = __builtin_amdgcn_mfma_f32_32x32x16_bf16(pa1, PK(l1, h1), od, 0, 0, 0);
    od = __builtin_amdgcn_mfma_f32_32x32x16_bf16(pa2, PK(l2, h2), od, 0, 0, 0); od = __builtin_amdgcn_mfma_f32_32x32x16_bf16(pa3, PK(l3, h3), od, 0, 0, 0);
  }
#undef PK
}

__device__ __forceinline__ void pv2(f32x16& o0, f32x16& o1, int vb, bf16x8 pa0, bf16x8 pa1, bf16x8 pa2, bf16x8 pa3) {
  const s16x4 l0 = tr_read<v_rd_off(0, 0, 0)>(vb), h0 = tr_read<v_rd_off(0, 0, 1)>(vb), m0 = tr_read<v_rd_off(1, 0, 0)>(vb), n0 = tr_read<v_rd_off(1, 0, 1)>(vb);
  const s16x4 l1 = tr_read<v_rd_off(0, 1, 0)>(vb), h1 = tr_read<v_rd_off(0, 1, 1)>(vb), m1 = tr_read<v_rd_off(1, 1, 0)>(vb), n1 = tr_read<v_rd_off(1, 1, 1)>(vb);
  const s16x4 l2 = tr_read<v_rd_off(0, 2, 0)>(vb), h2 = tr_read<v_rd_off(0, 2, 1)>(vb), m2 = tr_read<v_rd_off(1, 2, 0)>(vb), n2 = tr_read<v_rd_off(1, 2, 1)>(vb);
  const s16x4 l3 = tr_read<v_rd_off(0, 3, 0)>(vb), h3 = tr_read<v_rd_off(0, 3, 1)>(vb), m3 = tr_read<v_rd_off(1, 3, 0)>(vb), n3 = tr_read<v_rd_off(1, 3, 1)>(vb);
  asm volatile("s_waitcnt lgkmcnt(0)" ::: "memory"); SBAR();
#define PK(L, H) (bf16x8){L[0], L[1], L[2], L[3], H[0], H[1], H[2], H[3]}
  o0 = __builtin_amdgcn_mfma_f32_32x32x16_bf16(pa0, PK(l0, h0), o0, 0, 0, 0); o1 = __builtin_amdgcn_mfma_f32_32x32x16_bf16(pa0, PK(m0, n0), o1, 0, 0, 0);
  o0 = __builtin_amdgcn_mfma_f32_32x32x16_bf16(pa1, PK(l1, h1), o0, 0, 0, 0); o1 = __builtin_amdgcn_mfma_f32_32x32x16_bf16(pa1, PK(m1, n1), o1, 0, 0, 0);
  o0 = __builtin_amdgcn_mfma_f32_32x32x16_bf16(pa2, PK(l2, h2), o0, 0, 0, 0); o1 = __builtin_amdgcn_mfma_f32_32x32x16_bf16(pa2, PK(m2, n2), o1, 0, 0, 0);
  o0 = __builtin_amdgcn_mfma_f32_32x32x16_bf16(pa3, PK(l3, h3), o0, 0, 0, 0); o1 = __builtin_amdgcn_mfma_f32_32x32x16_bf16(pa3, PK(m3, n3), o1, 0, 0, 0);
#undef PK
}
__device__ __forceinline__ void finishSM2(f32x16& p0, f32x16& p1, bf16x8& pa0, bf16x8& pa1, bf16x8& pa2, bf16x8& pa3) {
#pragma unroll
  for (int r = 0; r < 16; ++r) p1[r] = __builtin_amdgcn_exp2f(p1[r]);
#define PK4(P, BASE, OUT) do { unsigned a0 = cvtpk(P[BASE + 0], P[BASE + 1]), a1 = cvtpk(P[BASE + 2], P[BASE + 3]);   \
    unsigned b0 = cvtpk(P[BASE + 4], P[BASE + 5]), b1 = cvtpk(P[BASE + 6], P[BASE + 7]);                              \
    auto r0 = __builtin_amdgcn_permlane32_swap(a0, b0, false, false); auto r1 = __builtin_amdgcn_permlane32_swap(a1, b1, false, false); \
    u32x4 w = {r0[0], r1[0], r0[1], r1[1]}; OUT = __builtin_bit_cast(bf16x8, w); } while (0)
  PK4(p0, 0, pa0); PK4(p0, 8, pa1); PK4(p1, 0, pa2); PK4(p1, 8, pa3);
#undef PK4
}
__device__ __forceinline__ void pv2l(f32x16& o0, f32x16& o1, f32x16& ls, int vb, bf16x8 pa0, bf16x8 pa1, bf16x8 pa2, bf16x8 pa3) {
  const s16x4 l0 = tr_read<v_rd_off(0, 0, 0)>(vb), h0 = tr_read<v_rd_off(0, 0, 1)>(vb), m0 = tr_read<v_rd_off(1, 0, 0)>(vb), n0 = tr_read<v_rd_off(1, 0, 1)>(vb);
  const s16x4 l1 = tr_read<v_rd_off(0, 1, 0)>(vb), h1 = tr_read<v_rd_off(0, 1, 1)>(vb), m1 = tr_read<v_rd_off(1, 1, 0)>(vb), n1 = tr_read<v_rd_off(1, 1, 1)>(vb);
  const s16x4 l2 = tr_read<v_rd_off(0, 2, 0)>(vb), h2 = tr_read<v_rd_off(0, 2, 1)>(vb), m2 = tr_read<v_rd_off(1, 2, 0)>(vb), n2 = tr_read<v_rd_off(1, 2, 1)>(vb);
  const s16x4 l3 = tr_read<v_rd_off(0, 3, 0)>(vb), h3 = tr_read<v_rd_off(0, 3, 1)>(vb), m3 = tr_read<v_rd_off(1, 3, 0)>(vb), n3 = tr_read<v_rd_off(1, 3, 1)>(vb);
  const short one = 0x3f80; const bf16x8 ones = {one, one, one, one, one, one, one, one};
  asm volatile("s_waitcnt lgkmcnt(0)" ::: "memory"); SBAR();
#define PK(L, H) (bf16x8){L[0], L[1], L[2], L[3], H[0], H[1], H[2], H[3]}
  o0 = __builtin_amdgcn_mfma_f32_32x32x16_bf16(pa0, PK(l0, h0), o0, 0, 0, 0); o1 = __builtin_amdgcn_mfma_f32_32x32x16_bf16(pa0, PK(m0, n0), o1, 0, 0, 0); ls = __builtin_amdgcn_mfma_f32_32x32x16_bf16(pa0, ones, ls, 0, 0, 0);
  o0 = __builtin_amdgcn_mfma_f32_32x32x16_bf16(pa1, PK(l1, h1), o0, 0, 0, 0); o1 = __builtin_amdgcn_mfma_f32_32x32x16_bf16(pa1, PK(m1, n1), o1, 0, 0, 0); ls = __builtin_amdgcn_mfma_f32_32x32x16_bf16(pa1, ones, ls, 0, 0, 0);
  o0 = __builtin_amdgcn_mfma_f32_32x32x16_bf16(pa2, PK(l2, h2), o0, 0, 0, 0); o1 = __builtin_amdgcn_mfma_f32_32x32x16_bf16(pa2, PK(m2, n2), o1, 0, 0, 0); ls = __builtin_amdgcn_mfma_f32_32x32x16_bf16(pa2, ones, ls, 0, 0, 0);
  o0 = __builtin_amdgcn_mfma_f32_32x32x16_bf16(pa3, PK(l3, h3), o0, 0, 0, 0); o1 = __builtin_amdgcn_mfma_f32_32x32x16_bf16(pa3, PK(m3, n3), o1, 0, 0, 0); ls = __builtin_amdgcn_mfma_f32_32x32x16_bf16(pa3, ones, ls, 0, 0, 0);
#undef PK
}
__device__ __forceinline__ void pv_kv(f32x16& acc, int vbk, int vbv) {
  const s16x4 al0 = tr_read<v_rd_off(0, 0, 0)>(vbk), ah0 = tr_read<v_rd_off(0, 0, 1)>(vbk), al1 = tr_read<v_rd_off(0, 1, 0)>(vbk), ah1 = tr_read<v_rd_off(0, 1, 1)>(vbk);
  const s16x4 al2 = tr_read<v_rd_off(0, 2, 0)>(vbk), ah2 = tr_read<v_rd_off(0, 2, 1)>(vbk), al3 = tr_read<v_rd_off(0, 3, 0)>(vbk), ah3 = tr_read<v_rd_off(0, 3, 1)>(vbk);
  const s16x4 bl0 = tr_read<v_rd_off(0, 0, 0)>(vbv), bh0 = tr_read<v_rd_off(0, 0, 1)>(vbv), bl1 = tr_read<v_rd_off(0, 1, 0)>(vbv), bh1 = tr_read<v_rd_off(0, 1, 1)>(vbv);
  const s16x4 bl2 = tr_read<v_rd_off(0, 2, 0)>(vbv), bh2 = tr_read<v_rd_off(0, 2, 1)>(vbv), bl3 = tr_read<v_rd_off(0, 3, 0)>(vbv), bh3 = tr_read<v_rd_off(0, 3, 1)>(vbv);
  asm volatile("s_waitcnt lgkmcnt(0)" ::: "memory"); SBAR();
#define PK(L, H) (bf16x8){L[0], L[1], L[2], L[3], H[0], H[1], H[2], H[3]}
  acc = __builtin_amdgcn_mfma_f32_32x32x16_bf16(PK(al0, ah0), PK(bl0, bh0), acc, 0, 0, 0); acc = __builtin_amdgcn_mfma_f32_32x32x16_bf16(PK(al1, ah1), PK(bl1, bh1), acc, 0, 0, 0);
  acc = __builtin_amdgcn_mfma_f32_32x32x16_bf16(PK(al2, ah2), PK(bl2, bh2), acc, 0, 0, 0); acc = __builtin_amdgcn_mfma_f32_32x32x16_bf16(PK(al3, ah3), PK(bl3, bh3), acc, 0, 0, 0);
#undef PK
}
__device__ __forceinline__ void attn_unit(int b, int h, int qb, const bf16* Q, const bf16* __restrict__ KN, const bf16* __restrict__ KR, const bf16* __restrict__ V, bf16* Y, char* lds) {
  int tid = threadIdx.x; asm volatile("" : "+v"(tid));
  const int wid = __builtin_amdgcn_readfirstlane(tid >> 6), lane = tid & 63, r32 = lane & 31, hi = lane >> 5;
  char* V_lds = lds; char* K_lds = lds + 2 * SHM_V;
  float* ws = (float*)(lds + 2 * SHM_V + 2 * SHM_K) + wid * 64; float* li_l = ws; float* al_l = ws + 32;
  float m_reg = -1e30f, l_reg = 0; f32x16 o[2] = {}; bf16x8 qr[6];
  const size_t rowbase = (size_t)b * SEQ; const int q0 = qb * 256;
  const bf16* Qw = Q + (rowbase + q0 + wid * QBLK + r32) * 768 + h * 96 + hi * 8;
#pragma unroll
  for (int d0 = 0; d0 < 6; ++d0) qr[d0] = *reinterpret_cast<const bf16x8*>(Qw + d0 * 16);
  const int sr = tid >> 4, sc = (tid & 15) * 8, vst0 = v_st(sr, sc & 63), vst1 = v_st(32 + sr, sc & 63);
  const bool doK = sc < 96, doV = sc < 64;
  const bf16* ksrc = sc < 64 ? KN + rowbase * 512 + h * 64 + sc : KR + rowbase * 32 + (sc - 64); const int kld = sc < 64 ? 512 : 32;
  const bf16* vsrc = V + rowbase * 512 + h * 64 + (sc & 63);
  const int vb0 = (int)(uintptr_t)V_lds + v_rd_base(lane);
  struct { bf16x8 vs0, vs1, ks0, ks1; } sr_[2];
#define SLOAD(i, k0) do { if (doV) { sr_[i].vs0 = *(const bf16x8*)(vsrc + (size_t)((k0) + sr) * 512); sr_[i].vs1 = *(const bf16x8*)(vsrc + (size_t)((k0) + 32 + sr) * 512); } \
    if (doK) { sr_[i].ks0 = *(const bf16x8*)(ksrc + (size_t)((k0) + sr) * kld); sr_[i].ks1 = *(const bf16x8*)(ksrc + (size_t)((k0) + 32 + sr) * kld); } } while (0)
#define SWRITE(bb, i) do { if (doV) { *(bf16x8*)(V_lds + (bb) * SHM_V + vst0) = sr_[i].vs0; *(bf16x8*)(V_lds + (bb) * SHM_V + vst1) = sr_[i].vs1; } \
    if (doK) { const int kc = sc * 2; *(bf16x8*)(K_lds + (bb) * SHM_K + KSWZ(sr, kc)) = sr_[i].ks0; *(bf16x8*)(K_lds + (bb) * SHM_K + KSWZ(32 + sr, kc)) = sr_[i].ks1; } } while (0)
#define SWAIT() asm volatile("s_waitcnt vmcnt(4)" ::: "memory")
#define RESC(a) do { if (__any((a) < 1.f)) { if (hi == 0) al_l[r32] = (a); asm volatile("s_waitcnt lgkmcnt(0)" ::: "memory"); \
    _Pragma("unroll") for (int d = 0; d < 2; ++d) _Pragma("unroll") for (int r = 0; r < 16; ++r) o[d][r] *= al_l[crow(r, hi)]; } } while (0)
#define MASK(P0, P1, j) do { if ((j) >= NTw) { _Pragma("unroll") for (int r = 0; r < 16; ++r) { P0[r] = -INFINITY; P1[r] = -INFINITY; } } } while (0)
  f32x16 pA0, pA1, pB0, pB1; float mnA, mnB, alA, alB; bf16x8 pa0, pa1, pa2, pa3;
  const int NT = 4 * qb + 4, NTw = 4 * qb + (wid >> 1) + 1;
  constexpr int SE = 0, SO = 1;
  SLOAD(SE, 0); asm volatile("s_waitcnt vmcnt(0)" ::: "memory"); SWRITE(0, SE); __syncthreads();
  qkt<6>(pA0, pA1, K_lds, qr, r32, hi); partialSM(pA0, pA1, m_reg, mnA, alA);
  SLOAD(SO, KVBLK); if (2 < NT) SLOAD(SE, 2 * KVBLK);
  SWAIT(); SWRITE(1, SO); __syncthreads();
  for (int j = 1; j + 1 < NT; j += 2) {
    SBAR(); qkt<6>(pB0, pB1, K_lds + SHM_K, qr, r32, hi); MASK(pB0, pB1, j);
    finishSM(pA0, pA1, alA, l_reg, pa0, pa1, pa2, pa3); SBAR();
    SLOAD(SO, (j + 2) * KVBLK); SBAR();
    pv_one<0, false>(o[0], vb0, pa0, pa1, pa2, pa3); pv_one<1, false>(o[1], vb0, pa0, pa1, pa2, pa3); partialSM(pB0, pB1, m_reg, mnB, alB);
    __syncthreads(); SWAIT(); SWRITE(0, SE);
    RESC(alB); __syncthreads();
    SBAR(); qkt<6>(pA0, pA1, K_lds, qr, r32, hi); MASK(pA0, pA1, j + 1);
    finishSM(pB0, pB1, alB, l_reg, pa0, pa1, pa2, pa3); SBAR();
    if (j + 3 < NT) SLOAD(SE, (j + 3) * KVBLK); SBAR();
    pv_one<0, false>(o[0], vb0 + SHM_V, pa0, pa1, pa2, pa3); pv_one<1, false>(o[1], vb0 + SHM_V, pa0, pa1, pa2, pa3); partialSM(pA0, pA1, m_reg, mnA, alA);
    __syncthreads(); SWAIT(); SWRITE(1, SO);
    RESC(alA); __syncthreads();
  }
  SBAR(); qkt<6>(pB0, pB1, K_lds + SHM_K, qr, r32, hi); MASK(pB0, pB1, NT - 1);
  finishSM(pA0, pA1, alA, l_reg, pa0, pa1, pa2, pa3); SBAR();
  pv_one<0, false>(o[0], vb0, pa0, pa1, pa2, pa3); pv_one<1, false>(o[1], vb0, pa0, pa1, pa2, pa3); partialSM(pB0, pB1, m_reg, mnB, alB);
  __syncthreads(); RESC(alB);
  finishSM(pB0, pB1, alB, l_reg, pa0, pa1, pa2, pa3); SBAR();
  pv_one<0, false>(o[0], vb0 + SHM_V, pa0, pa1, pa2, pa3); pv_one<1, false>(o[1], vb0 + SHM_V, pa0, pa1, pa2, pa3);
  if (hi == 0) li_l[r32] = l_reg; asm volatile("s_waitcnt lgkmcnt(0)" ::: "memory");
  bf16* Yw = Y + (rowbase + q0 + wid * QBLK) * ZY_LD + YA + h * 64;
#pragma unroll
  for (int r = 0; r < 16; ++r) { const int orow = crow(r, hi); const float rl = __builtin_amdgcn_rcpf(li_l[orow]);
#pragma unroll
    for (int d0 = 0; d0 < 2; ++d0) { bf16* p = Yw + (size_t)orow * ZY_LD + d0 * 32 + r32; const float g = __uint_as_float((unsigned)*p << 16); *p = (bf16)f2bf(o[d0][r] * rl * g); } }
  __syncthreads();
#undef SLOAD
#undef SWRITE
#undef SWAIT
#undef RESC
#undef MASK
}

__device__ __forceinline__ void glds16(const void* gsrc, unsigned lds_dst) { unsigned keep;
  asm volatile("s_mov_b32 %0, m0\n\ts_mov_b32 m0, %2\n\ts_nop 0\n\tglobal_load_lds_dwordx4 %1, off\n\ts_mov_b32 m0, %0" : "=&s"(keep) : "v"(gsrc), "s"(lds_dst) : "memory"); }
#define WAIT_BAR(N) asm volatile("s_waitcnt vmcnt(" #N ") lgkmcnt(0)\n\ts_barrier" ::: "memory")
template <int ND0> __device__ __forceinline__ void qkt_c(f32x16& p0, f32x16& p1, const f32x16& c, const char* Ks, const bf16x8* qr, int r32, int hi) {
  bf16x8 kf[2 * ND0];
#pragma unroll
  for (int d0 = 0; d0 < ND0; ++d0) { const int cb = (d0 * 16 + hi * 8) * 2;
    kf[2 * d0] = *reinterpret_cast<const bf16x8*>(Ks + KSWZ(r32, cb)); kf[2 * d0 + 1] = *reinterpret_cast<const bf16x8*>(Ks + KSWZ(32 + r32, cb)); }
  SBAR();
#pragma unroll
  for (int d0 = 0; d0 < ND0; ++d0) {
    if (d0 == 0) { p0 = __builtin_amdgcn_mfma_f32_32x32x16_bf16(kf[0], qr[0], c, 0, 0, 0); p1 = __builtin_amdgcn_mfma_f32_32x32x16_bf16(kf[1], qr[0], c, 0, 0, 0); }
    else { p0 = __builtin_amdgcn_mfma_f32_32x32x16_bf16(kf[2 * d0], qr[d0], p0, 0, 0, 0); p1 = __builtin_amdgcn_mfma_f32_32x32x16_bf16(kf[2 * d0 + 1], qr[d0], p1, 0, 0, 0); } }
}
__device__ __forceinline__ void partialSM2(f32x16& p0, f32x16& p1, float& m_reg, f32x16& negm, float& alpha, bool first) {
  float pmax = p0[0];
#pragma unroll
  for (int r = 1; r < 16; ++r) pmax = fmaxf(pmax, p0[r]);
#pragma unroll
  for (int r = 0; r < 16; ++r) pmax = fmaxf(pmax, p1[r]);
  { auto rr = __builtin_amdgcn_permlane32_swap(__float_as_uint(pmax), __float_as_uint(pmax), false, false); pmax = fmaxf(__uint_as_float(rr[0]), __uint_as_float(rr[1])); }
  alpha = 1.f;
  if (__builtin_expect(first || __any(pmax > THR2), 0)) { const float dl = first ? pmax : fmaxf(pmax, 0.f); m_reg += dl; alpha = __builtin_amdgcn_exp2f(-dl);
#pragma unroll
    for (int r = 0; r < 16; ++r) { p0[r] -= dl; p1[r] -= dl; negm[r] = -m_reg; } }
#pragma unroll
  for (int r = 0; r < 16; ++r) p0[r] = __builtin_amdgcn_exp2f(p0[r]);
}

__device__ __forceinline__ void attn_unit2(int b, int h, int qb, const bf16* Q, const bf16* __restrict__ KN, const bf16* __restrict__ KR, const bf16* __restrict__ V, bf16* Y, char* lds) {
  int tid = threadIdx.x; asm volatile("" : "+v"(tid));
  const int wid = __builtin_amdgcn_readfirstlane(tid >> 6), lane = tid & 63, r32 = lane & 31, hi = lane >> 5;
  constexpr int OFF_K = 0, OFF_V = 3 * SHM_K, OFF_WS = 3 * SHM_K + 3 * SHM_V;
  const unsigned lds0 = (unsigned)(uintptr_t)lds;
  float* ws = (float*)(lds + OFF_WS) + wid * 64; float* li_l = ws; float* al_l = ws + 32;
  const size_t rowbase = (size_t)b * SEQ; const int q0 = qb * 256;
  bf16x8 qr[6];
  const bf16* ksrc[2]; bool kval[2];
#pragma unroll
  for (int i = 0; i < 2; ++i) { const int row = 8 * wid + 4 * i + (lane >> 4), gc = (lane & 15) ^ (row & 7); kval[i] = gc < 12;
    ksrc[i] = gc < 8 ? KN + (rowbase + row) * 512 + h * 64 + gc * 8 : KR + (rowbase + row) * 32 + ((gc - 8) & 3) * 8; }
  const int kstr0 = 512 * 64, kstr1 = 32 * 64;
  const bf16* vsrc; { const int kk = 8 * wid + ((lane & 31) >> 2), k = (kk & ~0xC) | ((kk & 4) << 1) | ((kk & 8) >> 1); vsrc = V + (rowbase + k) * 512 + h * 64 + (lane >> 5) * 32 + (lane & 3) * 8; }
  const unsigned kdst = lds0 + OFF_K + wid * 2048, vdst = lds0 + OFF_V + wid * 2048;
#define DMA_K(t, slot) do { _Pragma("unroll") for (int i_ = 0; i_ < 2; ++i_) { const bool isn = ((lane & 15) ^ ((4 * i_ + (lane >> 4)) & 7)) < 8; \
    if (kval[i_]) glds16(ksrc[i_] + (size_t)(t) * (isn ? kstr0 : kstr1), (unsigned)__builtin_amdgcn_readfirstlane(kdst + (slot) * SHM_K + i_ * 1024)); } } while (0)
#define DMA_V(t, slot) glds16(vsrc + (size_t)(t) * (512 * 64), (unsigned)__builtin_amdgcn_readfirstlane(vdst + (slot) * SHM_V))
  const int vb0 = (int)(lds0 + OFF_V) + v_rd_base(lane);
  float m_reg = 0.f; f32x16 o[2] = {}; f32x16 lacc = {}; f32x16 negm = {}; asm volatile("" : "+v"(negm));
  f32x16 pA0, pA1, pB0, pB1; float alA = 1.f, alB = 1.f; bf16x8 pa0, pa1, pa2, pa3;
  const int NT = 4 * qb + 4, NTw = 4 * qb + (wid >> 1) + 1;
#define RESC(a) do { if (__any((a) < 1.f)) { if (hi == 0) al_l[r32] = (a); asm volatile("s_waitcnt lgkmcnt(0)" ::: "memory"); \
    _Pragma("unroll") for (int r = 0; r < 16; ++r) { const float f_ = al_l[crow(r, hi)]; o[0][r] *= f_; o[1][r] *= f_; lacc[r] *= f_; } } } while (0)
  int sk = 0, sv = 2;
#define ROT3(s) ((s) == 2 ? 0 : (s) + 1)
#define STEP(C0, C1, ALC, P0, P1, ALP, t, FIRST) do { \
    const int nk_ = ((t) + 2 < NT) ? 2 : 0, nv_ = ((t) + 1 < NT) ? 1 : 0; \
    if (nk_) DMA_K((t) + 2, (sk == 0 ? 2 : sk - 1)); if (nv_) DMA_V((t) + 1, (sv == 0 ? 2 : sv - 1)); \
    const bool vc_ = (t) < NTw, vp_ = !(FIRST) && ((t) - 1) < NTw; \
    if (vc_) { SBAR(); qkt_c<6>(C0, C1, negm, lds + OFF_K + sk * SHM_K, qr, r32, hi); } \
    if (vp_) { finishSM2(P0, P1, pa0, pa1, pa2, pa3); SBAR(); pv2l(o[0], o[1], lacc, vb0 + sv * SHM_V, pa0, pa1, pa2, pa3); } \
    if (vc_) { partialSM2(C0, C1, m_reg, negm, ALC, (FIRST)); RESC(ALC); } \
    if (nk_ + nv_ == 3) WAIT_BAR(3); else if (nk_ + nv_ == 1) WAIT_BAR(1); else WAIT_BAR(0); \
    sk = ROT3(sk); sv = ROT3(sv); } while (0)
  DMA_K(0, 0); DMA_V(0, 0); DMA_K(1, 1);
  { const bf16* Qw = Q + (rowbase + q0 + wid * QBLK + r32) * 768 + h * 96 + hi * 8;
#pragma unroll
    for (int d0 = 0; d0 < 6; ++d0) qr[d0] = *reinterpret_cast<const bf16x8*>(Qw + d0 * 16);
#pragma unroll
    for (int d0 = 0; d0 < 6; ++d0) asm volatile("" : "+v"(qr[d0])); }
  WAIT_BAR(0);
  STEP(pA0, pA1, alA, pB0, pB1, alB, 0, true);
  for (int t = 1; t + 1 < NT; t += 2) {
    STEP(pB0, pB1, alB, pA0, pA1, alA, t, false);
    STEP(pA0, pA1, alA, pB0, pB1, alB, t + 1, false);
  }
  STEP(pB0, pB1, alB, pA0, pA1, alA, NT - 1, false);
  if (NT - 1 < NTw) { finishSM2(pB0, pB1, pa0, pa1, pa2, pa3); SBAR(); pv2l(o[0], o[1], lacc, vb0 + sv * SHM_V, pa0, pa1, pa2, pa3); }
  asm volatile("s_waitcnt vmcnt(0) lgkmcnt(0)\n\ts_barrier" ::: "memory");
  { char* T = lds + OFF_K + wid * 4608;
    const size_t yr0 = rowbase + q0 + wid * QBLK; const int yc0 = 1024 + YA + h * 64;
    typedef unsigned u32x4a __attribute__((ext_vector_type(4)));
    u32x4a gv[4];
#pragma unroll
    for (int i = 0; i < 4; ++i) { const int c = lane + 64 * i; gv[i] = *(const u32x4a*)(Y + hz_off(yr0 + (c >> 3), yc0 + (c & 7) * 8)); }
#pragma unroll
    for (int r = 0; r < 16; ++r) { const int orow = crow(r, hi); const float rl = __builtin_amdgcn_rcpf(lacc[r]);
#pragma unroll
      for (int d0 = 0; d0 < 2; ++d0) *(bf16*)(T + orow * 144 + (d0 * 32 + r32) * 2) = (bf16)f2bf(o[d0][r] * rl); }
    asm volatile("s_waitcnt lgkmcnt(0)" ::: "memory");
#pragma unroll
    for (int i = 0; i < 4; ++i) { const int c = lane + 64 * i; const u32x4a tv = *(const u32x4a*)(T + (c >> 3) * 144 + (c & 7) * 16); u32x4a ov;
#pragma unroll
      for (int k = 0; k < 4; ++k) { const float lo = __uint_as_float(tv[k] << 16) * __uint_as_float(gv[i][k] << 16), hi2 = __uint_as_float(tv[k] & 0xffff0000u) * __uint_as_float(gv[i][k] & 0xffff0000u);
        ov[k] = (unsigned)f2bf(lo) | ((unsigned)f2bf(hi2) << 16); }
      *(u32x4a*)(Y + hz_off(yr0 + (c >> 3), yc0 + (c & 7) * 8)) = ov; } }
  asm volatile("s_waitcnt vmcnt(0) lgkmcnt(0)\n\ts_barrier" ::: "memory");
#undef DMA_K
#undef DMA_V
#undef RESC
#undef ROT3
#undef STEP
}
#undef WAIT_BAR
#undef KSWZ
#undef SBAR
}
namespace mls {
using att::bf16x8; using att::s16x4; using att::f32x16; using att::u32x4;
typedef unsigned u32x2g __attribute__((ext_vector_type(2)));
__device__ __forceinline__ float blo(unsigned w) { return __uint_as_float(w << 16); }
__device__ __forceinline__ float bhi(unsigned w) { return __uint_as_float(w & 0xffff0000u); }
constexpr int SHM_V = 16384, SHM_K = 16384, SHM_AP = 256, OFF_ST = 2 * SHM_V + 2 * SHM_K + 2 * SHM_AP + 512  , OFF_NS = OFF_ST + 16384, OFF_MX = OFF_NS + 256, SHM_TOT = OFF_MX + 64;
#define KSWZ(row, colB) ((row) * 256 + ((colB) ^ (((row) & 7) << 4)))
__device__ __forceinline__ void mlstm_unit(int b, int h, int qb, const bf16* __restrict__ ZT, const float* __restrict__ MLS, const float* __restrict__ gmh, const bf16* __restrict__ CK, const float* __restrict__ NK, const float* __restrict__ ML, bf16* Y, char* lds) {
  int tid = threadIdx.x; asm volatile("" : "+v"(tid));
  const int wid = __builtin_amdgcn_readfirstlane(tid >> 6), lane = tid & 63, r32 = lane & 31, hi = lane >> 5;
  char* V_lds = lds; char* K_lds = lds + 2 * SHM_V; float* AP = (float*)(lds + 2 * SHM_V + 2 * SHM_K);
  const size_t rowbase = (size_t)b * SEQ; const int q0 = qb * 256, tq = q0 + wid * 32 + r32; const size_t qrow = rowbase + tq;
  bf16x8 qr[4];
#pragma unroll
  for (int d0 = 0; d0 < 4; ++d0) qr[d0] = *reinterpret_cast<const bf16x8*>(ZT + qrow * ZT_LD + ZT_MQ + h * 64 + d0 * 16 + hi * 8);
  const f32x4 me = *(const f32x4*)(MLS + (qrow * 4 + h) * 4); const float At2 = me.y * 1.4426950409f, mt = me.z;
  const int sr = tid >> 4, sc = (tid & 15) * 8, vst0 = att::v_st(sr, sc), vst1 = att::v_st(32 + sr, sc); const bool doK = sc < 64;
  const bf16* ksrc = ZT + rowbase * ZT_LD + ZT_MK + h * 64 + (sc & 63); const bf16* vsrc = ZT + rowbase * ZT_LD + ZT_MV + h * 128 + sc;
  const int vb0 = (int)(uintptr_t)V_lds + att::v_rd_base(lane);
  bf16x8 vs0, vs1, ks0, ks1; float aps = 0.f;
#define SLOAD(k0) do { vs0 = *(const bf16x8*)(vsrc + (size_t)((k0) + sr) * ZT_LD); vs1 = *(const bf16x8*)(vsrc + (size_t)((k0) + 32 + sr) * ZT_LD); \
    if (doK) { ks0 = *(const bf16x8*)(ksrc + (size_t)((k0) + sr) * ZT_LD); ks1 = *(const bf16x8*)(ksrc + (size_t)((k0) + 32 + sr) * ZT_LD); } \
    if (tid < 64) aps = MLS[((rowbase + (k0) + tid) * 4 + h) * 4] * 1.4426950409f; } while (0)
#define SWRITE(bb) do { *(bf16x8*)(V_lds + (bb) * SHM_V + vst0) = vs0; *(bf16x8*)(V_lds + (bb) * SHM_V + vst1) = vs1; \
    if (doK) { const int kc = sc * 2; *(bf16x8*)(K_lds + (bb) * SHM_K + KSWZ(sr, kc)) = ks0; *(bf16x8*)(K_lds + (bb) * SHM_K + KSWZ(32 + sr, kc)) = ks1; } \
    if (tid < 64) AP[(bb) * 64 + tid] = aps; } while (0)
  f32x16 o[4] = {}; float den = 0.f;
  const int J0 = 4 * qb, NT = 4 * qb + 4, jd = 4 * qb + (wid >> 1);
  SLOAD(J0 * 64);
  if (qb > 0) {
    float* MX = (float*)(lds + OFF_MX); float* NS = (float*)(lds + OFF_NS); const int u0 = (b * 4 + h) * 16;
    if (tid < 16) { float Mj = -INFINITY; if (tid < qb) { float Bst = 0.f; if (tid > 0) { const f32x4 pr = *(const f32x4*)(MLS + ((rowbase + tid * 256 - 1) * 4 + h) * 4); Bst = pr.z - pr.y; } Mj = ML[u0 + tid] - Bst; } MX[tid] = Mj * 1.4426950409f; }
    __syncthreads();
    float Mp = MX[0];
    for (int j = 1; j < qb; ++j) Mp = fmaxf(Mp, MX[j]);
    float c0[8], c1[8]; float ns = 0.f;
#pragma unroll
    for (int e = 0; e < 8; ++e) { c0[e] = 0.f; c1[e] = 0.f; }
    for (int j0 = 0; j0 < qb; j0 += 4) {
      v4u x0[4], x1[4]; float fj[4], nk[4];
#pragma unroll
      for (int d = 0; d < 4; ++d) { const int j = j0 + d; const bool ok = j < qb; const int jj = ok ? j : j0; fj[d] = ok ? __builtin_amdgcn_exp2f(MX[jj] - Mp) : 0.f;
        const bf16* cj = CK + (size_t)(u0 + jj) * 8192 + sc; x0[d] = *(const v4u*)(cj + sr * 128); x1[d] = *(const v4u*)(cj + (32 + sr) * 128); nk[d] = tid < 64 ? NK[(u0 + jj) * 64 + tid] : 0.f; }
#pragma unroll
      for (int d = 0; d < 4; ++d) { const float f = fj[d];
#pragma unroll
        for (int k = 0; k < 4; ++k) { c0[2 * k] += f * blo(x0[d][k]); c0[2 * k + 1] += f * bhi(x0[d][k]); c1[2 * k] += f * blo(x1[d][k]); c1[2 * k + 1] += f * bhi(x1[d][k]); }
        ns += f * nk[d]; } }
    { v4u w0, w1;
#pragma unroll
      for (int k = 0; k < 4; ++k) { w0[k] = pk2(c0[2 * k], c0[2 * k + 1]); w1[k] = pk2(c1[2 * k], c1[2 * k + 1]); }
      *(v4u*)(lds + OFF_ST + vst0) = w0; *(v4u*)(lds + OFF_ST + vst1) = w1; if (tid < 64) NS[tid] = ns; }
    __syncthreads();
    const float ft = __builtin_amdgcn_exp2f(Mp - At2); bf16x8 qs[4]; float dn = 0.f;
#pragma unroll
    for (int d0 = 0; d0 < 4; ++d0) { const u32x4 qw = __builtin_bit_cast(u32x4, qr[d0]); u32x4 sw; const f32x4 n0 = *(const f32x4*)(NS + 16 * d0 + 8 * hi), n1 = *(const f32x4*)(NS + 16 * d0 + 8 * hi + 4);
      const float nn[8] = {n0[0], n0[1], n0[2], n0[3], n1[0], n1[1], n1[2], n1[3]};
#pragma unroll
      for (int k = 0; k < 4; ++k) { const float a = blo(qw[k]), c = bhi(qw[k]); dn += a * nn[2 * k] + c * nn[2 * k + 1]; sw[k] = pk2(ft * a, ft * c); }
      qs[d0] = __builtin_bit_cast(bf16x8, sw); }
    den += ft * dn;
    const int vbs = (int)(uintptr_t)(lds + OFF_ST) + att::v_rd_base(lane);
    att::pv_one<0, true>(o[0], vbs, qs[0], qs[1], qs[2], qs[3]); att::pv_one<1, true>(o[1], vbs, qs[0], qs[1], qs[2], qs[3]);
    att::pv_one<2, true>(o[2], vbs, qs[0], qs[1], qs[2], qs[3]); att::pv_one<3, true>(o[3], vbs, qs[0], qs[1], qs[2], qs[3]);
  }
  SWRITE(J0 & 1); __syncthreads();
  for (int j = J0; j < NT; ++j) { const int bb = j & 1;
    if (j + 1 < NT) SLOAD((j + 1) * 64);
    if (j <= jd) {
      f32x16 p0, p1; att::qkt<4>(p0, p1, K_lds + bb * SHM_K, qr, r32, hi);
      const float* ap = AP + bb * 64;
#pragma unroll
      for (int g = 0; g < 4; ++g) { const f32x4 a0 = *(const f32x4*)(ap + 8 * g + 4 * hi), a1 = *(const f32x4*)(ap + 32 + 8 * g + 4 * hi);
#pragma unroll
        for (int e = 0; e < 4; ++e) { p0[4 * g + e] *= __builtin_amdgcn_exp2f(a0[e] - At2); p1[4 * g + e] *= __builtin_amdgcn_exp2f(a1[e] - At2); } }
      if (j == jd) { const int kb = 64 * j + 4 * hi;
#pragma unroll
        for (int r = 0; r < 16; ++r) { const int kv = kb + (r & 3) + 8 * (r >> 2); if (kv > tq) p0[r] = 0.f; if (kv + 32 > tq) p1[r] = 0.f; } }
      float ps = 0.f;
#pragma unroll
      for (int r = 0; r < 16; ++r) ps += p0[r] + p1[r];
      den += ps;
      bf16x8 pa0, pa1, pa2, pa3;
#define PK4(P, BASE, OUT) do { unsigned a0_ = att::cvtpk(P[BASE + 0], P[BASE + 1]), a1_ = att::cvtpk(P[BASE + 2], P[BASE + 3]);   \
    unsigned b0_ = att::cvtpk(P[BASE + 4], P[BASE + 5]), b1_ = att::cvtpk(P[BASE + 6], P[BASE + 7]);                              \
    auto r0 = __builtin_amdgcn_permlane32_swap(a0_, b0_, false, false); auto r1 = __builtin_amdgcn_permlane32_swap(a1_, b1_, false, false); \
    u32x4 w = {r0[0], r1[0], r0[1], r1[1]}; OUT = __builtin_bit_cast(bf16x8, w); } while (0)
      PK4(p0, 0, pa0); PK4(p0, 8, pa1); PK4(p1, 0, pa2); PK4(p1, 8, pa3);
#undef PK4
      const int vb = vb0 + bb * SHM_V;
      att::pv_one<0, true>(o[0], vb, pa0, pa1, pa2, pa3); att::pv_one<1, true>(o[1], vb, pa0, pa1, pa2, pa3);
      att::pv_one<2, true>(o[2], vb, pa0, pa1, pa2, pa3); att::pv_one<3, true>(o[3], vb, pa0, pa1, pa2, pa3);
    }
    if (j + 1 < NT) SWRITE(bb ^ 1);
    __syncthreads();
  }
  { auto rr = __builtin_amdgcn_permlane32_swap(__float_as_uint(den), __float_as_uint(den), false, false); den = __uint_as_float(rr[0]) + __uint_as_float(rr[1]); }
  const float rd = __builtin_amdgcn_rcpf(fmaxf(fabsf(den), __builtin_amdgcn_exp2f(-mt * 1.4426950409f)));
  float ss = 0.f;
#pragma unroll
  for (int d = 0; d < 4; ++d)
#pragma unroll
    for (int r = 0; r < 16; ++r) ss += o[d][r] * o[d][r];
  { auto rr = __builtin_amdgcn_permlane32_swap(__float_as_uint(ss), __float_as_uint(ss), false, false); ss = __uint_as_float(rr[0]) + __uint_as_float(rr[1]); }
  const float rn = rd * __builtin_amdgcn_rsqf(rd * rd * ss * (1.f / 128.f) + RMS_EPS);
  { const float* gm = gmh + h * 128; char* T = lds + wid * 8704;
    const size_t yr0 = rowbase + q0 + wid * 32; const int yc0 = 1024 + YB + h * 128;
    typedef unsigned u32x4m __attribute__((ext_vector_type(4)));
    u32x4m og[8];
#pragma unroll
    for (int i = 0; i < 8; ++i) { const int c = lane + 64 * i; og[i] = *(const u32x4m*)(Y + hz_off(yr0 + (c >> 4), yc0 + (c & 15) * 8)); }
#pragma unroll
    for (int d = 0; d < 4; ++d)
#pragma unroll
      for (int g = 0; g < 4; ++g) { const int c = 32 * d + 8 * g + 4 * hi; const f32x4 gv = *(const f32x4*)(gm + c); u32x2g w;
        w.x = pk2(o[d][4 * g] * rn * gv[0], o[d][4 * g + 1] * rn * gv[1]); w.y = pk2(o[d][4 * g + 2] * rn * gv[2], o[d][4 * g + 3] * rn * gv[3]);
        *(u32x2g*)(T + r32 * 272 + c * 2) = w; }
    asm volatile("s_waitcnt lgkmcnt(0)" ::: "memory");
#pragma unroll
    for (int i = 0; i < 8; ++i) { const int c = lane + 64 * i; const u32x4m tv = *(const u32x4m*)(T + (c >> 4) * 272 + (c & 15) * 16); u32x4m ov;
#pragma unroll
      for (int k = 0; k < 4; ++k) ov[k] = pk2(blo(tv[k]) * blo(og[i][k]), bhi(tv[k]) * bhi(og[i][k]));
      *(u32x4m*)(Y + hz_off(yr0 + (c >> 4), yc0 + (c & 15) * 8)) = ov; } }
  __syncthreads();
#undef SLOAD
#undef SWRITE
}

__device__ __forceinline__ void mlstm_summary(int u, int h, size_t r0, const bf16* __restrict__ ZT, const float* __restrict__ GIF, float fb, bf16* CK, float* NK, float* ML, char* lds) {
  int tid = threadIdx.x; asm volatile("" : "+v"(tid));
  const int wid = __builtin_amdgcn_readfirstlane(tid >> 6), lane = tid & 63, r32 = lane & 31, hi = lane >> 5;
  char* Kt = lds; char* Vt = lds + 16384; float* WL = (float*)(lds + 32768); float* RED = (float*)(lds + 32768 + 1024); float* NKP = (float*)(lds + 32768 + 2048);
  float lf = 0.f, ai = 0.f; if (tid < 256) { const float f = GIF[(r0 + tid) * 8 + 4 + h] + fb; lf = fminf(f, 0.f) - 0.69314718056f * __builtin_amdgcn_logf(1.f + __builtin_amdgcn_exp2f(-1.4426950409f * fabsf(f))); ai = GIF[(r0 + tid) * 8 + h]; }
  float incl = lf;
#pragma unroll
  for (int o = 1; o < 64; o <<= 1) { const float t = __int_as_float(__builtin_amdgcn_ds_bpermute(((lane - o) & 63) << 2, __float_as_int(incl))); if (lane >= o) incl += t; }
  if (lane == 63) RED[wid] = incl;
  __syncthreads();
  float B = incl;
#pragma unroll
  for (int w = 0; w < 4; ++w) if (w < wid) B += RED[w];
  float a = tid < 256 ? ai - B : -INFINITY, mx = a;
  mx = fmaxf(mx, __int_as_float(__builtin_amdgcn_ds_swizzle(__float_as_int(mx), (1 << 10) | 0x1f))); mx = fmaxf(mx, __int_as_float(__builtin_amdgcn_ds_swizzle(__float_as_int(mx), (2 << 10) | 0x1f)));
  mx = fmaxf(mx, __int_as_float(__builtin_amdgcn_ds_swizzle(__float_as_int(mx), (4 << 10) | 0x1f))); mx = fmaxf(mx, __int_as_float(__builtin_amdgcn_ds_swizzle(__float_as_int(mx), (8 << 10) | 0x1f)));
  mx = fmaxf(mx, __int_as_float(__builtin_amdgcn_ds_swizzle(__float_as_int(mx), (16 << 10) | 0x1f)));
  { auto rr = __builtin_amdgcn_permlane32_swap(__float_as_uint(mx), __float_as_uint(mx), false, false); mx = fmaxf(__uint_as_float(rr[0]), __uint_as_float(rr[1])); }
  if (lane == 0) RED[8 + wid] = mx;
  __syncthreads();
  const float Mloc = fmaxf(fmaxf(RED[8], RED[9]), fmaxf(RED[10], RED[11]));
  if (tid < 256) WL[tid] = __builtin_amdgcn_exp2f((a - Mloc) * 1.4426950409f);
  __syncthreads();
  const int sr = tid >> 4, sc = (tid & 15) * 8, vst0 = att::v_st(sr, sc), vst1 = att::v_st(32 + sr, sc); const bool doK = sc < 64;
  const int ab = wid & 1, db = wid >> 1;
  const int vbk = (int)(uintptr_t)Kt + att::v_rd_base(lane) + ab * 512, vbv = (int)(uintptr_t)Vt + att::v_rd_base(lane) + db * 512;
  f32x16 acc = {}; float nk8[8];
#pragma unroll
  for (int e = 0; e < 8; ++e) nk8[e] = 0.f;
  v4u vs0, vs1, x0 = {0u, 0u, 0u, 0u}, x1 = {0u, 0u, 0u, 0u};
#define MS_LOAD(st_) do { const size_t ra_ = r0 + (st_) * 64 + sr, rb_ = ra_ + 32; vs0 = *(const v4u*)(ZT + ra_ * ZT_LD + ZT_MV + h * 128 + sc); vs1 = *(const v4u*)(ZT + rb_ * ZT_LD + ZT_MV + h * 128 + sc); \
    if (doK) { x0 = *(const v4u*)(ZT + ra_ * ZT_LD + ZT_MK + h * 64 + sc); x1 = *(const v4u*)(ZT + rb_ * ZT_LD + ZT_MK + h * 64 + sc); } } while (0)
  MS_LOAD(0);
  for (int st = 0; st < 4; ++st) { v4u k0 = {0u, 0u, 0u, 0u}, k1 = {0u, 0u, 0u, 0u}; const v4u w0v = vs0, w1v = vs1;
    if (doK) { const float w0 = WL[st * 64 + sr], w1 = WL[st * 64 + 32 + sr];
#pragma unroll
      for (int k = 0; k < 4; ++k) { const float a0 = w0 * blo(x0[k]), b0 = w0 * bhi(x0[k]), a1 = w1 * blo(x1[k]), b1 = w1 * bhi(x1[k]); nk8[2 * k] += a0 + a1; nk8[2 * k + 1] += b0 + b1; k0[k] = pk2(a0, b0); k1[k] = pk2(a1, b1); } }
    if (st > 0) __syncthreads();
    *(v4u*)(Vt + vst0) = w0v; *(v4u*)(Vt + vst1) = w1v; if (doK) { *(v4u*)(Kt + vst0) = k0; *(v4u*)(Kt + vst1) = k1; }
    if (st + 1 < 4) MS_LOAD(st + 1);
    __syncthreads();
    att::pv_kv(acc, vbk, vbv); }
#undef MS_LOAD
  if (doK) { *(f32x4*)(NKP + sr * 64 + sc) = (f32x4){nk8[0], nk8[1], nk8[2], nk8[3]}; *(f32x4*)(NKP + sr * 64 + sc + 4) = (f32x4){nk8[4], nk8[5], nk8[6], nk8[7]}; }
  __syncthreads();
  bf16* ck = CK + (size_t)u * 8192 + (ab * 32) * 128 + db * 32 + r32;
#pragma unroll
  for (int r = 0; r < 16; ++r) ck[att::crow(r, hi) * 128] = (bf16)f2bf(acc[r]);
  if (tid < 64) { float s = 0.f;
#pragma unroll 8
    for (int q = 0; q < 32; ++q) s += NKP[q * 64 + tid];
    NK[u * 64 + tid] = s; }
  if (tid == 0) ML[u] = Mloc;
  __syncthreads();
}
#undef KSWZ
}
namespace sgu {
using att::bf16x8; using att::f32x16;
typedef float f32x2s __attribute__((ext_vector_type(2)));
typedef unsigned u32x2s __attribute__((ext_vector_type(2)));
__device__ __forceinline__ float blo(unsigned w) { return __uint_as_float(w << 16); }
__device__ __forceinline__ float bhi(unsigned w) { return __uint_as_float(w & 0xffff0000u); }
__device__ __forceinline__ void sgu_unit(int bn, int g, const bf16* __restrict__ ZT, const float* __restrict__ PVS, const bf16* __restrict__ WS, const float* __restrict__ gsv, const float* __restrict__ bs, bf16* Y, char* lds) {
  int tid = threadIdx.x; asm volatile("" : "+v"(tid));
  const int wid = __builtin_amdgcn_readfirstlane(tid >> 6), lane = tid & 63, r32 = lane & 31, hi = lane >> 5;
  char* V_lds = lds; f32x2s* st = (f32x2s*)(lds + 32768);
  const size_t base = (size_t)bn * 128;
  const int sr = tid >> 4, sc = (tid & 15) * 8;
  const int tb = wid & 3, ch = wid >> 2, t = 32 * tb + r32;
  v4u xv[4];
#pragma unroll
  for (int q = 0; q < 4; ++q) xv[q] = __builtin_nontemporal_load((const v4u*)(ZT + (base + 32 * q + sr) * ZT_LD + ZT_V + g * 128 + sc));
  f32x2s pp[8];
  if (tid < 128) {
#pragma unroll
    for (int k = 0; k < 8; ++k) pp[k] = *(const f32x2s*)(PVS + ((base + tid) * 8 + k) * 2); }
  const size_t yr0 = base + 32 * tb; const int yc0 = 1024 + YD + g * 128 + 64 * ch;
  v4u ugv[4];
#pragma unroll
  for (int i = 0; i < 4; ++i) { const int c = lane + 64 * i; ugv[i] = *(const v4u*)(Y + hz_off(yr0 + (c >> 3), yc0 + (c & 7) * 8)); }
  if (tid < 128) { float s1 = 0.f, s2 = 0.f;
#pragma unroll
    for (int k = 0; k < 8; ++k) { s1 += pp[k].x; s2 += pp[k].y; }
    const float mean = s1 * (1.f / 512.f), var = fmaxf(s2 * (1.f / 512.f) - mean * mean, 0.f); f32x2s o; o.x = mean; o.y = __builtin_amdgcn_rsqf(var + RMS_EPS); st[tid] = o; }
  __syncthreads();
#pragma unroll
  for (int q = 0; q < 4; ++q) { const int s = 32 * q + sr; const f32x2s ms = st[s]; const v4u x = xv[q]; v4u w;
#pragma unroll
    for (int k = 0; k < 4; ++k) w[k] = pk2((blo(x[k]) - ms.x) * ms.y, (bhi(x[k]) - ms.x) * ms.y);
    *(v4u*)(V_lds + (q >> 1) * 16384 + att::v_st(32 * (q & 1) + sr, sc)) = w; }
  __syncthreads();
  f32x16 o[2] = {};
  const bf16* wrow = WS + ((size_t)g * 128 + t) * 128 + hi * 8;
  const int vb = (int)(uintptr_t)V_lds + att::v_rd_base(lane);
#pragma unroll
  for (int st_ = 0; st_ < 2; ++st_) { if (st_ == 1 && tb < 2) break;
    const bf16x8 pa0 = *(const bf16x8*)(wrow + 64 * st_), pa1 = *(const bf16x8*)(wrow + 64 * st_ + 16), pa2 = *(const bf16x8*)(wrow + 64 * st_ + 32), pa3 = *(const bf16x8*)(wrow + 64 * st_ + 48);
    if (ch == 0) { att::pv_one<0, true>(o[0], vb + st_ * 16384, pa0, pa1, pa2, pa3); att::pv_one<1, true>(o[1], vb + st_ * 16384, pa0, pa1, pa2, pa3); }
    else         { att::pv_one<2, true>(o[0], vb + st_ * 16384, pa0, pa1, pa2, pa3); att::pv_one<3, true>(o[1], vb + st_ * 16384, pa0, pa1, pa2, pa3); } }
  const float bt = bs[g * 128 + t]; const float* gp = gsv + g * 128 + 64 * ch;
  char* T = lds + 34816 + wid * 4608;
#pragma unroll
  for (int d = 0; d < 2; ++d)
#pragma unroll
    for (int q = 0; q < 4; ++q) { const int c = 32 * d + 8 * q + 4 * hi; const f32x4 gv = *(const f32x4*)(gp + c); u32x2s w;
      w.x = pk2(o[d][4 * q] * gv[0] + bt, o[d][4 * q + 1] * gv[1] + bt); w.y = pk2(o[d][4 * q + 2] * gv[2] + bt, o[d][4 * q + 3] * gv[3] + bt);
      *(u32x2s*)(T + r32 * 144 + c * 2) = w; }
  asm volatile("s_waitcnt lgkmcnt(0)" ::: "memory");
#pragma unroll
  for (int i = 0; i < 4; ++i) { const int c = lane + 64 * i; const v4u tv = *(const v4u*)(T + (c >> 3) * 144 + (c & 7) * 16); v4u ov;
#pragma unroll
    for (int k = 0; k < 4; ++k) ov[k] = pk2(blo(tv[k]) * blo(ugv[i][k]), bhi(tv[k]) * bhi(ugv[i][k]));
    *(v4u*)(Y + hz_off(yr0 + (c >> 3), yc0 + (c & 7) * 8)) = ov; }
  __syncthreads();
}
}

typedef float f32x2g __attribute__((ext_vector_type(2)));
typedef unsigned u32x2g __attribute__((ext_vector_type(2)));
__device__ __forceinline__ float fexp2g(float x) { return __builtin_amdgcn_exp2f(x); }
struct Args { const void* in[23]; float* out; unsigned char* ws; int ph_lo, ph_hi; };
struct Frame {
    LAS unsigned char* lds; volatile LAS unsigned* MISC; gu32* ctl; unsigned char* ws;
    int tid, lane, wave, G, gw, NGW;
};
#define WSP(T, off) ((T*)(F.ws + (off)))

template <int X> __device__ __forceinline__ float swz_xor(float v) { return __int_as_float(__builtin_amdgcn_ds_swizzle(__float_as_int(v), (X << 10) | 0x1f)); }
__device__ __forceinline__ float sum_xor32(float v) { auto r = __builtin_amdgcn_permlane32_swap(__float_as_uint(v), __float_as_uint(v), false, false); return __uint_as_float(r[0]) + __uint_as_float(r[1]); }
__device__ __forceinline__ float wave_sum(float v) { v += swz_xor<1>(v); v += swz_xor<2>(v); v += swz_xor<4>(v); v += swz_xor<8>(v); v += swz_xor<16>(v); return sum_xor32(v); }
__device__ __forceinline__ float lane_up(float v, int lane, int o) { return __int_as_float(__builtin_amdgcn_ds_bpermute(((lane - o) & 63) << 2, __float_as_int(v))); }
__device__ __forceinline__ float bf2f(bf16 h) { return __uint_as_float((unsigned)h << 16); }
__device__ __forceinline__ float blo(unsigned w) { return __uint_as_float(w << 16); }
__device__ __forceinline__ float bhi(unsigned w) { return __uint_as_float(w & 0xffff0000u); }

template <int MAP> __device__ __forceinline__ void cvt_item(const float* W, int K, int Nsrc, const float* kscale, bf16* WT, LAS float* scr, int item, int nblk, int lane, int ldk = 0) {
    if (ldk == 0) ldk = K;
    const int kb = item / nblk, nb = item % nblk, k0 = 64 * kb, n0 = 32 * nb;
    float cs = 1.f; int sc; const int vc = n0 + 4 * (lane & 7);
    if (MAP == 0) sc = vc; else if (MAP == 1) sc = map_in(vc, cs); else if (MAP == 2) { sc = map_q(vc); cs = QSCALE; } else sc = map_kv(vc);
#pragma unroll
    for (int i = 0; i < 8; ++i) { const int kk = 8 * i + (lane >> 3); f32x4 v = {0.f, 0.f, 0.f, 0.f};
        if (sc >= 0) { v = __builtin_nontemporal_load((const GAS f32x4*)(W + (size_t)(k0 + kk) * Nsrc + sc)); float s = cs; if (kscale) s *= kscale[k0 + kk]; v = v * s; }
        LAS float* d = scr + kk * 33 + 4 * (lane & 7); d[0] = v.x; d[1] = v.y; d[2] = v.z; d[3] = v.w; }
    LDS_WAIT(); asm volatile("" ::: "memory");
    const int c = lane & 7;
#pragma unroll
    for (int j = 0; j < 4; ++j) { const int n = (lane >> 3) + 8 * j; const LAS float* s = scr + (8 * c) * 33 + n;
        v4u o; o.x = pk2(s[0 * 33], s[1 * 33]); o.y = pk2(s[2 * 33], s[3 * 33]); o.z = pk2(s[4 * 33], s[5 * 33]); o.w = pk2(s[6 * 33], s[7 * 33]);
        *(GAS v4u*)(WT + (size_t)(n0 + n) * ldk + k0 + 8 * c) = o; }
    LDS_WAIT(); asm volatile("" ::: "memory");
}
__device__ __forceinline__ void p0_weights_part(Frame& F, const Args& A, int l, int part, int w0, int nw) {
    LAS float* scr = (LAS float*)(F.lds + RING_OFF + F.wave * 16384);
    constexpr int I_UQ = 4 * 24, I_UKV = 2 * 32, I_P = 8 * 32, I_O = 16 * 32;
    if (part == 0) {
        for (int it = w0; it < I_UQ + I_UKV; it += nw) { int r = it;
            if (r < I_UQ) { cvt_item<2>(((const float*)A.in[9]) + (size_t)l * 256 * 768, 256, 768, ((const float*)A.in[7]) + l * 256, WSP(bf16, WS_WB + WB_UQ), scr, r, 24, F.lane); continue; } r -= I_UQ;
            cvt_item<3>(((const float*)A.in[10]) + (size_t)l * 128 * 1024, 128, 1024, ((const float*)A.in[8]) + l * 128, WSP(bf16, WS_WB + WB_UKV), scr, r, 32, F.lane); }
        const float* wsrc = ((const float*)A.in[16]) + (size_t)l * 65536; bf16* wd = WSP(bf16, WS_WB + WB_S);
        for (int i = w0 * 64 + F.lane; i < 65536; i += nw * 64) { const int t = (i >> 7) & 127, s = i & 127; wd[i] = (bf16)f2bf(s <= t ? wsrc[i] : 0.f); }
    } else {
        for (int it = w0; it < 4 * I_P + I_O; it += nw) { int r = it;
            if (r < 4 * I_P) { const int i = r / I_P; const float* wp = (const float*)A.in[18 + i]; cvt_item<0>(wp + (size_t)l * 512 * 1024, 512, 1024, nullptr, WSP(bf16, WS_WB + WB_P) + (size_t)(i >> 1) * 1024 * 1024 + (i & 1) * 512, scr, r % I_P, 32, F.lane, 1024); continue; } r -= 4 * I_P;
            cvt_item<0>(((const float*)A.in[22]) + (size_t)l * 1024 * 1024, 1024, 1024, nullptr, WSP(bf16, WS_WOUT), scr, r, 32, F.lane); }
    }
}
__device__ __forceinline__ void p0_weights(Frame& F, const Args& A, int l) {
    p0_weights_part(F, A, l, 0, F.gw, F.NGW);
    if (F.G != 256) p0_weights_part(F, A, l, 1, F.gw, F.NGW);
}
__device__ __forceinline__ void p2_wlate(Frame& F, const Args& A, int l) {
    if (F.G != 256 || blockIdx.x < 128) return;
    p0_weights_part(F, A, l, 1, ((int)blockIdx.x - 128) * NWAVES + F.wave, 128 * NWAVES);
    __syncthreads();
}
__device__ __forceinline__ float max_xor32(float v) { auto r = __builtin_amdgcn_permlane32_swap(__float_as_uint(v), __float_as_uint(v), false, false); return fmaxf(__uint_as_float(r[0]), __uint_as_float(r[1])); }
__device__ __forceinline__ float wave_max(float v) { v = fmaxf(v, swz_xor<1>(v)); v = fmaxf(v, swz_xor<2>(v)); v = fmaxf(v, swz_xor<4>(v)); v = fmaxf(v, swz_xor<8>(v)); v = fmaxf(v, swz_xor<16>(v)); return max_xor32(v); }
__device__ __forceinline__ unsigned pk4_i8(float a, float b, float c, float d) {
    const int ia = (int)__builtin_rintf(a), ib = (int)__builtin_rintf(b), ic = (int)__builtin_rintf(c), id = (int)__builtin_rintf(d);
    return ((unsigned)ia & 0xffu) | (((unsigned)ib & 0xffu) << 8) | (((unsigned)ic & 0xffu) << 16) | ((unsigned)id << 24); }
template <int MAP, int KI, int ROT> __device__ __forceinline__ void quant_cols(Frame& F, const float* W, int Nsrc, int nitems, unsigned char* dst, float* cdq) {
    LAS float* red = (LAS float*)(F.lds + RING_OFF);
    for (int it = blockIdx.x; it < nitems; it += F.G) {
        const int cg = F.tid & 7, n0 = it * 32 + 4 * cg, kg = F.tid >> 3, k0 = kg * 16; float cs = 1.f; const int sc = MAP == 1 ? map_in(n0, cs) : n0;
        const bool q8 = k0 < KI;
        f32x4 v[16]; f32x4 mx = {0.f, 0.f, 0.f, 0.f};
#pragma unroll
        for (int i = 0; i < 16; ++i) { v[i] = sc >= 0 ? __builtin_nontemporal_load((const GAS f32x4*)(W + (size_t)(k0 + i) * Nsrc + sc)) : (f32x4){0.f, 0.f, 0.f, 0.f};
            if (q8) { mx.x = fmaxf(mx.x, fabsf(v[i].x)); mx.y = fmaxf(mx.y, fabsf(v[i].y)); mx.z = fmaxf(mx.z, fabsf(v[i].z)); mx.w = fmaxf(mx.w, fabsf(v[i].w)); } }
#pragma unroll
        for (int c = 0; c < 4; ++c) { float t = mx[c]; t = fmaxf(t, swz_xor<8>(t)); t = fmaxf(t, swz_xor<16>(t)); mx[c] = max_xor32(t); }
        __syncthreads();
        if (F.lane < 8) { LAS float* d = red + F.wave * 32 + 4 * F.lane; d[0] = mx.x; d[1] = mx.y; d[2] = mx.z; d[3] = mx.w; }
        __syncthreads();
        f32x4 cm = {0.f, 0.f, 0.f, 0.f};
#pragma unroll
        for (int w = 0; w < 8; ++w) { const LAS float* s = red + w * 32 + 4 * cg; cm.x = fmaxf(cm.x, s[0]); cm.y = fmaxf(cm.y, s[1]); cm.z = fmaxf(cm.z, s[2]); cm.w = fmaxf(cm.w, s[3]); }
#pragma unroll
        for (int c = 0; c < 4; ++c) { unsigned char* drow = dst + (size_t)(n0 + c) * 2048;
            if (q8) { const float s = cm[c] > 0.f ? 127.f / cm[c] : 0.f; v4u o;
                o.x = pk4_i8(v[0][c] * s, v[1][c] * s, v[2][c] * s, v[3][c] * s); o.y = pk4_i8(v[4][c] * s, v[5][c] * s, v[6][c] * s, v[7][c] * s);
                o.z = pk4_i8(v[8][c] * s, v[9][c] * s, v[10][c] * s, v[11][c] * s); o.w = pk4_i8(v[12][c] * s, v[13][c] * s, v[14][c] * s, v[15][c] * s);
                *(GAS v4u*)(drow + ((k0 + ROT) & 1023)) = o;
                if (kg == 0) cdq[n0 + c] = cs * cm[c] * (1.f / 127.f); }
            else { v4u o0, o1; o0.x = pk2(v[0][c] * cs, v[1][c] * cs); o0.y = pk2(v[2][c] * cs, v[3][c] * cs); o0.z = pk2(v[4][c] * cs, v[5][c] * cs); o0.w = pk2(v[6][c] * cs, v[7][c] * cs);
                o1.x = pk2(v[8][c] * cs, v[9][c] * cs); o1.y = pk2(v[10][c] * cs, v[11][c] * cs); o1.z = pk2(v[12][c] * cs, v[13][c] * cs); o1.w = pk2(v[14][c] * cs, v[15][c] * cs);
                GAS v4u* d2 = (GAS v4u*)(drow + KI + 2 * (k0 - KI)); d2[0] = o0; d2[1] = o1; } }
    }
    __syncthreads();
}
struct QItem { const float* W; int Nsrc, n0, sc, KI, ROT; float cs; unsigned char* dst; float* cdq; };
constexpr int Q_NITEMS = NV_IN / 32 + 4096 / 32;
template <int KI8> __device__ __forceinline__ QItem q_item(Frame& F, const Args& A, int l, int it) {
    QItem q; const int cg = F.tid & 7; q.cs = 1.f;
    if (it < NV_IN / 32) { q.W = ((const float*)A.in[4]) + (size_t)l * 1024 * IN_DIM; q.Nsrc = IN_DIM; q.n0 = it * 32 + 4 * cg; q.sc = map_in(q.n0, q.cs); q.KI = KI8; q.ROT = 0; q.dst = WSP(unsigned char, WS_WB + WB_IN); q.cdq = WSP(float, WS_CDQI); }
    else { q.W = ((const float*)A.in[5]) + (size_t)l * 1024 * 4096; q.Nsrc = 4096; q.n0 = (it - NV_IN / 32) * 32 + 4 * cg; q.sc = q.n0; q.KI = 1024; q.ROT = 1024 - KI8; q.dst = WSP(unsigned char, WS_WB + WB_GATE); q.cdq = WSP(float, WS_CDQ); }
    return q;
}
__device__ __forceinline__ void q_load(Frame& F, const QItem& q, f32x4 (&v)[16]) {
    const int k0 = (F.tid >> 3) * 16;
#pragma unroll
    for (int i = 0; i < 16; ++i) v[i] = q.sc >= 0 ? __builtin_nontemporal_load((const GAS f32x4*)(q.W + (size_t)(k0 + i) * q.Nsrc + q.sc)) : (f32x4){0.f, 0.f, 0.f, 0.f};
}
__device__ __forceinline__ void q_finish(Frame& F, const QItem& q, f32x4 (&v)[16]) {
    LAS float* red = (LAS float*)(F.lds + RING_OFF);
    const int cg = F.tid & 7, kg = F.tid >> 3, k0 = kg * 16; const bool q8 = k0 < q.KI;
    f32x4 mx = {0.f, 0.f, 0.f, 0.f};
    if (q8) {
#pragma unroll
        for (int i = 0; i < 16; ++i) { mx.x = fmaxf(mx.x, fabsf(v[i].x)); mx.y = fmaxf(mx.y, fabsf(v[i].y)); mx.z = fmaxf(mx.z, fabsf(v[i].z)); mx.w = fmaxf(mx.w, fabsf(v[i].w)); } }
#pragma unroll
    for (int c = 0; c < 4; ++c) { float t = mx[c]; t = fmaxf(t, swz_xor<8>(t)); t = fmaxf(t, swz_xor<16>(t)); mx[c] = max_xor32(t); }
    __syncthreads();
    if (F.lane < 8) { LAS float* d = red + F.wave * 32 + 4 * F.lane; d[0] = mx.x; d[1] = mx.y; d[2] = mx.z; d[3] = mx.w; }
    __syncthreads();
    f32x4 cm = {0.f, 0.f, 0.f, 0.f};
#pragma unroll
    for (int w = 0; w < 8; ++w) { const LAS float* s = red + w * 32 + 4 * cg; cm.x = fmaxf(cm.x, s[0]); cm.y = fmaxf(cm.y, s[1]); cm.z = fmaxf(cm.z, s[2]); cm.w = fmaxf(cm.w, s[3]); }
#pragma unroll
    for (int c = 0; c < 4; ++c) { unsigned char* drow = q.dst + (size_t)(q.n0 + c) * 2048; const float cs = q.cs;
        if (q8) { const float s = cm[c] > 0.f ? 127.f / cm[c] : 0.f; v4u o;
            o.x = pk4_i8(v[0][c] * s, v[1][c] * s, v[2][c] * s, v[3][c] * s); o.y = pk4_i8(v[4][c] * s, v[5][c] * s, v[6][c] * s, v[7][c] * s);
            o.z = pk4_i8(v[8][c] * s, v[9][c] * s, v[10][c] * s, v[11][c] * s); o.w = pk4_i8(v[12][c] * s, v[13][c] * s, v[14][c] * s, v[15][c] * s);
            *(GAS v4u*)(drow + ((k0 + q.ROT) & 1023)) = o;
            if (kg == 0) q.cdq[q.n0 + c] = cs * cm[c] * (1.f / 127.f); }
        else { v4u o0, o1; o0.x = pk2(v[0][c] * cs, v[1][c] * cs); o0.y = pk2(v[2][c] * cs, v[3][c] * cs); o0.z = pk2(v[4][c] * cs, v[5][c] * cs); o0.w = pk2(v[6][c] * cs, v[7][c] * cs);
            o1.x = pk2(v[8][c] * cs, v[9][c] * cs); o1.y = pk2(v[10][c] * cs, v[11][c] * cs); o1.z = pk2(v[12][c] * cs, v[13][c] * cs); o1.w = pk2(v[14][c] * cs, v[15][c] * cs);
            GAS v4u* d2 = (GAS v4u*)(drow + q.KI + 2 * (k0 - q.KI)); d2[0] = o0; d2[1] = o1; } }
}
template <int KI8> __device__ __forceinline__ void p0_rows(Frame& F, const Args& A, int stage) {
    const float* xsrc = stage == 2 ? A.out : ((const float*)A.in[0]);
    f32x4 gpo[4], gpr[4];
#pragma unroll
    for (int j = 0; j < 4; ++j) { gpo[j] = stage >= 1 ? *((const GAS f32x4*)(((const float*)A.in[3]) + (stage - 1) * D) + F.lane + 64 * j) : (f32x4){0.f, 0.f, 0.f, 0.f};
        gpr[j] = stage < 2 ? *((const GAS f32x4*)(((const float*)A.in[2]) + stage * D) + F.lane + 64 * j) : (f32x4){0.f, 0.f, 0.f, 0.f}; }
    f32x4 v[4], vn[4]; u32x2g mo[4], mon[4]; float po = 0.f, pon = 0.f;
#define ROW_LOAD(V, MO, PO, m_) do { if (stage == 2) { _Pragma("unroll") for (int j = 0; j < 4; ++j) { const u32x2g xb_ = __builtin_nontemporal_load((const GAS u32x2g*)((const char*)A.out + (size_t)(m_) * 4096) + F.lane + 64 * j); V[j].x = __uint_as_float(xb_.x); V[j].y = __uint_as_float(xb_.y); } } \
        else { _Pragma("unroll") for (int j = 0; j < 4; ++j) V[j] = __builtin_nontemporal_load((const GAS f32x4*)(xsrc + (size_t)(m_) * D) + F.lane + 64 * j); } \
        if (stage >= 1) { _Pragma("unroll") for (int j = 0; j < 4; ++j) MO[j] = __builtin_nontemporal_load((const GAS u32x2g*)(WSP(bf16, WS_MO) + (size_t)(m_) * D) + F.lane + 64 * j); PO = F.lane < 16 ? WSP(float, WS_PO)[(size_t)(m_) * 16 + F.lane] : 0.f; } } while (0)
    int m = F.gw; if (m < M) ROW_LOAD(v, mo, po, m);
    for (; m < M; m += F.NGW) {
        const int mn = m + F.NGW; if (mn < M) ROW_LOAD(vn, mon, pon, mn);
        if (stage == 2) {
#pragma unroll
            for (int j = 0; j < 4; ++j) { const unsigned w0 = __float_as_uint(v[j].x), w1 = __float_as_uint(v[j].y); v[j].x = blo(w0); v[j].y = bhi(w0); v[j].z = blo(w1); v[j].w = bhi(w1); } }
        if (stage >= 1) {
            const float rs = __builtin_amdgcn_rsqf(wave_sum(po) * (1.f / 1024.f) + RMS_EPS);
#pragma unroll
            for (int j = 0; j < 4; ++j) { v[j].x += blo(mo[j].x) * rs * gpo[j].x; v[j].y += bhi(mo[j].x) * rs * gpo[j].y; v[j].z += blo(mo[j].y) * rs * gpo[j].z; v[j].w += bhi(mo[j].y) * rs * gpo[j].w;
                if (stage == 1) { u32x2g o; o.x = pk2(v[j].x, v[j].y); o.y = pk2(v[j].z, v[j].w); __builtin_nontemporal_store(o, (GAS u32x2g*)((char*)A.out + (size_t)m * 4096) + F.lane + 64 * j); }
                else __builtin_nontemporal_store(v[j], (GAS f32x4*)(A.out + (size_t)m * D) + F.lane + 64 * j); }
        }
        if (stage < 2) {
            float s2 = 0.f;
#pragma unroll
            for (int j = 0; j < 4; ++j) s2 += (v[j].x * v[j].x + v[j].y * v[j].y) + (v[j].z * v[j].z + v[j].w * v[j].w);
            const float rs = __builtin_amdgcn_rsqf(wave_sum(s2) * (1.f / D) + RMS_EPS);
#pragma unroll
            for (int j = 0; j < 4; ++j) { v[j].x *= rs * gpr[j].x; v[j].y *= rs * gpr[j].y; v[j].z *= rs * gpr[j].z; v[j].w *= rs * gpr[j].w; }
            float mx = 0.f;
#pragma unroll
            for (int j = 0; j < 4; ++j) mx = fmaxf(fmaxf(mx, fmaxf(fabsf(v[j].x), fabsf(v[j].y))), fmaxf(fabsf(v[j].z), fabsf(v[j].w)));
            mx = wave_max(mx); const float qs = mx > 0.f ? 127.f / mx : 0.f;
#pragma unroll
            for (int j = 0; j < 4; ++j) { unsigned char* hz = WSP(unsigned char, WS_H); const int k = 256 * j + 4 * F.lane, p8 = (k + 1024 - KI8) & 1023;
                *(GAS unsigned*)(hz + hz_off(m, p8 >> 1) * 2) = pk4_i8(v[j].x * qs, v[j].y * qs, v[j].z * qs, v[j].w * qs);
                if (256 * j >= KI8) { u32x2g o; o.x = pk2(v[j].x, v[j].y); o.y = pk2(v[j].z, v[j].w); *(GAS u32x2g*)(hz + hz_off(m, (1024 + 2 * (k - KI8)) >> 1) * 2) = o; } }
            if (F.lane == 0) WSP(float, WS_RDQ)[m] = mx * (1.f / 127.f);
        }
#pragma unroll
        for (int j = 0; j < 4; ++j) { v[j] = vn[j]; mo[j] = mon[j]; } po = pon;
    }
#undef ROW_LOAD
}
template <int KI8> __device__ __forceinline__ void p0_all(Frame& F, const Args& A, int l) {
    const int nit = F.G == 256 ? NV_IN / 32 : Q_NITEMS;
    const int it0 = blockIdx.x; f32x4 qv[16]; QItem q0 = q_item<KI8>(F, A, l, it0 < nit ? it0 : 0);
    if (it0 < nit) q_load(F, q0, qv);
    p0_rows<KI8>(F, A, l);
    p0_weights(F, A, l);
    if (it0 < nit) q_finish(F, q0, qv);
    for (int it = it0 + F.G; it < nit; it += F.G) { QItem q = q_item<KI8>(F, A, l, it); q_load(F, q, qv); q_finish(F, q, qv); }
    __syncthreads();
}
template <int KI8> __device__ __forceinline__ void p2_gateq(Frame& F, const Args& A, int l) {
    if (F.G != 256 || blockIdx.x < 128) return;
    f32x4 qv[16]; QItem q = q_item<KI8>(F, A, l, NV_IN / 32 + ((int)blockIdx.x - 128)); q_load(F, q, qv); q_finish(F, q, qv);
    __syncthreads();
}
__device__ __forceinline__ void p0_rope(Frame& F, const Args& A) {
    const int gt = F.gw * 64 + F.lane, NT = F.NGW * 64;
    for (int i = gt; i < M * 16; i += NT) { const int row = i >> 4, j = i & 15;
        const float inv = exp2f(-(float)j * 0.83048202372184058f);     const float ang = (float)((const int*)A.in[1])[row] * inv; const double rv = (double)ang * 0.15915494309189535; const float fr = (float)(rv - rint(rv)); const float s = __builtin_amdgcn_sinf(fr), c = __builtin_amdgcn_cosf(fr);
        f32x2g o; o.x = c; o.y = s; *(GAS f32x2g*)(WSP(float, WS_ROPE) + (size_t)i * 2) = o; }
}
__device__ __forceinline__ void p2_conv(Frame& F, const Args& A, int l) {
    const float* wc = ((const float*)A.in[13]) + l * 3 * 512; const float* bc = ((const float*)A.in[14]) + l * 512; const int c0 = F.lane * 8;
    float w0[8], w1[8], w2[8], bb[8];
    { const f32x4 a0 = *(const GAS f32x4*)(wc + c0), a1 = *(const GAS f32x4*)(wc + c0 + 4), b0 = *(const GAS f32x4*)(wc + 512 + c0), b1 = *(const GAS f32x4*)(wc + 512 + c0 + 4),
                  d0 = *(const GAS f32x4*)(wc + 1024 + c0), d1 = *(const GAS f32x4*)(wc + 1024 + c0 + 4), e0 = *(const GAS f32x4*)(bc + c0), e1 = *(const GAS f32x4*)(bc + c0 + 4);
#pragma unroll
      for (int q = 0; q < 4; ++q) { w0[q] = a0[q]; w0[4 + q] = a1[q]; w1[q] = b0[q]; w1[4 + q] = b1[q]; w2[q] = d0[q]; w2[4 + q] = d1[q]; bb[q] = e0[q]; bb[4 + q] = e1[q]; } }
    for (int r0 = F.gw * 16; r0 < M; r0 += F.NGW * 16) {
        const int t0 = r0 & (SEQ - 1);
        const bf16* up = WSP(bf16, WS_ZT) + (size_t)r0 * ZT_LD + ZT_U + c0; bf16* hzb = WSP(bf16, WS_H); const int ecc = 1024 + YC + c0;
        v4u um2 = {0u, 0u, 0u, 0u}, um1 = {0u, 0u, 0u, 0u};
        if (t0 > 0) { um2 = *(const GAS v4u*)(up - 2 * ZT_LD); um1 = *(const GAS v4u*)(up - ZT_LD); }
#pragma unroll
        for (int hb = 0; hb < 2; ++hb) { v4u uu[8], gg[8];
#pragma unroll
            for (int i = 0; i < 8; ++i) { uu[i] = __builtin_nontemporal_load((const GAS v4u*)(up + (size_t)(8 * hb + i) * ZT_LD)); gg[i] = __builtin_nontemporal_load((const GAS v4u*)(hzb + hz_off((size_t)(r0 + 8 * hb + i), ecc))); }
#pragma unroll
            for (int i = 0; i < 8; ++i) { v4u o;
#pragma unroll
                for (int q = 0; q < 4; ++q) {
                    const float ylo = w0[2 * q] * blo(um2[q]) + w1[2 * q] * blo(um1[q]) + w2[2 * q] * blo(uu[i][q]) + bb[2 * q];
                    const float yhi = w0[2 * q + 1] * bhi(um2[q]) + w1[2 * q + 1] * bhi(um1[q]) + w2[2 * q + 1] * bhi(uu[i][q]) + bb[2 * q + 1];
                    o[q] = pk2(blo(gg[i][q]) * ylo, bhi(gg[i][q]) * yhi); }
                *(GAS v4u*)(hzb + hz_off((size_t)(r0 + 8 * hb + i), ecc)) = o; um2 = um1; um1 = uu[i]; } }
    }
}
__device__ __forceinline__ float logsig(float x) { return fminf(x, 0.f) - 0.69314718056f * __builtin_amdgcn_logf(1.f + __builtin_amdgcn_exp2f(-1.4426950409f * fabsf(x))); }
__device__ __forceinline__ void p2_mscan(Frame& F, const Args& A, int l) {
    if (blockIdx.x >= 32) return;
    const int b = blockIdx.x >> 2, h = blockIdx.x & 3, lane = F.lane, wave = F.wave; const float fb = ((const float*)A.in[11])[l * 4 + h];
    const size_t r0 = (size_t)b * SEQ + F.tid * 8; const float* G = WSP(float, WS_GIF); LAS float* X = (LAS float*)(F.lds + RING_OFF);
    float lf[8], ai[8];
#pragma unroll
    for (int i = 0; i < 8; ++i) { lf[i] = G[(r0 + i) * 8 + 4 + h]; ai[i] = G[(r0 + i) * 8 + h]; }
    float ls = 0.f;
#pragma unroll
    for (int i = 0; i < 8; ++i) { lf[i] = logsig(lf[i] + fb); ls += lf[i]; }
    float incl = ls;
#pragma unroll
    for (int o = 1; o < 64; o <<= 1) { const float t = lane_up(incl, lane, o); if (lane >= o) incl += t; }
    if (lane == 63) X[wave] = incl;
    __syncthreads();
    float B = incl - ls;
#pragma unroll
    for (int w = 0; w < 8; ++w) if (w < wave) B += X[w];
    float lm = -INFINITY;
#pragma unroll
    for (int i = 0; i < 8; ++i) { B += lf[i]; ai[i] -= B; lf[i] = B; lm = fmaxf(lm, ai[i]); }
    float im = lm;
#pragma unroll
    for (int o = 1; o < 64; o <<= 1) { const float t = lane_up(im, lane, o); if (lane >= o) im = fmaxf(im, t); }
    if (lane == 63) X[8 + wave] = im;
    __syncthreads();
    float run = lane_up(im, lane, 1); if (lane == 0) run = -INFINITY; run = fmaxf(run, 0.f);
#pragma unroll
    for (int w = 0; w < 8; ++w) if (w < wave) run = fmaxf(run, X[8 + w]);
    float* O = WSP(float, WS_MLS);
#pragma unroll
    for (int i = 0; i < 8; ++i) { run = fmaxf(run, ai[i]); f32x4 o; o.x = ai[i]; o.y = run; o.z = lf[i] + run; o.w = 0.f; *(GAS f32x4*)(O + ((r0 + i) * 4 + h) * 4) = o; }
    __syncthreads();
}
#if MK_NAIVE_SGU
__device__ __forceinline__ void p2_sgu_naive(Frame& F, const Args& A, int l) {
    LAS f32x2g* st = (LAS f32x2g*)(F.lds + RING_OFF);
    const int c = F.tid & 127, tq = F.tid >> 7;
    for (int u = blockIdx.x; u < 1024; u += F.G) { const int g = u & 3, bn = u >> 2; const size_t base = (size_t)bn * 128;
        if (F.tid < 128) { float s1 = 0.f, s2 = 0.f;
            for (int k = 0; k < 8; ++k) { const f32x2g p = *(const GAS f32x2g*)(WSP(float, WS_PVS) + ((base + F.tid) * 8 + k) * 2); s1 += p.x; s2 += p.y; }
            const float mean = s1 * (1.f / 512.f), var = fmaxf(s2 * (1.f / 512.f) - mean * mean, 0.f); f32x2g o; o.x = mean; o.y = 1.0f / sqrtf(var + RMS_EPS); st[F.tid] = o; }
        __syncthreads();
        const float* W = ((const float*)A.in[16]) + ((size_t)l * 4 + g) * 128 * 128;
        float acc[32];
#pragma unroll
        for (int i = 0; i < 32; ++i) acc[i] = 0.f;
        for (int s = 0; s < 128; ++s) { const f32x2g ms = st[s]; const float vn = (bf2f(WSP(bf16, WS_ZT)[(base + s) * ZT_LD + ZT_V + g * 128 + c]) - ms.x) * ms.y;
#pragma unroll
            for (int i = 0; i < 32; ++i) { const int tt = tq + 4 * i; if (tt >= s) acc[i] += W[tt * 128 + s] * vn; } }
        const float gs = ((const float*)A.in[15])[l * 512 + g * 128 + c];
#pragma unroll
        for (int i = 0; i < 32; ++i) { const int tt = tq + 4 * i; GAS bf16* p = (GAS bf16*)(WSP(bf16, WS_ZY) + (base + tt) * ZY_LD + YD + g * 128 + c);
            const float mixed = acc[i] * gs + ((const float*)A.in[17])[(l * 4 + g) * 128 + tt]; *p = (bf16)f2bf(bf2f(*p) * mixed); }
        __syncthreads();
    }
}
#endif
#if !MK_NAIVE_SGU
__device__ __forceinline__ void p2_sgu(Frame& F, const Args& A, int l) {
    for (int u = blockIdx.x; u < 1024; u += F.G)
        sgu::sgu_unit(u >> 2, u & 3, WSP(bf16, WS_ZT), WSP(float, WS_PVS), WSP(bf16, WS_WB + WB_S), ((const float*)A.in[15]) + l * 512, ((const float*)A.in[17]) + l * 512, WSP(bf16, WS_H), (char*)F.lds + RING_OFF);
}
#endif
#if MK_NAIVE_ATTN
__device__ __forceinline__ void p3_attn_naive(Frame& F, const Args& A, bf16* Yunused) {
    const int lane = F.lane;
    for (int pass = 0; pass < 2; ++pass) { const int u = pass == 0 ? F.gw : 4095 - F.gw; if (F.gw >= 2048) break;
        const int c = u & 63, h = (u >> 6) & 7, b = u >> 9; const size_t row = (size_t)b * SEQ + c * 64 + lane;
        v4u q[12];
#pragma unroll
        for (int i = 0; i < 12; ++i) q[i] = *(const GAS v4u*)(WSP(bf16, WS_Q) + row * 768 + h * 96 + 8 * i);
        float o[64];
#pragma unroll
        for (int i = 0; i < 64; ++i) o[i] = 0.f;
        float mx = -1e30f, lsum = 0.f; const int nk = 64 * (c + 1);
        for (int k0 = 0; k0 < nk; ++k0) { const size_t kr = (size_t)b * SEQ + k0; float a = 0.f;
#pragma unroll
            for (int i = 0; i < 8; ++i) { const v4u w = *(const GAS v4u*)(WSP(bf16, WS_KN) + kr * 512 + h * 64 + 8 * i);
#pragma unroll
                for (int k = 0; k < 4; ++k) a += blo(q[i][k]) * blo(w[k]) + bhi(q[i][k]) * bhi(w[k]); }
#pragma unroll
            for (int i = 0; i < 4; ++i) { const v4u w = *(const GAS v4u*)(WSP(bf16, WS_KR) + kr * 32 + 8 * i);
#pragma unroll
                for (int k = 0; k < 4; ++k) a += blo(q[8 + i][k]) * blo(w[k]) + bhi(q[8 + i][k]) * bhi(w[k]); }
            if (__any(a > mx)) { const float mn = fmaxf(a, mx), al = fexp2g(mx - mn); mx = mn; lsum *= al;
#pragma unroll
                for (int i = 0; i < 64; ++i) o[i] *= al; }
            const float p = fexp2g(a - mx); lsum += p;
#pragma unroll
            for (int i = 0; i < 8; ++i) { const v4u w = *(const GAS v4u*)(WSP(bf16, WS_V) + kr * 512 + h * 64 + 8 * i);
#pragma unroll
                for (int k = 0; k < 4; ++k) { o[8 * i + 2 * k] += p * blo(w[k]); o[8 * i + 2 * k + 1] += p * bhi(w[k]); } }
        }
        const float rl = 1.0f / lsum; GAS v4u* yp = (GAS v4u*)(WSP(bf16, WS_ZY) + row * ZY_LD + YA + h * 64);
#pragma unroll
        for (int i = 0; i < 8; ++i) { const v4u g = yp[i]; v4u w;
#pragma unroll
            for (int k = 0; k < 4; ++k) w[k] = pk2(o[8 * i + 2 * k] * rl * blo(g[k]), o[8 * i + 2 * k + 1] * rl * bhi(g[k]));
            yp[i] = w; }
    }
}
#endif
#if !MK_NAIVE_ATTN
#if MK_ATTN_V2 == 2
#define ATTN_UNIT attn_unit3
#elif MK_ATTN_V2
#define ATTN_UNIT attn_unit2
#else
#define ATTN_UNIT attn_unit
#endif
__device__ __forceinline__ void p3_attn(Frame& F, const Args& A, bf16* Y) {
    const int bx = blockIdx.x, vcu = (F.G % 8 == 0) ? (bx % 8) * (F.G / 8) + bx / 8 : bx;
    for (int u = vcu; u < 1024; u += F.G) { const int v = u & 255, i = u >> 8, bh = v >> 2, s = v & 3, qb = i == 0 ? s : i == 1 ? 7 - s : i == 2 ? 8 + s : 15 - s;
        att::ATTN_UNIT(bh >> 3, bh & 7, qb, WSP(bf16, WS_Q), WSP(bf16, WS_KN), WSP(bf16, WS_KR), WSP(bf16, WS_V), Y, (char*)F.lds + RING_OFF); }
}
#endif
#if MK_NAIVE_MLSTM
__device__ __forceinline__ void p3_mlstm_naive(Frame& F, const Args& A, int l, bf16* Yunused) {
    const int lane = F.lane, hf = lane >> 5;
    for (int pass = 0; pass < 2; ++pass) { const int u = pass == 0 ? F.gw : 4095 - F.gw; if (F.gw >= 2048) break;
        const int w = u & 127, h = (u >> 7) & 3, b = u >> 9; const int t = w * 32 + (lane & 31); const size_t row = (size_t)b * SEQ + t;
        v4u q[8];
#pragma unroll
        for (int i = 0; i < 8; ++i) q[i] = *(const GAS v4u*)(WSP(bf16, WS_ZT) + row * ZT_LD + ZT_MQ + h * 64 + 8 * i);
        float acc[64];
#pragma unroll
        for (int i = 0; i < 64; ++i) acc[i] = 0.f;
        const f32x4 me = *(const GAS f32x4*)(WSP(float, WS_MLS) + (row * 4 + h) * 4); const float At = me.y, mt = me.z; float den = 0.f;
        const int nk = 32 * (w + 1);
        for (int s = 0; s < nk; ++s) { const size_t sr = (size_t)b * SEQ + s; float dot = 0.f;
#pragma unroll
            for (int i = 0; i < 8; ++i) { const v4u x = *(const GAS v4u*)(WSP(bf16, WS_ZT) + sr * ZT_LD + ZT_MK + h * 64 + 8 * i);
#pragma unroll
                for (int k = 0; k < 4; ++k) dot += blo(q[i][k]) * blo(x[k]) + bhi(q[i][k]) * bhi(x[k]); }
            const float ap = WSP(float, WS_MLS)[(sr * 4 + h) * 4]; const float p = s <= t ? dot * fexp2g((ap - At) * 1.4426950409f) : 0.f; den += p;
#pragma unroll
            for (int i = 0; i < 8; ++i) { const v4u x = *(const GAS v4u*)(WSP(bf16, WS_ZT) + sr * ZT_LD + ZT_MV + h * 128 + hf * 64 + 8 * i);
#pragma unroll
                for (int k = 0; k < 4; ++k) { acc[8 * i + 2 * k] += p * blo(x[k]); acc[8 * i + 2 * k + 1] += p * bhi(x[k]); } } }
        const float rd = 1.0f / fmaxf(fabsf(den), fexp2g(-mt * 1.4426950409f)); float ss = 0.f;
#pragma unroll
        for (int i = 0; i < 64; ++i) ss += acc[i] * acc[i];
        ss = sum_xor32(ss);
        const float rn = rd * __builtin_amdgcn_rsqf(rd * rd * ss * (1.f / 128.f) + RMS_EPS);
        const float* gm = ((const float*)A.in[12]) + l * 512 + h * 128 + hf * 64;
        GAS v4u* yp = (GAS v4u*)(WSP(bf16, WS_ZY) + row * ZY_LD + YB + h * 128 + hf * 64);
#pragma unroll
        for (int i = 0; i < 8; ++i) { const v4u g = yp[i]; v4u o;
#pragma unroll
            for (int k = 0; k < 4; ++k) o[k] = pk2(acc[8 * i + 2 * k] * rn * gm[8 * i + 2 * k] * blo(g[k]), acc[8 * i + 2 * k + 1] * rn * gm[8 * i + 2 * k + 1] * bhi(g[k]));
            yp[i] = o; }
    }
}
#endif
#if !MK_NAIVE_MLSTM
__device__ __forceinline__ void p3_mlstm(Frame& F, const Args& A, int l, bf16* Y) {
    const int bx = blockIdx.x, vcu = (F.G % 8 == 0) ? (bx % 8) * (F.G / 8) + bx / 8 : bx;
    for (int u = vcu; u < 512; u += F.G) { const int bh = u >> 4, qb = (u < 256) ? (u & 15) : 15 - (u & 15);
        mls::mlstm_unit(bh >> 2, bh & 3, qb, WSP(bf16, WS_ZT), WSP(float, WS_MLS), ((const float*)A.in[12]) + l * 512, WSP(bf16, WS_MSUM), WSP(float, WS_MSUM + 8 * MiB), WSP(float, WS_MSUM + 8 * MiB + 256 * 1024), Y, (char*)F.lds + RING_OFF); }
}
__device__ __forceinline__ void p2_msum(Frame& F, const Args& A, int l) {
    for (int u = blockIdx.x; u < 512; u += F.G) { const int bh = u >> 4, J = u & 15, h = bh & 3;
        mls::mlstm_summary(u, h, (size_t)(bh >> 2) * SEQ + J * 256, WSP(bf16, WS_ZT), WSP(float, WS_GIF), ((const float*)A.in[11])[l * 4 + h], WSP(bf16, WS_MSUM), WSP(float, WS_MSUM + 8 * MiB), WSP(float, WS_MSUM + 8 * MiB + 256 * 1024), (char*)F.lds + RING_OFF); }
}
#endif

#if MK_NAIVE_MLSTM
#define P2_MSUM(F, a, l) do {} while (0)
#else
#define P2_MSUM p2_msum
#endif
#if MK_NAIVE_SGU
#define P2_SGU p2_sgu_naive
#else
#define P2_SGU p2_sgu
#endif
#if MK_NAIVE_MLSTM
#define P3_MLSTM p3_mlstm_naive
#else
#define P3_MLSTM p3_mlstm
#endif
#if MK_NAIVE_ATTN
#define P3_ATTN p3_attn_naive
#else
#define P3_ATTN p3_attn
#endif
__global__ void __launch_bounds__(NTHREADS, 2) mk_fwd(Args args) {
    extern __shared__ __attribute__((aligned(16))) unsigned char lds[];
    Frame F;
    F.lds = (LAS unsigned char*)lds; F.MISC = (volatile LAS unsigned*)(F.lds + MISC_OFF);
    F.tid = threadIdx.x; F.lane = F.tid & 63; F.wave = __builtin_amdgcn_readfirstlane(F.tid >> 6); F.G = gridDim.x; F.gw = blockIdx.x * NWAVES + F.wave; F.NGW = F.G * NWAVES;
    F.ws = args.ws; F.ctl = (gu32*)(F.ws + WS_CTL);
    const Args& A = args;
    for (int u = F.tid; u < (LDS_BYTES - LDSCTL_OFF) / 4; u += NTHREADS) ((LAS unsigned*)(F.lds + LDSCTL_OFF))[u] = 0u;
    __syncthreads();
    const int lo = args.ph_lo, hi = args.ph_hi;
    XcdBarrier bar; bar.bar = (unsigned*)(F.ctl + CW_BAR); bar.x = 0; bar.st = nullptr;
    if (hi - lo > 1) bar = xcd_barrier_post((unsigned*)(F.ctl + CW_BAR), F.MISC + 8);
#define IN(k) (lo <= (k) && (k) < hi)
#define PROBE(b) ((MK_PROBE >> (b)) & 1)
#define NREP(b) (1 + PROBE(b))
#define FRESH() do { int z_ = 0; asm volatile("" : "+v"(z_)); F.ws = args.ws + __builtin_amdgcn_readfirstlane(z_); int t_ = threadIdx.x; asm volatile("" : "+v"(t_)); F.tid = t_; F.lane = t_ & 63; \
        F.wave = __builtin_amdgcn_readfirstlane(t_ >> 6); F.gw = blockIdx.x * NWAVES + F.wave; } while (0)
#define SEAM(k) do { if (IN(k) && IN((k) + 1)) xcd_barrier(bar); } while (0)
    typedef pg8::StaticOrder SO;
#define LAYER(l) do { \
        const int pb = 6 * l; \
        if (IN(pb + 0)) for (int rep_ = 0; rep_ < NREP(3); ++rep_) { FRESH(); if (l == 0) p0_rope(F, args); FRESH(); p0_all<ki8_of(l)>(F, args, l); } \
        SEAM(pb + 0); \
        if (IN(pb + 1)) for (int rep_ = 0; rep_ < NREP(0); ++rep_) { FRESH(); \
            pg8::Gemm g{WSP(bf16, WS_H), WSP(bf16, WS_WB + WB_IN), M, NV_IN, 1024, 64, 32768u, 48u * 32768u}; SO S; S.init(M, NV_IN, F.G, (int)blockIdx.x, 64 * (ki8_of(l) / 128 + (1024 - ki8_of(l)) / 64)  , (unsigned)((1024 - ki8_of(l)) / 128) * 32768u); \
            pg8::EpiIn<ki8_of(l)> E{WSP(bf16, WS_ZT), WSP(bf16, WS_H), WSP(bf16, WS_KR), WSP(float, WS_PQ), WSP(float, WS_PKV), WSP(float, WS_PVS), WSP(float, WS_GIF), WSP(float, WS_ROPE), WSP(float, WS_RDQ), WSP(float, WS_CDQI)}; \
            pg8::gemm_phase<pg8::EpiIn<ki8_of(l)>, SO, true, true>(F.lds + RING_OFF, g, S, E); \
        } \
        SEAM(pb + 1); \
        if (IN(pb + 2)) { for (int rep_ = 0; rep_ < NREP(6); ++rep_) { FRESH(); \
            { pg8::Gemm g{WSP(bf16, WS_ZT) + ZT_CQ, WSP(bf16, WS_WB + WB_UQ), M, 768, 256, ZT_LD}; SO S; S.init(M, 768, F.G, (int)blockIdx.x, 256); pg8::EpiUpQ E{WSP(bf16, WS_Q), WSP(float, WS_PQ), WSP(float, WS_ROPE)}; \
              pg8::gemm_phase<pg8::EpiUpQ, SO, true, true>(F.lds + RING_OFF, g, S, E); } \
            FRESH(); if (rep_ == 0) { p2_gateq<ki8_of(l)>(F, args, l); FRESH(); p2_wlate(F, args, l); FRESH(); } \
            { pg8::Gemm g{WSP(bf16, WS_ZT) + ZT_CKV, WSP(bf16, WS_WB + WB_UKV), M, 1024, 128, ZT_LD}; SO S; S.init(M, 1024, F.G, (int)blockIdx.x, 128); pg8::EpiUpKV E{WSP(bf16, WS_KN), WSP(bf16, WS_V), WSP(float, WS_PKV)}; \
              pg8::gemm_phase<pg8::EpiUpKV, SO, true, true>(F.lds + RING_OFF, g, S, E); } \
            __syncthreads(); } \
            for (int rep_ = 0; rep_ < NREP(7); ++rep_) { FRESH(); \
            p2_mscan(F, args, l); FRESH(); \
            P2_MSUM(F, args, l); } \
            FRESH(); \
            p2_conv(F, args, l); FRESH(); \
            P2_SGU(F, args, l); \
        } \
        SEAM(pb + 2); \
        if (IN(pb + 3)) { FRESH(); P3_ATTN(F, args, WSP(bf16, WS_H)); if (PROBE(4) && l == 0) { FRESH(); P3_ATTN(F, args, (bf16*)args.out); } FRESH(); P3_MLSTM(F, args, l, WSP(bf16, WS_H)); if (PROBE(5) && l == 0) { FRESH(); P3_MLSTM(F, args, l, (bf16*)args.out); } } \
        SEAM(pb + 3); \
        if (IN(pb + 4)) for (int rep_ = 0; rep_ < NREP(1); ++rep_) { FRESH(); \
            pg8::Gemm g{WSP(bf16, WS_H), WSP(bf16, WS_WB + WB_GATE), M, 1024, 1024, 64, 32768u, 48u * 32768u}; pg8::P4Order S; S.init(M, F.G, (int)blockIdx.x, (unsigned)(WB_P - WB_GATE)); \
            pg8::EpiP4 E{WSP(unsigned char, WS_S), WSP(bf16, WS_MG), ((const float*)A.in[6]) + l * 4096, WSP(float, WS_RDQ), WSP(float, WS_CDQ), WSP(unsigned char, WS_Q)  }; \
            pg8::gemm_phase<pg8::EpiP4, pg8::P4Order, true, true>(F.lds + RING_OFF, g, S, E); \
        } \
        SEAM(pb + 4); \
        if (IN(pb + 5)) for (int rep_ = 0; rep_ < NREP(2); ++rep_) { FRESH(); \
            pg8::Gemm g{WSP(bf16, WS_MG), WSP(bf16, WS_WOUT), M, 1024, 1024, 64, 32768u, 16u * 32768u};     SO S; S.init(M, 1024, F.G, (int)blockIdx.x, 1024); pg8::EpiOut E{WSP(bf16, WS_MO), WSP(float, WS_PO)}; \
            pg8::gemm_phase<pg8::EpiOut, SO, true, true>(F.lds + RING_OFF, g, S, E); \
        } \
        SEAM(pb + 5); \
    } while (0)
    LAYER(0);
    LAYER(1);
#undef LAYER
    if (IN(12)) { FRESH(); p0_rows<512>(F, args, 2); }
#undef IN
#undef SEAM
}

extern "C" void kernel_launch(void* const* d_in, const int* in_sizes, int n_in, void* d_out, int out_size, void* d_ws, size_t ws_size, hipStream_t stream) {
    static int grid = 0;
    if (grid == 0) {
        if (n_in != 23 || in_sizes[0] != M * D || out_size != M * D || ws_size < WS_END) { fprintf(stderr, "kernel_launch: unexpected shapes (n_in %d, in0 %d, out %d, ws %zu < %zu)\n", n_in, n_in > 0 ? in_sizes[0] : -1, out_size, ws_size, (size_t)WS_END); grid = -1; return; }
        int dev = 0, cus = 0, per_cu = 0;
        if (hipGetDevice(&dev) != hipSuccess || hipDeviceGetAttribute(&cus, hipDeviceAttributeMultiprocessorCount, dev) != hipSuccess) { grid = -1; return; }
        if (hipFuncSetAttribute((const void*)mk_fwd, hipFuncAttributeMaxDynamicSharedMemorySize, LDS_BYTES) != hipSuccess) { fprintf(stderr, "kernel_launch: hipFuncSetAttribute failed\n"); grid = -1; return; }
        if (hipOccupancyMaxActiveBlocksPerMultiprocessor(&per_cu, (const void*)mk_fwd, NTHREADS, LDS_BYTES) != hipSuccess || per_cu < 1) fprintf(stderr, "kernel_launch: occupancy query reports %d\n", per_cu);
        (void)hipGetLastError();
        grid = cus;
    }
    if (grid < 0) return;
    if (hipMemsetAsync((char*)d_ws + WS_CTL, 0, CTL_ZERO_BYTES, stream) != hipSuccess) return;
    Args a{};
    for (int i = 0; i < 23; ++i) a.in[i] = d_in[i];
    a.out = (float*)d_out; a.ws = (unsigned char*)d_ws;
#if MK_ONE_LAUNCH
    a.ph_lo = 0; a.ph_hi = N_PHASES;
    hipLaunchKernelGGL(mk_fwd, dim3(grid), dim3(NTHREADS), LDS_BYTES, stream, a);
#else
    for (int p = 0; p < N_PHASES; ++p) { a.ph_lo = p; a.ph_hi = p + 1; hipLaunchKernelGGL(mk_fwd, dim3(grid), dim3(NTHREADS), LDS_BYTES, stream, a); }
#endif
    const hipError_t le = hipPeekAtLastError();
    if (le != hipSuccess) fprintf(stderr, "kernel_launch: launch failed: %s\n", hipGetErrorName(le));
}
```
